# Optimizing an MI355X kernel written in HIP

```python
import math
import jax, jax.numpy as jnp
from jax import lax
import numpy as np

D_MODEL = 2048
BATCH = 8
SEQ = 2048
DEPTH = 2

N_A_LAYERS = DEPTH // 2
N_B_LAYERS = DEPTH - N_A_LAYERS
MEM_LEN = 256
MEM_HEADS = 4
MEM_HEAD_DIM = 128
MEM_WIDTH = MEM_HEADS * MEM_HEAD_DIM
MIX_WIDTH = D_MODEL
POOL_WIDTH = MIX_WIDTH - MEM_WIDTH
POOL_WINDOWS = (2, 4, 8, 16)
N_POOL_GROUPS = len(POOL_WINDOWS)
POOL_GROUP = POOL_WIDTH // N_POOL_GROUPS
DIFF_HEAD_DIM = 64
DIFF_V_DIM = 2 * DIFF_HEAD_DIM
DIFF_HEADS = POOL_WIDTH // DIFF_V_DIM
DIFF_QK_WIDTH = DIFF_HEADS * DIFF_HEAD_DIM
DIFF_V_WIDTH = DIFF_HEADS * DIFF_V_DIM
KV_WIDTH = 2 * DIFF_QK_WIDTH + DIFF_V_WIDTH
ROPE_THETA = 500000.0
ROPE_DIM = DIFF_HEAD_DIM // 4
D_FF = 4 * D_MODEL
Q_BLOCK = 128
EPS = 1e-6
NEG_INF = -1e30

kernel_name = 'yoco_pool_diffattn_memory_hybrid'


def rms_norm(x, g):
    xf = x.astype(jnp.float32)
    y = xf * lax.rsqrt(jnp.mean(xf * xf, axis=-1, keepdims=True) + EPS)
    return (y * g.astype(jnp.float32)).astype(x.dtype)


def rope_tables(seq):
    pos = jnp.arange(seq, dtype=jnp.float32)
    inv = ROPE_THETA ** (-(jnp.arange(ROPE_DIM // 2, dtype=jnp.float32) * 2.0) / ROPE_DIM)
    ang = pos[:, None] * inv[None, :]
    return jnp.cos(ang), jnp.sin(ang)


def partial_rope(t, cos, sin):
    half = ROPE_DIM // 2
    c = cos[None, :, None, :].astype(t.dtype)
    s = sin[None, :, None, :].astype(t.dtype)
    r1, r2, rest = t[..., :half], t[..., half:ROPE_DIM], t[..., ROPE_DIM:]
    return jnp.concatenate([r1 * c - r2 * s, r1 * s + r2 * c, rest], axis=-1)


def causal_multiscale_pool(u):
    B, S, _ = u.shape
    groups = u.astype(jnp.float32).reshape(B, S, N_POOL_GROUPS, POOL_GROUP)
    csum = jnp.cumsum(groups, axis=1)
    t = jnp.arange(S)
    outs = []
    for g, w in enumerate(POOL_WINDOWS):
        cg = csum[:, :, g]
        lag = jnp.pad(cg, ((0, 0), (w, 0), (0, 0)))[:, :S]
        count = jnp.minimum(t + 1, w).astype(jnp.float32)[None, :, None]
        outs.append((cg - lag) / count)
    mean = jnp.stack(outs, axis=2)
    return (mean - groups).astype(u.dtype)


def memory_cross_attention(q, mem, mem_norm_g, w_mem_kv, mq_g, mk_g):
    B, S, _ = q.shape
    M = mem.shape[1]
    mkv = rms_norm(mem, mem_norm_g) @ w_mem_kv
    k = mkv[..., :MEM_WIDTH].reshape(B, M, MEM_HEADS, MEM_HEAD_DIM)
    v = mkv[..., MEM_WIDTH:].reshape(B, M, MEM_HEADS, MEM_HEAD_DIM)
    q = rms_norm(q.reshape(B, S, MEM_HEADS, MEM_HEAD_DIM), mq_g)
    k = rms_norm(k, mk_g)
    s = jnp.einsum('bqhd,bkhd->bhqk', q, k).astype(jnp.float32) * (MEM_HEAD_DIM ** -0.5)
    p = jax.nn.softmax(s, axis=-1).astype(v.dtype)
    o = jnp.einsum('bhqk,bkhd->bqhd', p, v)
    return o.reshape(B, S, MEM_WIDTH)


def differential_attention(q1, q2, k1, k2, v, lam):
    B, S, H, dk = q1.shape
    dv = v.shape[-1]
    nb = S // Q_BLOCK
    scale = dk ** -0.5
    key_pos = jnp.arange(S)

    def blockify(t):
        return t.reshape(B, nb, Q_BLOCK, H, dk).transpose(1, 0, 2, 3, 4)

    def one_block(args):
        q1b, q2b, start = args
        q_pos = start + jnp.arange(Q_BLOCK)
        mask = key_pos[None, :] <= q_pos[:, None]

        def probs(qb, k):
            s = jnp.einsum('bqhd,bkhd->bhqk', qb, k).astype(jnp.float32) * scale
            return jax.nn.softmax(jnp.where(mask, s, NEG_INF), axis=-1)

        a = probs(q1b, k1) - lam * probs(q2b, k2)
        return jnp.einsum('bhqk,bkhd->bqhd', a.astype(v.dtype), v)

    starts = jnp.arange(nb) * Q_BLOCK
    out = lax.map(one_block, (blockify(q1), blockify(q2), starts))
    return out.transpose(1, 0, 2, 3, 4).reshape(B, S, H, dv)


def shared_kv(x, kv_norm, w_kv, k_norm, cos, sin):
    B, S, _ = x.shape
    kv = rms_norm(x, kv_norm) @ w_kv
    k1 = kv[..., :DIFF_QK_WIDTH].reshape(B, S, DIFF_HEADS, DIFF_HEAD_DIM)
    k2 = kv[..., DIFF_QK_WIDTH:2 * DIFF_QK_WIDTH].reshape(B, S, DIFF_HEADS, DIFF_HEAD_DIM)
    v = kv[..., 2 * DIFF_QK_WIDTH:].reshape(B, S, DIFF_HEADS, DIFF_V_DIM)
    k1 = partial_rope(rms_norm(k1, k_norm), cos, sin)
    k2 = partial_rope(rms_norm(k2, k_norm), cos, sin)
    return k1, k2, v


def squared_relu_mlp(h, w1, w2):
    z = jax.nn.relu(h @ w1)
    return (z * z) @ w2


def setup_inputs(seed: int = 0) -> dict:
    key = jax.random.key(seed)
    ks = jax.random.split(key, 20)
    f32 = jnp.float32

    def nrm(k, shape, scale):
        return jax.random.normal(k, shape, f32) * scale

    def gain(k, shape, noise=0.02):
        return 1.0 + noise * jax.random.normal(k, shape, f32)

    return {
        'x': nrm(ks[0], (BATCH, SEQ, D_MODEL), 1.0),
        'mem': nrm(ks[1], (BATCH, MEM_LEN, D_MODEL), 1.0),
        'mix_norm': gain(ks[2], (DEPTH, D_MODEL)),
        'w_in': nrm(ks[3], (DEPTH, D_MODEL, MIX_WIDTH), D_MODEL ** -0.5),
        'w_out': nrm(ks[4], (DEPTH, MIX_WIDTH, D_MODEL), 0.5 * MIX_WIDTH ** -0.5),
        'mem_norm': gain(ks[5], (DEPTH, D_MODEL)),
        'w_mem_kv': nrm(ks[6], (DEPTH, D_MODEL, 2 * MEM_WIDTH), D_MODEL ** -0.5),
        'mem_q_norm': gain(ks[7], (DEPTH, MEM_HEAD_DIM)),
        'mem_k_norm': gain(ks[8], (DEPTH, MEM_HEAD_DIM)),
        'ffn_norm': gain(ks[9], (DEPTH, D_MODEL)),
        'w_ff1': nrm(ks[10], (DEPTH, D_MODEL, D_FF), D_MODEL ** -0.5),
        'w_ff2': nrm(ks[11], (DEPTH, D_FF, D_MODEL), 0.5 * D_FF ** -0.5),
        'pool_w': nrm(ks[12], (N_A_LAYERS, N_POOL_GROUPS, POOL_GROUP, POOL_GROUP), POOL_GROUP ** -0.5),
        'pool_scale': gain(ks[13], (N_A_LAYERS, POOL_WIDTH), 0.1),
        'kv_norm': gain(ks[14], (D_MODEL,)),
        'w_kv': nrm(ks[15], (D_MODEL, KV_WIDTH), D_MODEL ** -0.5),
        'k_norm': gain(ks[16], (DIFF_HEAD_DIM,)),
        'q_norm': gain(ks[17], (N_B_LAYERS, DIFF_HEAD_DIM)),
        'diff_lambda': nrm(ks[18], (N_B_LAYERS, 4, DIFF_HEAD_DIM), 0.1),
        'subln_norm': gain(ks[19], (N_B_LAYERS, DIFF_V_DIM)),
    }


def reference(x, mem, mix_norm, w_in, w_out, mem_norm, w_mem_kv, mem_q_norm, mem_k_norm,
              ffn_norm, w_ff1, w_ff2, pool_w, pool_scale, kv_norm, w_kv, k_norm, q_norm,
              diff_lambda, subln_norm):
    B, S, _ = x.shape
    cos, sin = rope_tables(S)
    sk1 = sk2 = sv = None
    for i in range(DEPTH):
        if i == N_A_LAYERS:
            sk1, sk2, sv = shared_kv(x, kv_norm, w_kv, k_norm, cos, sin)
        u = rms_norm(x, mix_norm[i]) @ w_in[i]
        if i < N_A_LAYERS:
            a = i
            pooled = causal_multiscale_pool(u[..., :POOL_WIDTH])
            token_out = jnp.einsum('bsgc,gcd->bsgd', pooled, pool_w[a]).reshape(B, S, POOL_WIDTH) * pool_scale[a]
            mem_q = u[..., POOL_WIDTH:]
        else:
            b = i - N_A_LAYERS
            lam_init = 0.8 - 0.6 * math.exp(-0.3 * i)
            q1 = u[..., :DIFF_QK_WIDTH].reshape(B, S, DIFF_HEADS, DIFF_HEAD_DIM)
            q2 = u[..., DIFF_QK_WIDTH:2 * DIFF_QK_WIDTH].reshape(B, S, DIFF_HEADS, DIFF_HEAD_DIM)
            q1 = partial_rope(rms_norm(q1, q_norm[b]), cos, sin)
            q2 = partial_rope(rms_norm(q2, q_norm[b]), cos, sin)
            lq = diff_lambda[b].astype(jnp.float32)
            lam = jnp.exp(jnp.sum(lq[0] * lq[1])) - jnp.exp(jnp.sum(lq[2] * lq[3])) + lam_init
            o = differential_attention(q1, q2, sk1, sk2, sv, lam)
            token_out = (rms_norm(o, subln_norm[b]) * (1.0 - lam_init)).reshape(B, S, DIFF_V_WIDTH)
            mem_q = u[..., 2 * DIFF_QK_WIDTH:]
        mem_out = memory_cross_attention(mem_q, mem, mem_norm[i], w_mem_kv[i], mem_q_norm[i], mem_k_norm[i])
        x = x + jnp.concatenate([token_out, mem_out], axis=-1) @ w_out[i]
        x = x + squared_relu_mlp(rms_norm(x, ffn_norm[i]), w_ff1[i], w_ff2[i])
    return x
```

```cpp
#include <hip/hip_runtime.h>
#include <hip/hip_cooperative_groups.h>
#include <cstdio>
#include <cstdint>
namespace cg = cooperative_groups;
namespace pg8 {
#define PG8_LAS __attribute__((address_space(3)))
typedef unsigned short bf16_t;
typedef short bf16x8 __attribute__((ext_vector_type(8)));
typedef float f32x4 __attribute__((ext_vector_type(4)));
typedef unsigned u32x4 __attribute__((ext_vector_type(4)));
constexpr int BM = 256, BK = 64, HALF = 128, HTB = HALF * BK * 2  , STAGE_BYTES = 8 * HTB, NXCD = 8, WGM = 8;

__host__ __device__ __forceinline__ int lds_byte(int r, int c) { const int st = (r >> 4) * 2 + (c >> 5), rr = r & 15, cc = c & 31, ob = rr * 64 + cc * 2; return st * 1024 + (ob ^ (((ob >> 9) & 1) << 5)); }
__host__ __device__ __forceinline__ void stage_rc(int b, int& R, int& C) { const int st = b / 1024, sb = b % 1024, swz = sb ^ (((sb >> 9) & 1) << 5); R = (st >> 1) * 16 + swz / 64; C = (st & 1) * 32 + (swz % 64) / 2; }
__host__ __device__ __forceinline__ int perm32(int rho) { const int n = rho >> 4, i = rho & 15; return 8 * (i >> 2) + 4 * n + (i & 3); }

struct Unit { int pm, pn; };
struct Gemm { const bf16_t* A; const bf16_t* Bt; int M, N, K; };

struct StaticOrder {
    int nM, nN, nwg, G, c;
    __host__ __device__ void init(int M, int N, int G_, int c_) { nM = M / BM; nN = N / BM; nwg = nM * nN; G = G_; c = c_; }
    __host__ __device__ bool next(int i, Unit& u) const {
        const long L = (long)i * G + c; if (L >= nwg) return false;
        int wgid = (int)L; { const int q = nwg / NXCD, r = nwg % NXCD, xcd = wgid % NXCD, off = wgid / NXCD; wgid = (xcd < r ? xcd * (q + 1) : r * (q + 1) + (xcd - r) * q) + off; }
        const int nig = WGM * nN, gid = wgid / nig, fm = gid * WGM, gsz = (nM - fm) < WGM ? (nM - fm) : WGM;
        u.pm = fm + ((wgid % nig) % gsz); u.pn = (wgid % nig) / gsz; return true;
    }
    __device__ __forceinline__ void a_ready(const Unit&) const {}
    __device__ __forceinline__ void done(const Unit&) const {}
};

__device__ __forceinline__ unsigned cvt_pk_bf16(float lo, float hi) { unsigned r; asm volatile("v_cvt_pk_bf16_f32 %0, %1, %2" : "=v"(r) : "v"(lo), "v"(hi)); return r; }
typedef float f32x2 __attribute__((ext_vector_type(2)));
struct GemmX { const bf16_t* A; const bf16_t* Bt; int M, N, K, lda, ldb; };
struct SchedStd : StaticOrder {
    __device__ __forceinline__ const char* a_ptr(const GemmX& g, const Unit& u) const { return (const char*)g.A + (size_t)u.pm * BM * g.lda * 2; }
    __device__ __forceinline__ const char* b_ptr(const GemmX& g, const Unit& u) const { return (const char*)g.Bt + (size_t)u.pn * BM * g.ldb * 2; }
};
struct SchedP1 {
    StaticOrder so; int G, c;
    __device__ void init(int G_, int c_) { so.init(16384, 2048, G_, c_); G = G_; c = c_; }
    __device__ bool next(int i, Unit& u) const {
        const int L = i * G + c;
        if (L < 512) return so.next(i, u);
        const int l = L - 512; if (l >= 64) return false;
        u.pm = 64 + (l >> 3); u.pn = 8 + (l & 7); return true;
    }
    __device__ __forceinline__ void a_ready(const Unit&) const {}
    __device__ __forceinline__ void done(const Unit&) const {}
    __device__ __forceinline__ const char* a_ptr(const GemmX& g, const Unit& u) const { return (const char*)g.A + (size_t)u.pm * BM * g.lda * 2; }
    __device__ __forceinline__ const char* b_ptr(const GemmX& g, const Unit& u) const { return (const char*)g.Bt + (size_t)u.pn * BM * g.ldb * 2; }
};
struct SchedPool {
    int G, c;
    __device__ void init(int G_, int c_) { G = G_; c = c_; }
    __device__ bool next(int i, Unit& u) const {
        const int L = i * G + c; if (L >= 512) return false;
        u.pm = (L >> 1) & 63; u.pn = ((L >> 7) << 1) | (L & 1); return true;
    }
    __device__ __forceinline__ void a_ready(const Unit&) const {}
    __device__ __forceinline__ void done(const Unit&) const {}
    __device__ __forceinline__ const char* a_ptr(const GemmX& g, const Unit& u) const { return (const char*)g.A + ((size_t)u.pm * BM * g.lda + (size_t)(u.pn >> 1) * 384) * 2; }
    __device__ __forceinline__ const char* b_ptr(const GemmX& g, const Unit& u) const { return (const char*)g.Bt + (size_t)u.pn * BM * g.ldb * 2; }
};

typedef unsigned u32x2 __attribute__((ext_vector_type(2)));
constexpr float RMS_EPS = 1e-6f;
__device__ __forceinline__ float rstd2048(const float* rss, int row) { return rsqrtf(rss[row] * (1.0f / 2048.0f) + RMS_EPS); }

struct EpiP1 {
    static constexpr bool PERM = true, AFTER_DRAIN = false;
    bf16_t* big; bf16_t* mkv; const float* rss;
    __device__ __forceinline__ void operator()(const f32x4 (&acc)[2][2][4][2], const Unit& u, int wr, int wc, int fr, int fq) const {
        const int row0 = u.pm * BM + wr * 64 + fr;
        bf16_t* base; size_t ld;
        if (u.pm < 64) { ld = 8192; base = big + (u.pn < 6 ? u.pn * 256 : 3072 + (u.pn - 6) * 256); }
        else { ld = 2048; base = mkv - (size_t)16384 * 2048 + (u.pn - 8) * 256; }
        base += wc * 32 + 8 * fq;
#pragma unroll
        for (int ai = 0; ai < 2; ++ai)
#pragma unroll
            for (int m = 0; m < 4; ++m) { const int row = row0 + ai * HALF + m * 16; const float sc = rstd2048(rss, row); bf16_t* rowp = base + (size_t)row * ld;
#pragma unroll
                for (int bj = 0; bj < 2; ++bj) { const f32x4 v0 = acc[ai][bj][m][0] * sc, v1 = acc[ai][bj][m][1] * sc;
                    u32x4 w; w.x = cvt_pk_bf16(v0[0], v0[1]); w.y = cvt_pk_bf16(v0[2], v0[3]); w.z = cvt_pk_bf16(v1[0], v1[1]); w.w = cvt_pk_bf16(v1[2], v1[3]);
                    *(u32x4*)(rowp + bj * HALF) = w; } }
    }
};
struct EpiPool {
    static constexpr bool PERM = true, AFTER_DRAIN = false;
    bf16_t* big;
    __device__ __forceinline__ void operator()(const f32x4 (&acc)[2][2][4][2], const Unit& u, int wr, int wc, int fr, int fq) const {
        const int row0 = u.pm * BM + wr * 64 + fr; const int g = u.pn >> 1, half = u.pn & 1;
        bf16_t* base = big + 3584 + g * 384 + half * 256 + wc * 32 + 8 * fq;
#pragma unroll
        for (int ai = 0; ai < 2; ++ai)
#pragma unroll
            for (int m = 0; m < 4; ++m) { bf16_t* rowp = base + (size_t)(row0 + ai * HALF + m * 16) * 8192;
#pragma unroll
                for (int bj = 0; bj < 2; ++bj) { if (bj == 1 && half == 1) continue;
                    const f32x4 v0 = acc[ai][bj][m][0], v1 = acc[ai][bj][m][1];
                    u32x4 w; w.x = cvt_pk_bf16(v0[0], v0[1]); w.y = cvt_pk_bf16(v0[2], v0[3]); w.z = cvt_pk_bf16(v1[0], v1[1]); w.w = cvt_pk_bf16(v1[2], v1[3]);
                    *(u32x4*)(rowp + bj * HALF) = w; } }
    }
};
struct EpiRelu2 {
    static constexpr bool PERM = true, AFTER_DRAIN = false;
    bf16_t* big; const float* rss;
    __device__ __forceinline__ void operator()(const f32x4 (&acc)[2][2][4][2], const Unit& u, int wr, int wc, int fr, int fq) const {
        const int row0 = u.pm * BM + wr * 64 + fr;
        bf16_t* base = big + u.pn * BM + wc * 32 + 8 * fq;
#pragma unroll
        for (int ai = 0; ai < 2; ++ai)
#pragma unroll
            for (int m = 0; m < 4; ++m) { const int row = row0 + ai * HALF + m * 16; const float sc = rstd2048(rss, row); bf16_t* rowp = base + (size_t)row * 8192;
#pragma unroll
                for (int bj = 0; bj < 2; ++bj) { f32x4 v0 = acc[ai][bj][m][0] * sc, v1 = acc[ai][bj][m][1] * sc;
#pragma unroll
                    for (int e = 0; e < 4; ++e) { v0[e] = fmaxf(v0[e], 0.f); v0[e] *= v0[e]; v1[e] = fmaxf(v1[e], 0.f); v1[e] *= v1[e]; }
                    u32x4 w; w.x = cvt_pk_bf16(v0[0], v0[1]); w.y = cvt_pk_bf16(v0[2], v0[3]); w.z = cvt_pk_bf16(v1[0], v1[1]); w.w = cvt_pk_bf16(v1[2], v1[3]);
                    *(u32x4*)(rowp + bj * HALF) = w; } }
    }
};
struct EpiResid {
    static constexpr bool PERM = false, AFTER_DRAIN = false;
    const float* base; float* out; bf16_t* xb; float* rss_out;
    __device__ __forceinline__ void operator()(const f32x4 (&acc)[2][2][4][2], const Unit& u, int wr, int wc, int fr, int fq) const {
        const int row0 = u.pm * BM + wr * 64 + fr; const int col0 = u.pn * BM + wc * 32 + 4 * fq;
#pragma unroll
        for (int ai = 0; ai < 2; ++ai)
#pragma unroll
            for (int m = 0; m < 4; ++m) { const int row = row0 + ai * HALF + m * 16; const size_t off = (size_t)row * 2048 + col0; float ss = 0.f;
#pragma unroll
                for (int bj = 0; bj < 2; ++bj)
#pragma unroll
                    for (int n = 0; n < 2; ++n) { const f32x4 bs = *(const f32x4*)(base + off + bj * HALF + n * 16); const f32x4 o = bs + acc[ai][bj][m][n];
                        *(f32x4*)(out + off + bj * HALF + n * 16) = o;
                        if (xb) { u32x2 w; w.x = cvt_pk_bf16(o[0], o[1]); w.y = cvt_pk_bf16(o[2], o[3]); *(u32x2*)(xb + off + bj * HALF + n * 16) = w; }
                        ss += (o[0] * o[0] + o[1] * o[1]) + (o[2] * o[2] + o[3] * o[3]); }
                if (rss_out) { ss += __shfl_xor(ss, 16); ss += __shfl_xor(ss, 32); if (fq == 0) __hip_atomic_fetch_add(rss_out + row, ss, __ATOMIC_RELAXED, __HIP_MEMORY_SCOPE_AGENT); }
                if (m & 1) asm volatile("" ::: "memory"); }
    }
};
struct EpiP6 {
    static constexpr bool PERM = false, AFTER_DRAIN = false;
    bf16_t* big; const float* rss; const float* kgain; const float* qgain; const float* rope;
    __device__ __forceinline__ void operator()(const f32x4 (&acc)[2][2][4][2], const Unit& u, int wr, int wc, int fr, int fq) const {
        const int row0 = u.pm * BM + wr * 64 + fr; const int pn = u.pn;
        const int kind = (pn < 6) ? 1 : (pn >= 12 && pn < 18) ? 2 : 0;
        bf16_t* basep = big + pn * BM + wc * 64 + 4 * fq;
        if (kind == 0) {
#pragma unroll
            for (int ai = 0; ai < 2; ++ai)
#pragma unroll
                for (int m = 0; m < 4; ++m) { const int row = row0 + ai * HALF + m * 16; const float sc = rstd2048(rss, row); bf16_t* rowp = basep + (size_t)row * 8192;
#pragma unroll
                    for (int bj = 0; bj < 2; ++bj)
#pragma unroll
                        for (int n = 0; n < 2; ++n) { const f32x4 v = acc[ai][bj][m][n] * sc; u32x2 w; w.x = cvt_pk_bf16(v[0], v[1]); w.y = cvt_pk_bf16(v[2], v[3]); *(u32x2*)(rowp + bj * 32 + n * 16) = w; } }
        } else {
            const float* gp = (kind == 1 ? kgain : qgain) + 4 * fq; const float osc = (kind == 2) ? (0.125f * 1.4426950408889634f) : 1.0f;
            f32x4 gv[2][2];
#pragma unroll
            for (int bj = 0; bj < 2; ++bj)
#pragma unroll
                for (int n = 0; n < 2; ++n) gv[bj][n] = *(const f32x4*)(gp + bj * 32 + n * 16) * osc;
#pragma unroll
            for (int ai = 0; ai < 2; ++ai)
#pragma unroll
                for (int m = 0; m < 4; ++m) { const int row = row0 + ai * HALF + m * 16; const float sc = rstd2048(rss, row); bf16_t* rowp = basep + (size_t)row * 8192;
                    f32x4 v[2][2]; float ss = 0.f;
#pragma unroll
                    for (int bj = 0; bj < 2; ++bj)
#pragma unroll
                        for (int n = 0; n < 2; ++n) { v[bj][n] = acc[ai][bj][m][n] * sc; const f32x4 x = v[bj][n]; ss += (x[0] * x[0] + x[1] * x[1]) + (x[2] * x[2] + x[3] * x[3]); }
                    ss += __shfl_xor(ss, 16); ss += __shfl_xor(ss, 32);
                    const float r = rsqrtf(ss * (1.0f / 64.0f) + RMS_EPS);
#pragma unroll
                    for (int bj = 0; bj < 2; ++bj)
#pragma unroll
                        for (int n = 0; n < 2; ++n) v[bj][n] = v[bj][n] * r * gv[bj][n];
                    {
                        const float* rp = rope + (size_t)(row & 2047) * 16 + 4 * (fq & 1);
                        const f32x4 cs = *(const f32x4*)rp, sn = *(const f32x4*)(rp + 8);
                        f32x4 y = v[0][0], oth;
#pragma unroll
                        for (int e = 0; e < 4; ++e) oth[e] = __shfl_xor(y[e], 32);
                        const float sg = (fq < 2) ? -1.0f : 1.0f;
                        v[0][0] = y * cs + oth * (sn * sg);
                    }
#pragma unroll
                    for (int bj = 0; bj < 2; ++bj)
#pragma unroll
                        for (int n = 0; n < 2; ++n) { const f32x4 x = v[bj][n]; u32x2 w; w.x = cvt_pk_bf16(x[0], x[1]); w.y = cvt_pk_bf16(x[2], x[3]); *(u32x2*)(rowp + bj * 32 + n * 16) = w; } }
        }
    }
};
template <class Epi, class Sched, bool ALIGN_EPI = false, bool SP2 = false>
__device__ __forceinline__ void gemm_phase(PG8_LAS unsigned char* lds, const GemmX g, const Sched& S, const Epi& E) {
    int tid_ = threadIdx.x; asm volatile("" : "+v"(tid_));
    const int tid = tid_, wid = __builtin_amdgcn_readfirstlane(tid >> 6), lane = tid & 63, wr = wid >> 2, wc = wid & 3, fr = lane & 15, fq = lane >> 4;
    const int K = g.K, nt = K / BK;
    unsigned voffA[2], voffB[2];
#pragma unroll
    for (int i = 0; i < 2; ++i) { int R, C; stage_rc(tid * 16 + i * 8192, R, C); const int Rb = Epi::PERM ? ((R & ~31) + perm32(R & 31)) : R;
        voffA[i] = (unsigned)(R * g.lda + C) * 2u; voffB[i] = (unsigned)(Rb * g.ldb + C) * 2u; }
    const size_t kstep = (size_t)(BK * 2);
    const size_t hsA = (size_t)HALF * g.lda * 2, hsB = (size_t)HALF * g.ldb * 2;
    const unsigned ldsw = (unsigned)wid * 1024u;
    const int aoff = lds_byte(wr * 64 + fr, fq * 8), boff = lds_byte(wc * 32 + fr, fq * 8);
#define PG8_SA(b, h) (((b) * 2 + (h)) * HTB)
#define PG8_SB(b, h) ((4 + (b) * 2 + (h)) * HTB)
#define PG8_STAGE(bufoff, gbase, voff) do { _Pragma("unroll") for (int _i = 0; _i < 2; ++_i) \
        __builtin_amdgcn_global_load_lds((const unsigned*)((const char*)(gbase) + (voff)[_i]), (PG8_LAS unsigned*)(lds + (bufoff) + ldsw + _i * 8192), 16, 0, 0); } while (0)
#define PG8_LDA(dst, b, h) do { _Pragma("unroll") for (int m = 0; m < 4; ++m) _Pragma("unroll") for (int k = 0; k < 2; ++k) dst[m][k] = *(const PG8_LAS bf16x8*)(lds + PG8_SA(b, h) + aoff + m * 2048 + k * 1024); } while (0)
#define PG8_LDB(dst, b, h) do { _Pragma("unroll") for (int n = 0; n < 2; ++n) _Pragma("unroll") for (int k = 0; k < 2; ++k) dst[n][k] = *(const PG8_LAS bf16x8*)(lds + PG8_SB(b, h) + boff + n * 2048 + k * 1024); } while (0)
#define PG8_MMA(ai, bj, At, Bt) do { __builtin_amdgcn_s_setprio(1); _Pragma("unroll") for (int m = 0; m < 4; ++m) _Pragma("unroll") for (int n = 0; n < 2; ++n) _Pragma("unroll") for (int k = 0; k < 2; ++k) \
        acc[ai][bj][m][n] = __builtin_amdgcn_mfma_f32_16x16x32_bf16(Bt[n][k], At[m][k], acc[ai][bj][m][n], 0, 0, 0); __builtin_amdgcn_s_setprio(0); } while (0)
#define PG8_WAIT_V(n) asm volatile("s_waitcnt vmcnt(" #n ")" ::: "memory")
#define PG8_WAIT_L(n) asm volatile("s_waitcnt lgkmcnt(" #n ")" ::: "memory")
#define PG8_BAR __builtin_amdgcn_s_barrier()
#define PG8_SCHED __builtin_amdgcn_sched_barrier(0)
    Unit cur, nxt; int ui = 0;
    if (!S.next(0, cur)) return;
    f32x4 acc[2][2][4][2];
#pragma unroll
    for (int a = 0; a < 2; ++a)
#pragma unroll
        for (int b = 0; b < 2; ++b)
#pragma unroll
            for (int m = 0; m < 4; ++m)
#pragma unroll
                for (int n = 0; n < 2; ++n) acc[a][b][m][n] = (f32x4){0.f, 0.f, 0.f, 0.f};
    bf16x8 At[4][2], B0[2][2], B1[2][2];
    const char* cA = S.a_ptr(g, cur); const char* cB = S.b_ptr(g, cur);
    S.a_ready(cur);
    if constexpr (SP2) {
        PG8_STAGE(PG8_SB(0, 0), cB, voffB); PG8_STAGE(PG8_SB(0, 1), cB + hsB, voffB); PG8_STAGE(PG8_SA(0, 0), cA, voffA); PG8_STAGE(PG8_SA(0, 1), cA + hsA, voffA);
        if (wr == 1) PG8_BAR;
        PG8_WAIT_V(2); PG8_BAR;
        PG8_STAGE(PG8_SB(1, 0), cB + kstep, voffB); PG8_STAGE(PG8_SA(1, 0), cA + kstep, voffA); PG8_STAGE(PG8_SB(1, 1), cB + hsB + kstep, voffB);
        PG8_WAIT_V(6); PG8_BAR;
    } else {
        PG8_STAGE(PG8_SB(0, 0), cB, voffB); PG8_STAGE(PG8_SA(0, 0), cA, voffA); PG8_STAGE(PG8_SB(0, 1), cB + hsB, voffB); PG8_STAGE(PG8_SA(0, 1), cA + hsA, voffA);
        if (wr == 1) PG8_BAR;
        PG8_WAIT_V(4); PG8_BAR;
        PG8_STAGE(PG8_SB(1, 0), cB + kstep, voffB); PG8_STAGE(PG8_SA(1, 0), cA + kstep, voffA); PG8_STAGE(PG8_SB(1, 1), cB + hsB + kstep, voffB);
        PG8_WAIT_V(6); PG8_BAR;
    }
    for (;;) {
        const bool has_next = S.next(ui + 1, nxt);
        const char* nA = has_next ? S.a_ptr(g, nxt) : cA; const char* nB = has_next ? S.b_ptr(g, nxt) : cB;
        for (int t = 0; t < nt; t += 2) {
            const bool last = (t == nt - 2);
            const char* a1 = cA + (size_t)(t + 1) * kstep;
            const char* a2 = last ? nA : cA + (size_t)(t + 2) * kstep; const char* b2 = last ? nB : cB + (size_t)(t + 2) * kstep;
            const char* a3 = a2 + kstep; const char* b3 = b2 + kstep;
            if (last && has_next) S.a_ready(nxt);
            if constexpr (SP2) {
            PG8_LDB(B0, 0, 0); PG8_LDB(B1, 0, 1); PG8_SCHED; PG8_LDA(At, 0, 0); PG8_STAGE(PG8_SA(1, 1), a1 + hsA, voffA);
            PG8_WAIT_V(8); PG8_WAIT_L(0); PG8_BAR; PG8_MMA(0, 0, At, B0); PG8_MMA(0, 1, At, B1); PG8_BAR; PG8_SCHED;
            PG8_LDA(At, 0, 1); PG8_STAGE(PG8_SB(0, 0), b2, voffB); PG8_STAGE(PG8_SB(0, 1), b2 + hsB, voffB); PG8_STAGE(PG8_SA(0, 0), a2, voffA);
            PG8_WAIT_V(8); PG8_WAIT_L(0); PG8_BAR; PG8_MMA(1, 0, At, B0); PG8_MMA(1, 1, At, B1); PG8_BAR; PG8_SCHED;
            PG8_LDB(B0, 1, 0); PG8_LDB(B1, 1, 1); PG8_SCHED; PG8_LDA(At, 1, 0); PG8_STAGE(PG8_SA(0, 1), a2 + hsA, voffA);
            PG8_WAIT_V(8); PG8_WAIT_L(0); PG8_BAR; PG8_MMA(0, 0, At, B0); PG8_MMA(0, 1, At, B1); PG8_BAR; PG8_SCHED;
            PG8_LDA(At, 1, 1); PG8_STAGE(PG8_SB(1, 0), b3, voffB); PG8_STAGE(PG8_SB(1, 1), b3 + hsB, voffB); PG8_STAGE(PG8_SA(1, 0), a3, voffA);
            PG8_WAIT_V(8); PG8_WAIT_L(0); PG8_BAR; PG8_MMA(1, 0, At, B0); PG8_MMA(1, 1, At, B1); PG8_BAR; PG8_SCHED;
            } else {
            PG8_LDB(B0, 0, 0); PG8_SCHED; PG8_LDA(At, 0, 0); PG8_STAGE(PG8_SA(1, 1), a1 + hsA, voffA);
            PG8_WAIT_L(8); PG8_BAR; PG8_WAIT_L(0); PG8_MMA(0, 0, At, B0); PG8_BAR; PG8_SCHED;
            PG8_LDB(B1, 0, 1); PG8_STAGE(PG8_SB(0, 0), b2, voffB);
            PG8_BAR; PG8_WAIT_L(0); PG8_MMA(0, 1, At, B1); PG8_BAR;
            PG8_LDA(At, 0, 1); PG8_STAGE(PG8_SA(0, 0), a2, voffA);
            PG8_BAR; PG8_WAIT_L(0); PG8_MMA(1, 0, At, B0); PG8_BAR; PG8_SCHED;
            PG8_STAGE(PG8_SB(0, 1), b2 + hsB, voffB);
            PG8_WAIT_V(6); PG8_BAR; PG8_MMA(1, 1, At, B1); PG8_BAR;
            PG8_LDB(B0, 1, 0); PG8_SCHED; PG8_LDA(At, 1, 0); PG8_STAGE(PG8_SA(0, 1), a2 + hsA, voffA);
            PG8_WAIT_L(8); PG8_BAR; PG8_WAIT_L(0); PG8_MMA(0, 0, At, B0); PG8_BAR; PG8_SCHED;
            PG8_LDB(B1, 1, 1); PG8_STAGE(PG8_SB(1, 0), b3, voffB);
            PG8_BAR; PG8_WAIT_L(0); PG8_MMA(0, 1, At, B1); PG8_BAR;
            PG8_LDA(At, 1, 1); PG8_STAGE(PG8_SA(1, 0), a3, voffA);
            PG8_BAR; PG8_WAIT_L(0); PG8_MMA(1, 0, At, B0); PG8_BAR; PG8_SCHED;
            PG8_STAGE(PG8_SB(1, 1), b3 + hsB, voffB);
            PG8_WAIT_V(6); PG8_BAR; PG8_MMA(1, 1, At, B1); PG8_BAR;
            }
        }
        if constexpr (ALIGN_EPI) { if (wr == 0) PG8_BAR; }
        if constexpr (!Epi::AFTER_DRAIN) { E(acc, cur, wr, wc, fr, fq); S.done(cur); }
        if (!has_next) break;
#pragma unroll
        for (int a = 0; a < 2; ++a)
#pragma unroll
            for (int b = 0; b < 2; ++b)
#pragma unroll
                for (int m = 0; m < 4; ++m)
#pragma unroll
                    for (int n = 0; n < 2; ++n) acc[a][b][m][n] = (f32x4){0.f, 0.f, 0.f, 0.f};
        cur = nxt; cA = nA; cB = nB; ++ui;
        if constexpr (ALIGN_EPI) { if (wr == 1) PG8_BAR; }
    }
    PG8_WAIT_V(0);
    if constexpr (!ALIGN_EPI) { if (wr == 0) PG8_BAR; }
    PG8_BAR;
    if constexpr (Epi::AFTER_DRAIN) { E.fused(acc, cur, wr, wc, fr, fq, lds, wid, lane); S.done(cur); }
#undef PG8_SA
#undef PG8_SB
#undef PG8_STAGE
#undef PG8_LDA
#undef PG8_LDB
#undef PG8_MMA
#undef PG8_WAIT_V
#undef PG8_WAIT_L
#undef PG8_BAR
#undef PG8_SCHED
}
}

#include <hip/hip_bf16.h>
#include <cmath>
namespace attn_body {
using bf16=__hip_bfloat16;
using bf16x8=__attribute__((ext_vector_type(8)))short;
using s16x4=__attribute__((ext_vector_type(4)))short;
using f32x16=__attribute__((ext_vector_type(16)))float;
using u32x4=__attribute__((ext_vector_type(4)))unsigned;
constexpr int BATCH=8,SEQ=2048,D=64,DM=8192;
constexpr int NW=8,QBLK=32,QB=QBLK*NW,KVBLK=64,NQB=SEQ/QB;
constexpr int ATTN_PITCH=DM, ATTN_UNIT_ROWS=QB;
__device__ __forceinline__ int crow(int r,int hi){return (r&3)+8*(r>>2)+4*hi;}
#define SBAR() __builtin_amdgcn_sched_barrier(0)
__device__ __forceinline__ void cmask(f32x16&p0,f32x16&p1,int jb,int qrel,int hi){
  const float NEG=-INFINITY; int kb=64*jb+4*hi;
  #pragma unroll
  for(int r=0;r<16;++r){int kv=kb+(r&3)+8*(r>>2); if(kv>qrel)p0[r]=NEG; if(kv+32>qrel)p1[r]=NEG;}
}

constexpr int NSLOT=3, SLOTB=8192;
constexpr int LDS_K=0, LDS_V=NSLOT*SLOTB, LDS_WS=2*NSLOT*SLOTB, LDS_OST=LDS_WS+NW*64*4, LDS_BYTES=LDS_OST+NW*4096;
constexpr float C2=0.125f*1.4426950408889634f;
__device__ __forceinline__ void glds16(const void*gsrc,unsigned lds_dst){unsigned keep;
  asm volatile("s_mov_b32 %0, m0\n\ts_mov_b32 m0, %2\n\ts_nop 0\n\tglobal_load_lds_dwordx4 %1, off\n\ts_mov_b32 m0, %0":"=&s"(keep):"v"(gsrc),"s"(lds_dst):"memory");}
__device__ __forceinline__ float max3f(float a,float b,float c){float r;asm("v_max3_f32 %0, %1, %2, %3":"=v"(r):"v"(a),"v"(b),"v"(c));return r;}
__device__ __forceinline__ float max2f(float a,float b){float r;asm("v_max_f32_e32 %0, %1, %2":"=v"(r):"v"(a),"v"(b));return r;}
__device__ __forceinline__ float fadd_s(float a,float b){float r;asm("v_add_f32_e32 %0, %1, %2":"=v"(r):"v"(a),"v"(b));return r;}
__device__ __forceinline__ float fsub_s(float a,float b){float r;asm("v_sub_f32_e32 %0, %1, %2":"=v"(r):"v"(a),"v"(b));return r;}
typedef float f32x2_t __attribute__((ext_vector_type(2))); typedef __bf16 bf16x2_t __attribute__((ext_vector_type(2)));
__device__ __forceinline__ unsigned cvtpk_s(float lo,float hi){f32x2_t v={lo,hi};bf16x2_t b=__builtin_convertvector(v,bf16x2_t);return __builtin_bit_cast(unsigned,b);}
#define WAIT_BAR(N) asm volatile("s_waitcnt vmcnt(" #N ") lgkmcnt(0)\n\ts_barrier":::"memory")

__device__ __forceinline__ void qkt(f32x16&p0,f32x16&p1,const char*Kslot,const bf16x8*qr,const f32x16&negm,int r32,int hi){
  const char*kb=Kslot+hi*1024+r32*16;
  #pragma unroll
  for(int d0=0;d0<4;++d0){
    const bf16x8 b0=*reinterpret_cast<const bf16x8*>(kb+d0*2048);
    const bf16x8 b1=*reinterpret_cast<const bf16x8*>(kb+d0*2048+512);
    if(d0==0){p0=__builtin_amdgcn_mfma_f32_32x32x16_bf16(b0,qr[0],negm,0,0,0);p1=__builtin_amdgcn_mfma_f32_32x32x16_bf16(b1,qr[0],negm,0,0,0);}
    else{p0=__builtin_amdgcn_mfma_f32_32x32x16_bf16(b0,qr[d0],p0,0,0,0);p1=__builtin_amdgcn_mfma_f32_32x32x16_bf16(b1,qr[d0],p1,0,0,0);}}
}
typedef __attribute__((address_space(3))) const char* lds_cptr;
typedef short v4i16_t __attribute__((ext_vector_type(4)));
__device__ __forceinline__ void kload8(bf16x8*kf,lds_cptr kp){
  kf[0]=*(const __attribute__((address_space(3))) bf16x8*)(kp);      kf[1]=*(const __attribute__((address_space(3))) bf16x8*)(kp+512);
  kf[2]=*(const __attribute__((address_space(3))) bf16x8*)(kp+2048); kf[3]=*(const __attribute__((address_space(3))) bf16x8*)(kp+2560);
  kf[4]=*(const __attribute__((address_space(3))) bf16x8*)(kp+4096); kf[5]=*(const __attribute__((address_space(3))) bf16x8*)(kp+4608);
  kf[6]=*(const __attribute__((address_space(3))) bf16x8*)(kp+6144); kf[7]=*(const __attribute__((address_space(3))) bf16x8*)(kp+6656);
}
__device__ __forceinline__ void kload2(bf16x8*kf,lds_cptr kp,int j){ kf[2*j]=*(const __attribute__((address_space(3))) bf16x8*)(kp+j*2048); kf[2*j+1]=*(const __attribute__((address_space(3))) bf16x8*)(kp+j*2048+512); }
__device__ __forceinline__ s16x4 vtr(lds_cptr p){ return __builtin_bit_cast(s16x4,__builtin_amdgcn_ds_read_tr16_b64_v4i16((__attribute__((address_space(3))) v4i16_t*)p)); }
__device__ __forceinline__ float rowmax(const f32x16&p0,const f32x16&p1){
  float a=max3f(p0[0],p0[1],p1[0]),b=max3f(p0[2],p0[3],p1[1]);a=max3f(a,p1[2],p1[3]);
  #pragma unroll
  for(int r=4;r<16;r+=4){a=max3f(a,p0[r],p0[r+1]);b=max3f(b,p0[r+2],p0[r+3]);a=max3f(a,p1[r],p1[r+1]);b=max3f(b,p1[r+2],p1[r+3]);}
  const float m=max2f(a,b);
  auto rr=__builtin_amdgcn_permlane32_swap(__float_as_uint(m),__float_as_uint(m),false,false);
  return max2f(__uint_as_float(rr[0]),__uint_as_float(rr[1]));
}
__device__ __forceinline__ void pv(f32x16*o,int vb,bf16x8 pa0,bf16x8 pa1,bf16x8 pa2,bf16x8 pa3){
  #pragma unroll
  for(int d0=0;d0<2;++d0){s16x4 lo[4],hi[4];
    #pragma unroll
    for(int ks=0;ks<4;++ks){
      asm volatile("ds_read_b64_tr_b16 %0,%1 offset:%c2":"=&v"(lo[ks]):"v"(vb),"i"(d0*4096+ks*1024):"memory");
      asm volatile("ds_read_b64_tr_b16 %0,%1 offset:%c2":"=&v"(hi[ks]):"v"(vb),"i"(d0*4096+ks*1024+512):"memory");}
    asm volatile("s_waitcnt lgkmcnt(0)":::"memory");SBAR();
    #define PK(k) (bf16x8){lo[k][0],lo[k][1],lo[k][2],lo[k][3],hi[k][0],hi[k][1],hi[k][2],hi[k][3]}
    o[d0]=__builtin_amdgcn_mfma_f32_32x32x16_bf16(pa0,PK(0),o[d0],0,0,0);
    o[d0]=__builtin_amdgcn_mfma_f32_32x32x16_bf16(pa1,PK(1),o[d0],0,0,0);
    o[d0]=__builtin_amdgcn_mfma_f32_32x32x16_bf16(pa2,PK(2),o[d0],0,0,0);
    o[d0]=__builtin_amdgcn_mfma_f32_32x32x16_bf16(pa3,PK(3),o[d0],0,0,0);
    #undef PK
  }
}

#ifndef ATTN_STORE16
#define ATTN_STORE16(p,v) (*(u32x4*)(p)=(v))
#endif
template<int THRL> __device__ __forceinline__ void attn_unit(int b,int h,int qb,const bf16*Q,const bf16*__restrict__ K,const bf16*__restrict__ V,bf16*O,char*shm){
  int tid_=threadIdx.x; asm volatile("":"+v"(tid_)); const int tid=tid_,lane=tid&63,r32=lane&31,hi=lane>>5; const int wid=__builtin_amdgcn_readfirstlane(tid>>6);
  const long rowbase=(long)b*SEQ; const int q0=qb*QB;
  const bf16*Qw=Q+(rowbase+q0+wid*QBLK)*DM+h*D;
  const bf16*Kh=K+rowbase*DM+h*D,*Vh=V+rowbase*DM+h*D;
  const unsigned lds0=(unsigned)(uintptr_t)shm;
  float*wsf=(float*)(shm+LDS_WS)+wid*64;
  const bf16*ksrc=Kh+(long)lane*DM+wid*8;
  const bf16*vsrc=Vh+(long)(16*(wid&3)+(lane>>2))*DM+(wid>>2)*32+(lane&3)*8;
  const unsigned kdst=lds0+LDS_K+wid*1024, vdst=lds0+LDS_V+wid*1024;
  #define DMA_K(t,slot) glds16(ksrc+(long)(t)*KVBLK*DM,(unsigned)__builtin_amdgcn_readfirstlane(kdst+(slot)))
  #define DMA_V(t,slot) glds16(vsrc+(long)(t)*KVBLK*DM,(unsigned)__builtin_amdgcn_readfirstlane(vdst+(slot)))
  const int vb0=(int)(lds0+LDS_V)+((lane>>4)&1)*32+(lane&3)*8+(4*hi+((lane&15)>>2))*64;
  const char*Kbase=shm+LDS_K; bf16x8 kf[8];
  const lds_cptr shm3=(lds_cptr)shm; const lds_cptr kp0=shm3+LDS_K+hi*1024+r32*16; const lds_cptr vp0=shm3+LDS_V+((lane>>4)&1)*32+(lane&3)*8+(4*hi+((lane&15)>>2))*64;
  const int NT=(q0+QB)/KVBLK;
  DMA_K(0,0);DMA_V(0,0);DMA_K(1,SLOTB);
  bf16x8 qr[4];
  #pragma unroll
  for(int d0=0;d0<4;++d0)qr[d0]=*reinterpret_cast<const bf16x8*>(&Qw[(long)r32*DM+d0*16+hi*8]);
  float mhat=0.f,l_reg=0.f;f32x16 o[2];o[0]=f32x16{};o[1]=f32x16{};f32x16 negm=f32x16{};asm volatile("":"+v"(negm));
  const int qrel=wid*QBLK+r32;
  #define CMASK(P0,P1,t) do{int jb_=(t)-(NT-4); if(jb_>=0)cmask(P0,P1,jb_,qrel,hi);}while(0)
  bool resc=false;
  #define START(P0,P1) do{ const float rm=rowmax(P0,P1); resc=false; \
    { const float dl=rm; mhat=fadd_s(mhat,dl); \
      _Pragma("unroll") for(int r=0;r<16;++r){P0[r]=fsub_s(P0[r],dl);P1[r]=fsub_s(P1[r],dl);} \
      _Pragma("unroll") for(int r=0;r<16;++r)negm[r]=-mhat; asm volatile("":"+v"(negm)); } \
    _Pragma("unroll") for(int r=0;r<16;++r)P0[r]=__builtin_amdgcn_exp2f(P0[r]); }while(0)
  #define RESC() do{ if(resc){ asm volatile("s_waitcnt lgkmcnt(0)":::"memory"); \
      _Pragma("unroll") for(int d_=0;d_<2;++d_) _Pragma("unroll") for(int r=0;r<16;++r)o[d_][r]*=wsf[crow(r,hi)]; } }while(0)
  f32x16 pA0,pA1,pB0,pB1;
  int sl_prev=0,sl_cur=0,sl_next=SLOTB;
  #define ROT() do{sl_prev=sl_cur;sl_cur=sl_next;sl_next=(sl_next==(NSLOT-1)*SLOTB)?0:sl_next+SLOTB;}while(0)
  DMA_K(2,2*SLOTB);
  WAIT_BAR(3);
  qkt(pA0,pA1,Kbase,qr,negm,r32,hi);asm volatile("s_nop 15\n\ts_nop 7":"+v"(pA0),"+v"(pA1));CMASK(pA0,pA1,0);
  START(pA0,pA1);
  _Pragma("unroll") for(int r=0;r<16;++r)pA1[r]=__builtin_amdgcn_exp2f(pA1[r]);
  WAIT_BAR(0);
  DMA_K(3,0);DMA_V(1,SLOTB);
  ROT();
  kload8(kf,kp0+sl_cur);
  WAIT_BAR(2);
  s16x4 vlo[8],vhi[8]; u32x4 pw0,pw1,pw2,pw3;
  #define PKW(P,B) cvtpk_s(P[B],P[B+1])
  #define PAF(k) __builtin_bit_cast(bf16x8,pw##k)
  #define VFR(i) (bf16x8){vlo[i][0],vlo[i][1],vlo[i][2],vlo[i][3],vhi[i][0],vhi[i][1],vhi[i][2],vhi[i][3]}
  #define PIN(x) asm volatile("":"+v"(x))
  #define MX3(a,b,c) __builtin_fmaxf(__builtin_fmaxf((a),(b)),(c))
  #define GAPA(MF,A0,A1,A2,A3,W0,W1,PW) do{ MF; sacc+=A0; sacc+=A1; sacc+=A2; sacc+=A3; PIN(sacc); W0; W1; PIN(PW); SBAR(); }while(0)
  #define EX(v) __builtin_amdgcn_exp2f(v)
  #define GAPB(MF,X,B) do{ MF; X[B]=EX(X[B]); X[B+1]=EX(X[B+1]); X[B+2]=EX(X[B+2]); X[B+3]=EX(X[B+3]); PIN(X); SBAR(); }while(0)
  #define VRD(i) do{ vlo[i]=vtr(vp_+(((i)>>2)*4096+((i)&3)*1024)); vhi[i]=vtr(vp_+(((i)>>2)*4096+((i)&3)*1024+512)); }while(0)
  #define KRD(G,j) do{ if(G){ kload2(kf,kp0+sl_next,j); SBAR(); } }while(0)
  #define STEP(C0,C1,P0,P1,t,GK,GV,GL) do{ SBAR(); \
    const lds_cptr vp_=vp0+sl_prev; \
    VRD(0); SBAR(); float sacc=(P0[0]+P0[1]); \
    GAPA(C0=__builtin_amdgcn_mfma_f32_32x32x16_bf16(kf[0],qr[0],negm,0,0,0), P0[2],P0[3],P0[4],P0[5],     pw0[0]=PKW(P0,0), pw0[1]=PKW(P0,2), pw0); \
    VRD(4); SBAR(); GAPA(C1=__builtin_amdgcn_mfma_f32_32x32x16_bf16(kf[1],qr[0],negm,0,0,0), P0[6],P0[7],P0[8],P0[9],     pw0[2]=PKW(P0,4), pw0[3]=PKW(P0,6), pw0); \
    VRD(1); SBAR(); GAPA(C0=__builtin_amdgcn_mfma_f32_32x32x16_bf16(kf[2],qr[1],C0,0,0,0),   P0[10],P0[11],P0[12],P0[13], pw1[0]=PKW(P0,8), pw1[1]=PKW(P0,10), pw1); \
    VRD(5); SBAR(); GAPA(C1=__builtin_amdgcn_mfma_f32_32x32x16_bf16(kf[3],qr[1],C1,0,0,0),   P0[14],P0[15],P1[0],P1[1],   pw1[2]=PKW(P0,12),pw1[3]=PKW(P0,14), pw1); \
    VRD(2); SBAR(); GAPA(C0=__builtin_amdgcn_mfma_f32_32x32x16_bf16(kf[4],qr[2],C0,0,0,0),   P1[2],P1[3],P1[4],P1[5],     pw2[0]=PKW(P1,0), pw2[1]=PKW(P1,2), pw2); \
    VRD(6); SBAR(); GAPA(C1=__builtin_amdgcn_mfma_f32_32x32x16_bf16(kf[5],qr[2],C1,0,0,0),   P1[6],P1[7],P1[8],P1[9],     pw2[2]=PKW(P1,4), pw2[3]=PKW(P1,6), pw2); \
    VRD(3); SBAR(); GAPA(C0=__builtin_amdgcn_mfma_f32_32x32x16_bf16(kf[6],qr[3],C0,0,0,0),   P1[10],P1[11],P1[12],P1[13], pw3[0]=PKW(P1,8), pw3[1]=PKW(P1,10), pw3); \
    VRD(7); SBAR(); GAPA(C1=__builtin_amdgcn_mfma_f32_32x32x16_bf16(kf[7],qr[3],C1,0,0,0),   P1[14],P1[15],0.f,0.f,       pw3[2]=PKW(P1,12),pw3[3]=PKW(P1,14), pw3); \
    l_reg+=sacc; \
    if(GK){DMA_K((t)+3,sl_cur);} if(GV){DMA_V((t)+1,sl_next);} \
    CMASK(C0,C1,t); \
    { float a=MX3(C0[0],C0[1],C1[0]),b=MX3(C0[2],C0[3],C1[1]); a=MX3(a,C1[2],C1[3]); \
      _Pragma("unroll") for(int r=4;r<16;r+=4){a=MX3(a,C0[r],C0[r+1]);b=MX3(b,C0[r+2],C0[r+3]);a=MX3(a,C1[r],C1[r+1]);b=MX3(b,C1[r+2],C1[r+3]);} \
      float rm=__builtin_fmaxf(a,b); { auto rr=__builtin_amdgcn_permlane32_swap(__float_as_uint(rm),__float_as_uint(rm),false,false); rm=__builtin_fmaxf(__uint_as_float(rr[0]),__uint_as_float(rr[1])); } \
      resc=false; \
      if(__builtin_expect(__any(rm>(float)THRL),0)){ const float dl=__builtin_fmaxf(rm,0.f); mhat+=dl; \
        _Pragma("unroll") for(int r=0;r<16;++r){C0[r]-=dl;C1[r]-=dl;} \
        _Pragma("unroll") for(int r=0;r<16;++r)negm[r]=-mhat; asm volatile("":"+v"(negm)); \
        const float f=__builtin_amdgcn_exp2f(-dl); l_reg*=f; if(hi==0)wsf[r32]=f; resc=true; } } \
    SBAR(); \
    GAPB(o[0]=__builtin_amdgcn_mfma_f32_32x32x16_bf16(PAF(0),VFR(0),o[0],0,0,0), C0,0); \
    GAPB(o[1]=__builtin_amdgcn_mfma_f32_32x32x16_bf16(PAF(0),VFR(4),o[1],0,0,0), C0,4); \
    KRD(GL,0); GAPB(o[0]=__builtin_amdgcn_mfma_f32_32x32x16_bf16(PAF(1),VFR(1),o[0],0,0,0), C0,8); \
    KRD(GL,1); GAPB(o[1]=__builtin_amdgcn_mfma_f32_32x32x16_bf16(PAF(1),VFR(5),o[1],0,0,0), C0,12); \
    KRD(GL,2); GAPB(o[0]=__builtin_amdgcn_mfma_f32_32x32x16_bf16(PAF(2),VFR(2),o[0],0,0,0), C1,0); \
    KRD(GL,3); GAPB(o[1]=__builtin_amdgcn_mfma_f32_32x32x16_bf16(PAF(2),VFR(6),o[1],0,0,0), C1,4); \
    GAPB(o[0]=__builtin_amdgcn_mfma_f32_32x32x16_bf16(PAF(3),VFR(3),o[0],0,0,0), C1,8); \
    GAPB(o[1]=__builtin_amdgcn_mfma_f32_32x32x16_bf16(PAF(3),VFR(7),o[1],0,0,0), C1,12); \
    }while(0)
  int t=1;
  #undef CMASK
  #define CMASK(P0,P1,t) do{}while(0)
  for(;t+5<NT;t+=2){
    STEP(pB0,pB1,pA0,pA1,t,true,true,true);     WAIT_BAR(2); RESC(); ROT();
    STEP(pA0,pA1,pB0,pB1,t+1,true,true,true);   WAIT_BAR(2); RESC(); ROT();
  }
  #undef CMASK
  #define CMASK(P0,P1,t) do{int jb_=(t)-(NT-4); if(jb_>=0)cmask(P0,P1,jb_,qrel,hi);}while(0)
  #define ENDW(tt) do{ if((tt)+3<NT){WAIT_BAR(2);} else if((tt)+2<NT){WAIT_BAR(1);} else {WAIT_BAR(0);} }while(0)
  for(;t+1<NT;t+=2){
    STEP(pB0,pB1,pA0,pA1,t,(t+3<NT),(t+1<NT),(t+1<NT));       ENDW(t);   RESC(); ROT();
    STEP(pA0,pA1,pB0,pB1,t+1,(t+4<NT),(t+2<NT),(t+2<NT));     ENDW(t+1); RESC(); ROT();
  }
  STEP(pB0,pB1,pA0,pA1,NT-1,false,false,false); RESC();
  { float sacc=pB0[0]+pB0[1]; _Pragma("unroll") for(int r=2;r<16;++r)sacc+=pB0[r]; _Pragma("unroll") for(int r=0;r<16;++r)sacc+=pB1[r]; l_reg+=sacc;
    pw0=(u32x4){PKW(pB0,0),PKW(pB0,2),PKW(pB0,4),PKW(pB0,6)};pw1=(u32x4){PKW(pB0,8),PKW(pB0,10),PKW(pB0,12),PKW(pB0,14)};pw2=(u32x4){PKW(pB1,0),PKW(pB1,2),PKW(pB1,4),PKW(pB1,6)};pw3=(u32x4){PKW(pB1,8),PKW(pB1,10),PKW(pB1,12),PKW(pB1,14)};
    SBAR(); pv(o,vb0+sl_cur,PAF(0),PAF(1),PAF(2),PAF(3)); }
  #undef PKW
  #undef PAF
  #undef VFR
  #undef PIN
  #undef MX3
  #undef GAPA
  #undef GAPB
  #undef EX
  #undef VRD
  #undef KRD
  #undef STEP
  #undef ENDW
  {auto rr=__builtin_amdgcn_permlane32_swap(__float_as_uint(l_reg),__float_as_uint(l_reg),false,false);l_reg=__uint_as_float(rr[0])+__uint_as_float(rr[1]);}
  if(hi==0)wsf[32+r32]=l_reg;asm volatile("s_waitcnt lgkmcnt(0)":::"memory");
  float rli[16];
  #pragma unroll
  for(int r=0;r<16;++r)rli[r]=__builtin_amdgcn_rcpf(wsf[32+crow(r,hi)]);
  bf16*Ow=O+(rowbase+q0+wid*QBLK)*DM+h*D;
  { bf16*stg=(bf16*)(shm+LDS_OST)+wid*2048;
    #pragma unroll
    for(int r=0;r<16;++r){const int orow=crow(r,hi);
      #pragma unroll
      for(int d0=0;d0<2;++d0)stg[orow*64+d0*32+r32]=__float2bfloat16(o[d0][r]*rli[r]);}
    asm volatile("s_waitcnt lgkmcnt(0)":::"memory");
    #pragma unroll
    for(int i=0;i<4;++i){const int row=i*8+(lane>>3),ch=lane&7; const u32x4 v=*(const u32x4*)(stg+row*64+ch*8); ATTN_STORE16(Ow+(long)row*DM+ch*8,v);} }
  asm volatile("s_waitcnt lgkmcnt(0)\n\ts_barrier":::"memory");
  #undef DMA_K
  #undef DMA_V
  #undef CMASK
  #undef START
  #undef RESC
  #undef ROT
}
constexpr int ATTN_LDS_BYTES=LDS_BYTES;
#undef SBAR
#undef WAIT_BAR
}

#define LAS __attribute__((address_space(3)))
typedef unsigned short bf16;
typedef unsigned v4u __attribute__((ext_vector_type(4)));
typedef unsigned v2u __attribute__((ext_vector_type(2)));
typedef float f32x4 __attribute__((ext_vector_type(4)));
typedef float f32x16 __attribute__((ext_vector_type(16)));
typedef short bf16x8 __attribute__((ext_vector_type(8)));
typedef short s16x4 __attribute__((ext_vector_type(4)));
constexpr float RMS_EPS = 1e-6f;
constexpr int NWAVES = 8, NTHREADS = 512;
constexpr int M = 16384, DM = 2048, SEQ = 2048, MEMROWS = 2048, BIGP = 8192;
constexpr size_t MiB = 1u << 20;
constexpr size_t WS_SMALL = 0;
constexpr size_t WS_W1 = 2 * MiB;
constexpr size_t WS_POOL = 18 * MiB;
constexpr size_t WS_WO0 = 20 * MiB, WS_WO1 = 28 * MiB;
constexpr size_t WS_W6 = 36 * MiB;
constexpr size_t WS_WF1 = 56 * MiB;
constexpr size_t WS_WF2 = 88 * MiB;
constexpr size_t WS_MKV = 120 * MiB;
constexpr size_t WS_XB = 128 * MiB;
constexpr size_t WS_BIG = 200 * MiB;
constexpr size_t WS_END = 456 * MiB;
constexpr int LDS_BYTES = 147456;

__device__ __forceinline__ unsigned f2bf(float f) { unsigned u = __builtin_bit_cast(unsigned, f); return (u + 0x7fffu + ((u >> 16) & 1u)) >> 16; }
__device__ __forceinline__ unsigned pk2(float lo, float hi) { return f2bf(lo) | (f2bf(hi) << 16); }
__device__ __forceinline__ float bflo(unsigned w) { return __builtin_bit_cast(float, w << 16); }
__device__ __forceinline__ float bfhi(unsigned w) { return __builtin_bit_cast(float, w & 0xffff0000u); }
#define LDS_WAIT() asm volatile("s_waitcnt lgkmcnt(0)" ::: "memory")
__device__ __forceinline__ float wave_sum(float v) {
#pragma unroll
    for (int o = 1; o < 64; o <<= 1) v += __shfl_xor(v, o);
    return v;
}

struct TJob { const float* W; int K, N; bf16* WT; int row_off; const float* kgain; const float* nscale; int kperm, sigma; };
__device__ __forceinline__ void transpose_item(const TJob& j, LAS float* scr, int item, int lane) {
    const int nblk = j.N / 32, kb = item / nblk, nb = item % nblk, k0 = 64 * kb, n0 = 32 * nb;
    const float ns = j.nscale ? j.nscale[n0 + (lane & 31)] : 1.0f;
#pragma unroll 8
    for (int i = 0; i < 32; ++i) { const int kk = 2 * i + (lane >> 5); float v = j.W[(size_t)(k0 + kk) * j.N + n0 + (lane & 31)];
        if (j.kgain) v *= j.kgain[k0 + kk];
        scr[kk * 33 + (lane & 31)] = v * ns; }
    LDS_WAIT(); asm volatile("" ::: "memory");
    const int c = lane & 7;
    const int kd = j.kperm ? ((k0 + 512) & 2047) : k0;
    int nd0 = n0;
    if (j.sigma) { const int tile = n0 >> 8, grp = (n0 & 255) >> 5; nd0 = tile * 256 + (4 * (grp & 1) + (grp >> 1)) * 32; }
#pragma unroll
    for (int jj = 0; jj < 4; ++jj) { const int n = (lane >> 3) + 8 * jj; const LAS float* s = scr + (8 * c) * 33 + n;
        v4u o; o.x = pk2(s[0 * 33], s[1 * 33]); o.y = pk2(s[2 * 33], s[3 * 33]); o.z = pk2(s[4 * 33], s[5 * 33]); o.w = pk2(s[6 * 33], s[7 * 33]);
        *(v4u*)(j.WT + (size_t)(j.row_off + nd0 + n) * j.K + kd + 8 * c) = o; }
    LDS_WAIT(); asm volatile("" ::: "memory");
}
__device__ __forceinline__ void run_tjob(const TJob& j, LAS float* scr, int gw, int NGW, int lane, int& cursor) {
    const int nitems = (j.K / 64) * (j.N / 32);
    int first = (gw - cursor % NGW + NGW) % NGW;
    for (int it = first; it < nitems; it += NGW) transpose_item(j, scr, it, lane);
    cursor += nitems;
}
__device__ __forceinline__ void row_to_bf16(const float* xrow, bf16* orow, float* rss, int lane) {
    const f32x4* xr = (const f32x4*)xrow + lane;
    f32x4 v[8]; float s = 0.f;
#pragma unroll
    for (int jx = 0; jx < 8; ++jx) { v[jx] = xr[64 * jx]; s += (v[jx].x * v[jx].x + v[jx].y * v[jx].y) + (v[jx].z * v[jx].z + v[jx].w * v[jx].w); }
    s = wave_sum(s);
    unsigned long long* o8 = (unsigned long long*)orow + lane;
#pragma unroll
    for (int jx = 0; jx < 8; ++jx) o8[64 * jx] = (unsigned long long)pk2(v[jx].x, v[jx].y) | ((unsigned long long)pk2(v[jx].z, v[jx].w) << 32);
    if (lane == 0) *rss = s;
}

constexpr int MA_KP = 272, MA_VP = 528;
constexpr int MA_K_OFF = 0, MA_V_OFF = 256 * MA_KP;
static_assert(MA_V_OFF + 128 * MA_VP <= 139264, "mem-attn LDS");
__device__ __forceinline__ void memattn_unit(bf16* qp, const bf16* kp, const bf16* vp, const float* qg, const float* kg, LAS unsigned char* lds, int wid, int lane) {
    __syncthreads();
    {
        const int c = lane & 15; f32x4 g0 = *(const f32x4*)(kg + 8 * c), g1 = *(const f32x4*)(kg + 8 * c + 4);
#pragma unroll 2
        for (int it = 0; it < 8; ++it) { const int r = it * 32 + wid * 4 + (lane >> 4);
            const v4u w = *(const v4u*)(kp + (size_t)r * 2048 + 8 * c);
            float f[8] ; f[0] = bflo(w.x); f[1] = bfhi(w.x); f[2] = bflo(w.y); f[3] = bfhi(w.y); f[4] = bflo(w.z); f[5] = bfhi(w.z); f[6] = bflo(w.w); f[7] = bfhi(w.w);
            float ss = 0.f;
#pragma unroll
            for (int e = 0; e < 8; ++e) ss += f[e] * f[e];
            ss += __shfl_xor(ss, 1); ss += __shfl_xor(ss, 2); ss += __shfl_xor(ss, 4); ss += __shfl_xor(ss, 8);
            const float rs = rsqrtf(ss * (1.0f / 128.0f) + RMS_EPS);
            v4u o; o.x = pk2(f[0] * rs * g0.x, f[1] * rs * g0.y); o.y = pk2(f[2] * rs * g0.z, f[3] * rs * g0.w); o.z = pk2(f[4] * rs * g1.x, f[5] * rs * g1.y); o.w = pk2(f[6] * rs * g1.z, f[7] * rs * g1.w);
            *(LAS v4u*)(lds + MA_K_OFF + r * MA_KP + 16 * c) = o; }
    }
    {
        const int kv = 64 * (wid & 3) + lane;
#pragma unroll 2
        for (int it = 0; it < 8; ++it) { const int c = 8 * (wid >> 2) + it;
            const v4u w = *(const v4u*)(vp + (size_t)kv * 2048 + 8 * c);
            LAS unsigned short* d = (LAS unsigned short*)(lds + MA_V_OFF + (8 * c) * MA_VP + 2 * kv);
            d[0 * (MA_VP / 2)] = (unsigned short)(w.x & 0xffffu); d[1 * (MA_VP / 2)] = (unsigned short)(w.x >> 16);
            d[2 * (MA_VP / 2)] = (unsigned short)(w.y & 0xffffu); d[3 * (MA_VP / 2)] = (unsigned short)(w.y >> 16);
            d[4 * (MA_VP / 2)] = (unsigned short)(w.z & 0xffffu); d[5 * (MA_VP / 2)] = (unsigned short)(w.z >> 16);
            d[6 * (MA_VP / 2)] = (unsigned short)(w.w & 0xffffu); d[7 * (MA_VP / 2)] = (unsigned short)(w.w >> 16); }
    }
    const int r32 = lane & 31, hh = lane >> 5;
    bf16* qrow = qp + (size_t)(wid * 32 + r32) * BIGP;
    bf16x8 qr[8];
    {
        v4u qw[8]; float ss = 0.f;
#pragma unroll
        for (int d0 = 0; d0 < 8; ++d0) { qw[d0] = *(const v4u*)(qrow + 16 * d0 + 8 * hh);
            const float a0 = bflo(qw[d0].x), a1 = bfhi(qw[d0].x), a2 = bflo(qw[d0].y), a3 = bfhi(qw[d0].y), a4 = bflo(qw[d0].z), a5 = bfhi(qw[d0].z), a6 = bflo(qw[d0].w), a7 = bfhi(qw[d0].w);
            ss += (a0 * a0 + a1 * a1) + (a2 * a2 + a3 * a3) + (a4 * a4 + a5 * a5) + (a6 * a6 + a7 * a7); }
        ss += __shfl_xor(ss, 32);
        const float rs = rsqrtf(ss * (1.0f / 128.0f) + RMS_EPS) * (0.08838834764831845f * 1.4426950408889634f);
#pragma unroll
        for (int d0 = 0; d0 < 8; ++d0) { const f32x4 g0 = *(const f32x4*)(qg + 16 * d0 + 8 * hh), g1 = *(const f32x4*)(qg + 16 * d0 + 8 * hh + 4);
            v4u o; o.x = pk2(bflo(qw[d0].x) * rs * g0.x, bfhi(qw[d0].x) * rs * g0.y); o.y = pk2(bflo(qw[d0].y) * rs * g0.z, bfhi(qw[d0].y) * rs * g0.w);
            o.z = pk2(bflo(qw[d0].z) * rs * g1.x, bfhi(qw[d0].z) * rs * g1.y); o.w = pk2(bflo(qw[d0].w) * rs * g1.z, bfhi(qw[d0].w) * rs * g1.w);
            qr[d0] = __builtin_bit_cast(bf16x8, o); }
    }
    __syncthreads();
    f32x16 o[4]; o[0] = f32x16{}; o[1] = f32x16{}; o[2] = f32x16{}; o[3] = f32x16{};
    float lsum = 0.f;
    const LAS unsigned char* kbase = lds + MA_K_OFF + r32 * MA_KP + 16 * hh;
    const LAS unsigned char* vbase = lds + MA_V_OFF + r32 * MA_VP + 8 * hh;
#pragma unroll 1
    for (int kb = 0; kb < 8; ++kb) {
        f32x16 x = f32x16{};
#pragma unroll
        for (int d0 = 0; d0 < 8; ++d0) { const bf16x8 kf = *(const LAS bf16x8*)(kbase + kb * 32 * MA_KP + 32 * d0);
            x = __builtin_amdgcn_mfma_f32_32x32x16_bf16(kf, qr[d0], x, 0, 0, 0); }
        float sacc = 0.f;
#pragma unroll
        for (int r = 0; r < 16; ++r) { x[r] = __builtin_amdgcn_exp2f(x[r]); sacc += x[r]; }
        lsum += sacc;
        v4u pw0, pw1;
        pw0.x = pk2(x[0], x[1]); pw0.y = pk2(x[2], x[3]); pw0.z = pk2(x[4], x[5]); pw0.w = pk2(x[6], x[7]);
        pw1.x = pk2(x[8], x[9]); pw1.y = pk2(x[10], x[11]); pw1.z = pk2(x[12], x[13]); pw1.w = pk2(x[14], x[15]);
        const bf16x8 p0 = __builtin_bit_cast(bf16x8, pw0), p1 = __builtin_bit_cast(bf16x8, pw1);
#pragma unroll
        for (int db = 0; db < 4; ++db) {
            const LAS unsigned char* vb = vbase + db * 32 * MA_VP + kb * 64;
            const v2u a0 = *(const LAS v2u*)(vb), a1 = *(const LAS v2u*)(vb + 16), b0 = *(const LAS v2u*)(vb + 32), b1 = *(const LAS v2u*)(vb + 48);
            v4u f0; f0.x = a0.x; f0.y = a0.y; f0.z = a1.x; f0.w = a1.y;
            v4u f1; f1.x = b0.x; f1.y = b0.y; f1.z = b1.x; f1.w = b1.y;
            o[db] = __builtin_amdgcn_mfma_f32_32x32x16_bf16(__builtin_bit_cast(bf16x8, f0), p0, o[db], 0, 0, 0);
            o[db] = __builtin_amdgcn_mfma_f32_32x32x16_bf16(__builtin_bit_cast(bf16x8, f1), p1, o[db], 0, 0, 0);
        }
    }
    lsum += __shfl_xor(lsum, 32);
    const float rl = 1.0f / lsum;
#pragma unroll
    for (int db = 0; db < 4; ++db)
#pragma unroll
        for (int g = 0; g < 4; ++g) { v2u w; w.x = pk2(o[db][4 * g] * rl, o[db][4 * g + 1] * rl); w.y = pk2(o[db][4 * g + 2] * rl, o[db][4 * g + 3] * rl);
            *(v2u*)(qrow + 32 * db + 8 * g + 4 * hh) = w; }
}
#ifdef DBGCHK
__device__ __forceinline__ float bf2f(bf16 v) { return __builtin_bit_cast(float, (unsigned)v << 16); }
__device__ __forceinline__ unsigned hsh(unsigned s, unsigned k) { unsigned h = s * 2654435761u + k * 40503u + 12345u; h ^= h >> 13; h *= 2246822519u; h ^= h >> 16; return h; }
__device__ __forceinline__ void chk(unsigned* flag, int stage, float got, float want, float tol) { if (!(fabsf(got - want) <= tol * (fabsf(want) + 1.0f))) atomicMin(flag, (unsigned)stage); }
__device__ __forceinline__ float row_rstd(const float* xr, int lane) { float s = 0.f; for (int k = lane; k < 2048; k += 64) s += xr[k] * xr[k]; s = wave_sum(s); return rsqrtf(s * (1.0f / 2048.0f) + RMS_EPS); }
__device__ __forceinline__ float row_dot(const float* xr, const float* g, const float* W, int ldw, int col, int lane) { float s = 0.f; for (int k = lane; k < 2048; k += 64) s += xr[k] * (g ? g[k] : 1.0f) * W[(size_t)k * ldw + col]; return wave_sum(s); }
__device__ __forceinline__ void chk_memattn(unsigned* flag, int stage, const float* xr, const float* g, const float* W, int ldw, int wcol, const bf16* kp, const bf16* vp, const float* qg, const float* kg, const bf16* got, LAS float* scr, int lane) {
    const float rs = row_rstd(xr, lane);
    for (int d = 0; d < 128; ++d) { const float v = row_dot(xr, g, W, ldw, wcol + d, lane) * rs; if (lane == 0) scr[d] = v; }
    LDS_WAIT();
    float ss = 0.f; for (int d = 0; d < 128; ++d) ss += scr[d] * scr[d];
    const float qr = rsqrtf(ss * (1.0f / 128.0f) + RMS_EPS);
    float sc[4], mx = -1e30f;
#pragma unroll
    for (int i = 0; i < 4; ++i) { const int j = lane + 64 * i; float ks = 0.f; for (int d = 0; d < 128; ++d) { const float kv = bf2f(kp[(size_t)j * 2048 + d]); ks += kv * kv; }
        const float kr = rsqrtf(ks * (1.0f / 128.0f) + RMS_EPS); float s = 0.f;
        for (int d = 0; d < 128; ++d) s += scr[d] * qr * qg[d] * bf2f(kp[(size_t)j * 2048 + d]) * kr * kg[d];
        sc[i] = s * 0.08838834764831845f; mx = fmaxf(mx, sc[i]); }
    for (int o = 1; o < 64; o <<= 1) mx = fmaxf(mx, __shfl_xor(mx, o));
    float l = 0.f;
#pragma unroll
    for (int i = 0; i < 4; ++i) { sc[i] = expf(sc[i] - mx); l += sc[i]; }
    l = wave_sum(l);
#pragma unroll
    for (int i = 0; i < 4; ++i) scr[128 + lane + 64 * i] = sc[i] / l;
    LDS_WAIT();
    for (int dd = 0; dd < 2; ++dd) { const int d = lane + 64 * dd; float o = 0.f; for (int j = 0; j < 256; ++j) o += scr[128 + j] * bf2f(vp[(size_t)j * 2048 + d]);
        chk(flag, stage, bf2f(got[d]), o, 0.05f); }
    LDS_WAIT();
}
__device__ __forceinline__ float naive_diff(const bf16* big, int row, int qcol, int kcol, int vcol, LAS float* scr, int lane) {
    const int b = row >> 11, t = row & 2047; const bf16* q = big + (size_t)row * BIGP + qcol;
    float mx = -1e30f;
    for (int j = lane; j <= t; j += 64) { const bf16* k = big + (size_t)(b * 2048 + j) * BIGP + kcol; float s = 0.f; for (int d = 0; d < 64; ++d) s += bf2f(q[d]) * bf2f(k[d]); scr[j] = s; mx = fmaxf(mx, s); }
    for (int o = 1; o < 64; o <<= 1) mx = fmaxf(mx, __shfl_xor(mx, o));
    float l = 0.f; for (int j = lane; j <= t; j += 64) { const float p = exp2f(scr[j] - mx); scr[j] = p; l += p; } l = wave_sum(l);
    LDS_WAIT();
    float o = 0.f; for (int j = 0; j <= t; ++j) o += scr[j] * bf2f(big[(size_t)(b * 2048 + j) * BIGP + vcol + lane]);
    LDS_WAIT();
    return o / l;
}
#endif
struct DiffUnit { int row, qb; };
__device__ __forceinline__ bool diff_next(int vcu, int G, int i, DiffUnit& u) {
    const int rep = i / 12, k = i - rep * 12; const int p = (vcu >> 1) + rep * (G >> 1); if (p >= 128) return false;
    const int role = vcu & 1;
    if (k < 8) { u.row = 3 * p + role; u.qb = 7 - k; }
    else { const int jx = k - 8; u.row = 3 * p + 2; u.qb = role == 0 ? ((jx & 1) ? (jx >> 1) : 7 - (jx >> 1)) : ((jx & 1) ? 2 + (jx >> 1) : 5 - (jx >> 1)); }
    return true;
}

struct Args { const float* in[20]; float* out; unsigned char* ws; int ph_lo, ph_hi; };

__global__ void __launch_bounds__(NTHREADS, 2) mega_fwd(Args args) {
    extern __shared__ __attribute__((aligned(16))) unsigned char lds_raw[];
    LAS unsigned char* lds = (LAS unsigned char*)lds_raw;
    cg::grid_group grid = cg::this_grid();
#define TIDS() int tid_ = threadIdx.x; asm volatile("" : "+v"(tid_)); const int tid = tid_, lane = tid & 63, wid = __builtin_amdgcn_readfirstlane(tid >> 6); \
    int bx_ = blockIdx.x; asm volatile("" : "+s"(bx_)); const int bx = bx_, G = gridDim.x, vcu = (G % 8 == 0) ? (bx % 8) * (G / 8) + bx / 8 : bx, gw = vcu * NWAVES + wid, NGW = G * NWAVES; \
    LAS float* scr = (LAS float*)(lds + wid * 16384); (void)tid; (void)lane; (void)gw; (void)NGW; (void)scr; (void)vcu
    typedef const __attribute__((address_space(4))) Args* kargp_t;
#define KARG() kargp_t ap = (kargp_t)__builtin_amdgcn_kernarg_segment_ptr(); asm volatile("" : "+s"(ap)); unsigned char* ws = ap->ws; (void)ws
#define INP(k) (ap->in[k])
#define WSP(T, off) ((T*)(ws + (off)))
#define lamp WSP(float, WS_SMALL)
#define rss0 WSP(float, WS_SMALL + 65536)
#define rss1 WSP(float, WS_SMALL + 196608)
#define rss2 WSP(float, WS_SMALL + 262144)
#define rss3 WSP(float, WS_SMALL + 327680)
#define rope WSP(float, WS_SMALL + 524288)
#define W1 WSP(bf16, WS_W1)
#define WPOOL WSP(bf16, WS_POOL)
#define WO0 WSP(bf16, WS_WO0)
#define WO1 WSP(bf16, WS_WO1)
#define W6 WSP(bf16, WS_W6)
#define WF1 WSP(bf16, WS_WF1)
#define WF2 WSP(bf16, WS_WF2)
#define MKV WSP(bf16, WS_MKV)
#define XB WSP(bf16, WS_XB)
#define BIG WSP(bf16, WS_BIG)
#define DFLAG WSP(unsigned, WS_SMALL + 1024)
#define x_in INP(0)
#define mem_in INP(1)
#define mix_norm INP(2)
#define w_in INP(3)
#define w_out INP(4)
#define mem_norm INP(5)
#define w_mem_kv INP(6)
#define mem_q_norm INP(7)
#define mem_k_norm INP(8)
#define ffn_norm INP(9)
#define w_ff1 INP(10)
#define w_ff2 INP(11)
#define pool_w INP(12)
#define pool_scale INP(13)
#define kv_norm INP(14)
#define w_kv INP(15)
#define k_norm INP(16)
#define q_norm INP(17)
#define diff_lambda INP(18)
#define subln_norm INP(19)
#define out_p (ap->out)
#define IN(k) true
#define GSYNC() do { asm volatile("s_waitcnt vmcnt(0) lgkmcnt(0)" ::: "memory"); grid.sync(); asm volatile("buffer_inv sc1\n\ts_waitcnt vmcnt(0)" ::: "memory"); } while (0)
#define SEAM(k) do { if (IN(k) && IN((k) + 1)) GSYNC(); } while (0)

    if (IN(0)) {
        KARG(); TIDS();
        int cursor = 0;
        { TJob j{w_in, 2048, 2048, W1, 0, mix_norm, nullptr, 0, 0}; run_tjob(j, scr, gw, NGW, lane, cursor); }
        { TJob j{w_mem_kv, 2048, 1024, W1, 2048, mem_norm, nullptr, 0, 0}; run_tjob(j, scr, gw, NGW, lane, cursor); }
        { TJob j{w_mem_kv + (size_t)2048 * 1024, 2048, 1024, W1, 3072, mem_norm + 2048, nullptr, 0, 0}; run_tjob(j, scr, gw, NGW, lane, cursor); }
#pragma unroll 1
        for (int g = 0; g < 4; ++g) { TJob j{pool_w + (size_t)g * 384 * 384, 384, 384, WPOOL, g * 512, nullptr, pool_scale + g * 384, 0, 0}; run_tjob(j, scr, gw, NGW, lane, cursor); }
        { TJob j{w_out, 2048, 2048, WO0, 0, nullptr, nullptr, 1, 0}; run_tjob(j, scr, gw, NGW, lane, cursor); }
        { TJob j{w_out + (size_t)2048 * 2048, 2048, 2048, WO1, 0, nullptr, nullptr, 1, 0}; run_tjob(j, scr, gw, NGW, lane, cursor); }
        { TJob j{w_kv, 2048, 3072, W6, 0, kv_norm, nullptr, 0, 1}; run_tjob(j, scr, gw, NGW, lane, cursor); }
        { TJob j{w_in + (size_t)2048 * 2048, 2048, 2048, W6, 3072, mix_norm + 2048, nullptr, 0, 1}; run_tjob(j, scr, gw, NGW, lane, cursor); }
        { TJob j{w_ff1, 2048, 8192, WF1, 0, ffn_norm, nullptr, 0, 0}; run_tjob(j, scr, gw, NGW, lane, cursor); }
        { TJob j{w_ff2, 8192, 2048, WF2, 0, nullptr, nullptr, 0, 0}; run_tjob(j, scr, gw, NGW, lane, cursor); }
        for (int i = gw * 64 + lane; i < 4 * 128 * 384 / 8; i += NGW * 64) { const int g = i / (128 * 48), r = i % (128 * 48); *(v4u*)(WPOOL + (size_t)(g * 512 + 384) * 384 + (size_t)r * 8) = (v4u){0u, 0u, 0u, 0u}; }
        for (int m = gw; m < M + MEMROWS; m += NGW) row_to_bf16(m < M ? x_in + (size_t)m * DM : mem_in + (size_t)(m - M) * DM, XB + (size_t)m * DM, rss0 + m, lane);
        for (int i = gw * 64 + lane; i < 3 * 16384; i += NGW * 64) rss1[i] = 0.f;
        for (int i = gw * 64 + lane; i < 2048 * 8; i += NGW * 64) { const int pos = i >> 3, fi = i & 7;
            const double invf = fi == 0 ? 1.0 : fi == 1 ? 0.19392274474868576 : fi == 2 ? 0.03760603093086393 : fi == 3 ? 0.007292664737217109 : fi == 4 ? 0.001414213562373095 : fi == 5 ? 0.0002742481756762073 : fi == 6 ? 5.318295896944988e-05 : 1.031338537721246e-05;
            double rev = (double)pos * invf * 0.15915494309189535; rev -= __builtin_rint(rev);
            rope[pos * 16 + fi] = __builtin_amdgcn_cosf((float)rev); rope[pos * 16 + 8 + fi] = __builtin_amdgcn_sinf((float)rev); }
#ifdef DBGCHK
        if (gw == 0 && lane == 0) DFLAG[0] = 0xffffffffu;
#endif
        if (gw == 0) { float a = diff_lambda[lane] * diff_lambda[64 + lane], b = diff_lambda[128 + lane] * diff_lambda[192 + lane]; a = wave_sum(a); b = wave_sum(b);
            if (lane == 0) lamp[0] = expf(a) - expf(b) + 0.35550906759096934f; }
    }
    SEAM(0);
    if (IN(1)) {
        KARG(); TIDS();
        pg8::GemmX g{XB, W1, M + MEMROWS, 4096, 2048, 2048, 2048}; pg8::SchedP1 S; S.init(G, bx);
        pg8::EpiP1 E{BIG, MKV, rss0};
        pg8::gemm_phase<pg8::EpiP1, pg8::SchedP1, true, true>(lds, g, S, E);
    }
    SEAM(1);
#ifdef DBGCHK
    { KARG(); TIDS(); if (gw < 64) { const int s_ = gw; (void)s_;
        { const int row = hsh(s_, 1) % 16384, col = hsh(s_, 2) % 2048; const float* xr = x_in + (size_t)row * 2048;
          const float want = row_dot(xr, mix_norm, w_in, 2048, col, lane) * row_rstd(xr, lane);
          chk(DFLAG, 1, bf2f(BIG[(size_t)row * BIGP + (col < 1536 ? col : 3072 + col - 1536)]), want, 0.03f); }
        { const int mrow = hsh(s_, 3) % 2048, mcol = hsh(s_, 4) % 2048, layer = mcol >> 10; const float* xr = mem_in + (size_t)mrow * 2048;
          const float want = row_dot(xr, mem_norm + layer * 2048, w_mem_kv + (size_t)layer * 2048 * 1024, 1024, mcol & 1023, lane) * row_rstd(xr, lane);
          chk(DFLAG, 2, bf2f(MKV[(size_t)mrow * 2048 + mcol]), want, 0.03f); }
    } GSYNC(); }
#endif

    if (IN(2)) {
        KARG(); TIDS();
        for (int it = gw; it < 3072; it += NGW) {
            const int span = it % 3, rb = it / 3, m0 = rb * 16, t0 = m0 & 2047;
            const int col = span * 512 + lane * 8; const int w = 2 << (col / 384);
            const bf16* src = BIG + (size_t)m0 * BIGP + col; bf16* dst = BIG + (size_t)m0 * BIGP + 1536 + col;
            float s[8];
#pragma unroll
            for (int e = 0; e < 8; ++e) s[e] = 0.f;
            if (t0 > 0) {
#pragma unroll 1
                for (int jx = 1; jx <= 16; ++jx) if (jx <= w) {     const v4u q = *(const v4u*)(src - (size_t)jx * BIGP);
                    s[0] += bflo(q.x); s[1] += bfhi(q.x); s[2] += bflo(q.y); s[3] += bfhi(q.y); s[4] += bflo(q.z); s[5] += bfhi(q.z); s[6] += bflo(q.w); s[7] += bfhi(q.w); }
            }
#pragma unroll 1
            for (int r = 0; r < 16; ++r) { const int t = t0 + r; const v4u q = *(const v4u*)(src + (size_t)r * BIGP);
                float c[8]; c[0] = bflo(q.x); c[1] = bfhi(q.x); c[2] = bflo(q.y); c[3] = bfhi(q.y); c[4] = bflo(q.z); c[5] = bfhi(q.z); c[6] = bflo(q.w); c[7] = bfhi(q.w);
#pragma unroll
                for (int e = 0; e < 8; ++e) s[e] += c[e];
                if (t >= w) { const v4u p = *(const v4u*)(src + (size_t)(r - w) * BIGP);
                    s[0] -= bflo(p.x); s[1] -= bfhi(p.x); s[2] -= bflo(p.y); s[3] -= bfhi(p.y); s[4] -= bflo(p.z); s[5] -= bfhi(p.z); s[6] -= bflo(p.w); s[7] -= bfhi(p.w); }
                const float ic = 1.0f / (float)((t + 1) < w ? (t + 1) : w);
                v4u o; o.x = pk2(s[0] * ic - c[0], s[1] * ic - c[1]); o.y = pk2(s[2] * ic - c[2], s[3] * ic - c[3]); o.z = pk2(s[4] * ic - c[4], s[5] * ic - c[5]); o.w = pk2(s[6] * ic - c[6], s[7] * ic - c[7]);
                *(v4u*)(dst + (size_t)r * BIGP) = o; }
        }
        for (int u = vcu; u < 256; u += G) { const int b = u >> 5, h = (u >> 3) & 3, qb = u & 7;
            memattn_unit(BIG + (size_t)(b * SEQ + qb * 256) * BIGP + 3072 + 128 * h, MKV + (size_t)(b * 256) * 2048 + 128 * h, MKV + (size_t)(b * 256) * 2048 + 512 + 128 * h, mem_q_norm, mem_k_norm, lds, wid, lane); }
        __syncthreads();
    }
    SEAM(2);
#ifdef DBGCHK
    { KARG(); TIDS(); if (gw < 64) { const int s_ = gw; (void)s_;
        { const int row = hsh(s_, 5) % 16384, col = hsh(s_, 6) % 1536, w = 2 << (col / 384), t = row & 2047; float sum = 0.f; const int n = (t + 1) < w ? (t + 1) : w;
          for (int j = 0; j < n; ++j) sum += bf2f(BIG[(size_t)(row - j) * BIGP + col]);
          const float want = sum / (float)n - bf2f(BIG[(size_t)row * BIGP + col]);
          chk(DFLAG, 3, bf2f(BIG[(size_t)row * BIGP + 1536 + col]), want, 0.03f); }
        if (s_ < 16) { const int row = hsh(s_, 7) % 16384, h = s_ & 3, b = row >> 11;
          chk_memattn(DFLAG, 4, x_in + (size_t)row * 2048, mix_norm, w_in, 2048, 1536 + 128 * h, MKV + (size_t)(b * 256) * 2048 + 128 * h, MKV + (size_t)(b * 256) * 2048 + 512 + 128 * h,
                      mem_q_norm, mem_k_norm, BIG + (size_t)row * BIGP + 3072 + 128 * h, scr, lane); }
    } GSYNC(); }
#endif

    if (IN(3)) {
        KARG(); TIDS();
        pg8::GemmX g{BIG + 1536, WPOOL, M, 2048, 384, BIGP, 384}; pg8::SchedPool S; S.init(G, bx);
        pg8::EpiPool E{BIG};
        pg8::gemm_phase<pg8::EpiPool, pg8::SchedPool, true, true>(lds, g, S, E);
    }
    SEAM(3);
#ifdef DBGCHK
    { KARG(); TIDS(); if (gw < 64) { const int s_ = gw; (void)s_;
        { const int row = hsh(s_, 8) % 16384, col = hsh(s_, 9) % 1536, g = col / 384, d = col % 384; float sum = 0.f;
          for (int c = lane; c < 384; c += 64) sum += bf2f(BIG[(size_t)row * BIGP + 1536 + 384 * g + c]) * pool_w[((size_t)g * 384 + c) * 384 + d];
          const float want = wave_sum(sum) * pool_scale[col];
          chk(DFLAG, 5, bf2f(BIG[(size_t)row * BIGP + 3584 + col]), want, 0.03f); }
    } GSYNC(); }
#endif

#pragma unroll 1
    for (int layer = 0; layer < 2; ++layer) {
        const int pb = 4 + layer * 10;
        if (layer == 1) {
            if (IN(11)) {
                KARG(); TIDS();
                pg8::GemmX g{XB, W6, M, 5120, 2048, 2048, 2048}; pg8::SchedStd S; S.init(M, 5120, G, bx);
                pg8::EpiP6 E{BIG, rss2, k_norm, q_norm, rope};
                pg8::gemm_phase<pg8::EpiP6, pg8::SchedStd, true, true>(lds, g, S, E);
            }
            SEAM(11);
#ifdef DBGCHK
            { KARG(); TIDS(); if (gw < 64) { const int s_ = gw;
              const int row = hsh(s_, 14) % 16384, hh = hsh(s_, 15) % 12, kind = s_ & 3; const float* xr = out_p + (size_t)row * 2048; const float rs = row_rstd(xr, lane);
              const float* Wp = kind == 2 ? w_in + (size_t)2048 * 2048 : w_kv; const float* gp = kind == 2 ? mix_norm + 2048 : kv_norm; const int ldw = kind == 2 ? 2048 : 3072;
              const int wcol = (kind == 0 ? 0 : kind == 1 ? 768 : kind == 2 ? 768 : 1536) + hh * 64; const int bcol = (kind == 0 ? 0 : kind == 1 ? 768 : kind == 2 ? 3840 : 1536) + hh * 64;
              for (int d = 0; d < 64; ++d) { const float v = row_dot(xr, gp, Wp, ldw, wcol + d, lane) * rs; if (lane == 0) scr[d] = v; }
              LDS_WAIT();
              float y = scr[lane];
              if (kind != 3) { float ss = 0.f; for (int d = 0; d < 64; ++d) ss += scr[d] * scr[d]; const float r = rsqrtf(ss * (1.0f / 64.0f) + RMS_EPS);
                y = y * r * (kind == 2 ? q_norm[lane] * (0.125f * 1.4426950408889634f) : k_norm[lane]); scr[64 + lane] = y; LDS_WAIT();
                if (lane < 16) { const int i = lane & 7; const float c = rope[(size_t)(row & 2047) * 16 + i], sn = rope[(size_t)(row & 2047) * 16 + 8 + i];
                  y = lane < 8 ? scr[64 + lane] * c - scr[64 + lane + 8] * sn : scr[64 + lane - 8] * sn + scr[64 + lane] * c; } }
              chk(DFLAG, 9, bf2f(BIG[(size_t)row * BIGP + bcol + lane]), y, 0.03f);
              LDS_WAIT();
            } GSYNC(); }
#endif

            if (IN(12)) {
                KARG(); TIDS();
                DiffUnit du;
                for (int i = 0; diff_next(vcu, G, i, du); ++i) {
                    const int b = du.row / 48, vh = du.row % 48, h = vh >> 2, map = (vh >> 1) & 1, half = vh & 1;
                    attn_body::attn_unit<8>(b, 0, du.qb, (const attn_body::bf16*)(BIG + 3072 + map * 768 + h * 64), (const attn_body::bf16*)(BIG + map * 768 + h * 64),
                                            (const attn_body::bf16*)(BIG + 1536 + h * 128 + half * 64), (attn_body::bf16*)(BIG + 5120 + map * 1536 + h * 128 + half * 64), (char*)lds_raw);
                }
                for (int u = vcu; u < 256; u += G) { const int b = u >> 5, h = (u >> 3) & 3, qb = u & 7;
                    memattn_unit(BIG + (size_t)(b * SEQ + qb * 256) * BIGP + 4608 + 128 * h, MKV + (size_t)(b * 256) * 2048 + 1024 + 128 * h, MKV + (size_t)(b * 256) * 2048 + 1536 + 128 * h,
                                 mem_q_norm + 128, mem_k_norm + 128, lds, wid, lane); }
                __syncthreads();
            }
            SEAM(12);
#ifdef DBGCHK
            { KARG(); TIDS(); if (gw < 64) { const int s_ = gw;
              { const int row = hsh(s_, 16) % 16384, hh = hsh(s_, 17) % 12, map = s_ & 1, half = (s_ >> 1) & 1;
                const float o = naive_diff(BIG, row, 3072 + map * 768 + hh * 64, map * 768 + hh * 64, 1536 + hh * 128 + half * 64, scr, lane);
                chk(DFLAG, 10, bf2f(BIG[(size_t)row * BIGP + 5120 + map * 1536 + hh * 128 + half * 64 + lane]), o, 0.03f); }
              if (s_ < 16) { const int row = hsh(s_, 18) % 16384, h = s_ & 3, b = row >> 11;
                chk_memattn(DFLAG, 11, out_p + (size_t)row * 2048, mix_norm + 2048, w_in + (size_t)2048 * 2048, 2048, 1536 + 128 * h, MKV + (size_t)(b * 256) * 2048 + 1024 + 128 * h, MKV + (size_t)(b * 256) * 2048 + 1536 + 128 * h,
                            mem_q_norm + 128, mem_k_norm + 128, BIG + (size_t)row * BIGP + 4608 + 128 * h, scr, lane); }
            } GSYNC(); }
#endif

            if (IN(13)) {
                KARG(); TIDS();
                const float lam = lamp[0]; const int sub = lane >> 4, c = lane & 15;
                const f32x4 g0 = *(const f32x4*)(subln_norm + 8 * c) * (1.0f - 0.35550906759096934f), g1 = *(const f32x4*)(subln_norm + 8 * c + 4) * (1.0f - 0.35550906759096934f);
                for (int idx = gw * 4 + sub; idx < M * 12; idx += NGW * 4) { const int row = idx / 12, h = idx - row * 12;
                    bf16* pa = BIG + (size_t)row * BIGP + 5120 + h * 128 + 8 * c;
                    const v4u a = *(const v4u*)pa, bq = *(const v4u*)(pa + 1536);
                    float f[8]; f[0] = bflo(a.x) - lam * bflo(bq.x); f[1] = bfhi(a.x) - lam * bfhi(bq.x); f[2] = bflo(a.y) - lam * bflo(bq.y); f[3] = bfhi(a.y) - lam * bfhi(bq.y);
                    f[4] = bflo(a.z) - lam * bflo(bq.z); f[5] = bfhi(a.z) - lam * bfhi(bq.z); f[6] = bflo(a.w) - lam * bflo(bq.w); f[7] = bfhi(a.w) - lam * bfhi(bq.w);
                    float ss = 0.f;
#pragma unroll
                    for (int e = 0; e < 8; ++e) ss += f[e] * f[e];
                    ss += __shfl_xor(ss, 1); ss += __shfl_xor(ss, 2); ss += __shfl_xor(ss, 4); ss += __shfl_xor(ss, 8);
                    const float rs = rsqrtf(ss * (1.0f / 128.0f) + RMS_EPS);
                    v4u o; o.x = pk2(f[0] * rs * g0.x, f[1] * rs * g0.y); o.y = pk2(f[2] * rs * g0.z, f[3] * rs * g0.w); o.z = pk2(f[4] * rs * g1.x, f[5] * rs * g1.y); o.w = pk2(f[6] * rs * g1.z, f[7] * rs * g1.w);
                    *(v4u*)pa = o; }
                int cursor = 0;
                { TJob j{w_ff1 + (size_t)2048 * 8192, 2048, 8192, WF1, 0, ffn_norm + 2048, nullptr, 0, 0}; run_tjob(j, scr, gw, NGW, lane, cursor); }
                { TJob j{w_ff2 + (size_t)8192 * 2048, 8192, 2048, WF2, 0, nullptr, nullptr, 0, 0}; run_tjob(j, scr, gw, NGW, lane, cursor); }
            }
            SEAM(13);
#ifdef DBGCHK
            { KARG(); TIDS(); if (gw < 64) { const int s_ = gw;
              const int row = hsh(s_, 19) % 16384, hh = hsh(s_, 20) % 12;
              float la = 0.f, lb = 0.f; for (int i = 0; i < 64; ++i) { la += diff_lambda[i] * diff_lambda[64 + i]; lb += diff_lambda[128 + i] * diff_lambda[192 + i]; }
              const float lam = expf(la) - expf(lb) + 0.35550906759096934f; chk(DFLAG, 13, lamp[0], lam, 0.001f);
              const float a0 = naive_diff(BIG, row, 3072 + hh * 64, hh * 64, 1536 + hh * 128, scr, lane) - lam * naive_diff(BIG, row, 3840 + hh * 64, 768 + hh * 64, 1536 + hh * 128, scr, lane);
              const float a1 = naive_diff(BIG, row, 3072 + hh * 64, hh * 64, 1536 + hh * 128 + 64, scr, lane) - lam * naive_diff(BIG, row, 3840 + hh * 64, 768 + hh * 64, 1536 + hh * 128 + 64, scr, lane);
              const float r = rsqrtf(wave_sum(a0 * a0 + a1 * a1) * (1.0f / 128.0f) + RMS_EPS);
              chk(DFLAG, 12, bf2f(BIG[(size_t)row * BIGP + 5120 + hh * 128 + lane]), a0 * r * subln_norm[lane] * (1.0f - 0.35550906759096934f), 0.03f);
              chk(DFLAG, 12, bf2f(BIG[(size_t)row * BIGP + 5120 + hh * 128 + 64 + lane]), a1 * r * subln_norm[64 + lane] * (1.0f - 0.35550906759096934f), 0.03f);
            } GSYNC(); }
#endif

        }
        if (IN(pb)) {
            KARG(); TIDS();
            pg8::GemmX g{BIG + (layer == 0 ? 3072 : 4608), layer == 0 ? WO0 : WO1, M, 2048, 2048, BIGP, 2048}; pg8::SchedStd S; S.init(M, 2048, G, bx);
            pg8::EpiResid E{layer == 0 ? x_in : out_p, out_p, XB, layer == 0 ? rss1 : rss3};
            pg8::gemm_phase<pg8::EpiResid, pg8::SchedStd, true, true>(lds, g, S, E);
        }
        SEAM(pb);
#ifdef DBGCHK
        if (layer == 0) { KARG(); TIDS(); if (gw < 64) { const int s_ = gw;
          const int row = hsh(s_, 10) % 16384, col = hsh(s_, 11) % 2048; float sum = 0.f;
          for (int k = lane; k < 2048; k += 64) sum += bf2f(BIG[(size_t)row * BIGP + (k < 1536 ? 3584 + k : 3072 + k - 1536)]) * w_out[(size_t)k * 2048 + col];
          const float want = x_in[(size_t)row * 2048 + col] + wave_sum(sum);
          chk(DFLAG, 6, out_p[(size_t)row * 2048 + col], want, 0.01f);
          chk(DFLAG, 7, bf2f(XB[(size_t)row * 2048 + col]), out_p[(size_t)row * 2048 + col], 0.01f);
          const float r1 = row_rstd(out_p + (size_t)row * 2048, lane); chk(DFLAG, 7, pg8::rstd2048(rss1, row), r1, 0.001f);
        } GSYNC(); }
#endif

        if (IN(pb + 1)) {
            KARG(); TIDS();
            pg8::GemmX g{XB, WF1, M, 8192, 2048, 2048, 2048}; pg8::SchedStd S; S.init(M, 8192, G, bx);
            pg8::EpiRelu2 E{BIG, layer == 0 ? rss1 : rss3};
            pg8::gemm_phase<pg8::EpiRelu2, pg8::SchedStd, true, true>(lds, g, S, E);
        }
        SEAM(pb + 1);
#ifdef DBGCHK
        { KARG(); TIDS(); if (gw < 64) { const int s_ = gw;
          const int row = hsh(s_, 12) % 16384, col = hsh(s_, 13) % 8192; const float* xr = out_p + (size_t)row * 2048;
          float v = row_dot(xr, ffn_norm + layer * 2048, w_ff1 + (size_t)layer * 2048 * 8192, 8192, col, lane) * row_rstd(xr, lane); v = fmaxf(v, 0.f); v *= v;
          chk(DFLAG, layer == 0 ? 8 : 15, bf2f(BIG[(size_t)row * BIGP + col]), v, 0.03f);
        } GSYNC(); }
#endif

        if (IN(pb + 2)) {
            KARG(); TIDS();
            pg8::GemmX g{BIG, WF2, M, 2048, 8192, BIGP, 8192}; pg8::SchedStd S; S.init(M, 2048, G, bx);
            pg8::EpiResid E{out_p, out_p, layer == 0 ? XB : nullptr, layer == 0 ? rss2 : nullptr};
            pg8::gemm_phase<pg8::EpiResid, pg8::SchedStd, true, true>(lds, g, S, E);
        }
        if (layer == 0) { if (IN(6) && IN(11)) GSYNC(); }
    }
#ifdef DBGCHK
    { GSYNC(); KARG(); if (blockIdx.x == 0 && threadIdx.x == 0) { const unsigned f = DFLAG[0]; if (f != 0xffffffffu) out_p[0] = 100.0f * (float)f; } }
#endif
#undef IN
#undef SEAM
#undef rope
#undef lamp
}

extern "C" void kernel_launch(void* const* d_in, const int* in_sizes, int n_in, void* d_out, int out_size, void* d_ws, size_t ws_size, hipStream_t stream) {
    static int grid = 0;
    if (grid == 0) {
        if (n_in != 20 || out_size != M * DM || ws_size < WS_END) { fprintf(stderr, "kernel_launch: unexpected shapes (n_in %d out %d ws %zu)\n", n_in, out_size, ws_size); grid = -1; return; }
        int dev = 0, cus = 0, per_cu = 0;
        (void)hipGetDevice(&dev); (void)hipDeviceGetAttribute(&cus, hipDeviceAttributeMultiprocessorCount, dev);
        if (hipFuncSetAttribute((const void*)mega_fwd, hipFuncAttributeMaxDynamicSharedMemorySize, LDS_BYTES) != hipSuccess) { fprintf(stderr, "kernel_launch: hipFuncSetAttribute failed\n"); grid = -1; return; }
        (void)hipOccupancyMaxActiveBlocksPerMultiprocessor(&per_cu, (const void*)mega_fwd, NTHREADS, LDS_BYTES);
        (void)hipGetLastError();
        if (per_cu < 1) { fprintf(stderr, "kernel_launch: occupancy query says %d blocks per CU\n", per_cu); per_cu = 1; }
        grid = cus * 1;
        fprintf(stderr, "kernel_launch: grid %d (cus %d, per_cu %d), ws %zu\n", grid, cus, per_cu, ws_size);
    }
    if (grid < 0) return;
    Args a{};
    for (int i = 0; i < 20; ++i) a.in[i] = (const float*)d_in[i];
    a.out = (float*)d_out; a.ws = (unsigned char*)d_ws; a.ph_lo = 0; a.ph_hi = 100;
    void* kargs[] = {&a};
    hipError_t e = hipLaunchCooperativeKernel((const void*)mega_fwd, dim3(grid), dim3(NTHREADS), kargs, LDS_BYTES, stream);
    if (e != hipSuccess) fprintf(stderr, "kernel_launch: cooperative launch failed: %s (grid %d)\n", hipGetErrorString(e), grid);
}
```

```cpp
#include <hip/hip_runtime.h>
#include <hip/hip_cooperative_groups.h>
#include <cstdio>
#include <cstdint>
namespace cg = cooperative_groups;
namespace pg8 {
#define PG8_LAS __attribute__((address_space(3)))
typedef unsigned short bf16_t;
typedef short bf16x8 __attribute__((ext_vector_type(8)));
typedef float f32x4 __attribute__((ext_vector_type(4)));
typedef unsigned u32x4 __attribute__((ext_vector_type(4)));
constexpr int BM = 256, BK = 64, HALF = 128, HTB = HALF * BK * 2  , STAGE_BYTES = 8 * HTB, NXCD = 8, WGM = 8;

__host__ __device__ __forceinline__ int lds_byte(int r, int c) { const int st = (r >> 4) * 2 + (c >> 5), rr = r & 15, cc = c & 31, ob = rr * 64 + cc * 2; return st * 1024 + (ob ^ (((ob >> 9) & 1) << 5)); }
__host__ __device__ __forceinline__ void stage_rc(int b, int& R, int& C) { const int st = b / 1024, sb = b % 1024, swz = sb ^ (((sb >> 9) & 1) << 5); R = (st >> 1) * 16 + swz / 64; C = (st & 1) * 32 + (swz % 64) / 2; }
__host__ __device__ __forceinline__ int perm32(int rho) { const int n = rho >> 4, i = rho & 15; return 8 * (i >> 2) + 4 * n + (i & 3); }

struct Unit { int pm, pn; };
struct Gemm { const bf16_t* A; const bf16_t* Bt; int M, N, K; };

struct StaticOrder {
    int nM, nN, nwg, G, c;
    __host__ __device__ void init(int M, int N, int G_, int c_) { nM = M / BM; nN = N / BM; nwg = nM * nN; G = G_; c = c_; }
    __host__ __device__ bool next(int i, Unit& u) const {
        const long L = (long)i * G + c; if (L >= nwg) return false;
        int wgid = (int)L; { const int q = nwg / NXCD, r = nwg % NXCD, xcd = wgid % NXCD, off = wgid / NXCD; wgid = (xcd < r ? xcd * (q + 1) : r * (q + 1) + (xcd - r) * q) + off; }
        const int nig = WGM * nN, gid = wgid / nig, fm = gid * WGM, gsz = (nM - fm) < WGM ? (nM - fm) : WGM;
        u.pm = fm + ((wgid % nig) % gsz); u.pn = (wgid % nig) / gsz; return true;
    }
    __device__ __forceinline__ void a_ready(const Unit&) const {}
    __device__ __forceinline__ void done(const Unit&) const {}
};

__device__ __forceinline__ unsigned cvt_pk_bf16(float lo, float hi) { unsigned r; asm volatile("v_cvt_pk_bf16_f32 %0, %1, %2" : "=v"(r) : "v"(lo), "v"(hi)); return r; }
typedef float f32x2 __attribute__((ext_vector_type(2)));
struct GemmX { const bf16_t* A; const bf16_t* Bt; int M, N, K, lda, ldb; };
struct SchedStd : StaticOrder {
    __device__ __forceinline__ const char* a_ptr(const GemmX& g, const Unit& u) const { return (const char*)g.A + (size_t)u.pm * BM * g.lda * 2; }
    __device__ __forceinline__ const char* b_ptr(const GemmX& g, const Unit& u) const { return (const char*)g.Bt + (size_t)u.pn * BM * g.ldb * 2; }
};
struct SchedP1 {
    StaticOrder so; int G, c;
    __device__ void init(int G_, int c_) { so.init(16384, 2048, G_, c_); G = G_; c = c_; }
    __device__ bool next(int i, Unit& u) const {
        const int L = i * G + c;
        if (L < 512) return so.next(i, u);
        const int l = L - 512; if (l >= 64) return false;
        u.pm = 64 + (l >> 3); u.pn = 8 + (l & 7); return true;
    }
    __device__ __forceinline__ void a_ready(const Unit&) const {}
    __device__ __forceinline__ void done(const Unit&) const {}
    __device__ __forceinline__ const char* a_ptr(const GemmX& g, const Unit& u) const { return (const char*)g.A + (size_t)u.pm * BM * g.lda * 2; }
    __device__ __forceinline__ const char* b_ptr(const GemmX& g, const Unit& u) const { return (const char*)g.Bt + (size_t)u.pn * BM * g.ldb * 2; }
};
struct SchedPool {
    int G, c;
    __device__ void init(int G_, int c_) { G = G_; c = c_; }
    __device__ bool next(int i, Unit& u) const {
        const int L = i * G + c; if (L >= 512) return false;
        u.pm = (L >> 1) & 63; u.pn = ((L >> 7) << 1) | (L & 1); return true;
    }
    __device__ __forceinline__ void a_ready(const Unit&) const {}
    __device__ __forceinline__ void done(const Unit&) const {}
    __device__ __forceinline__ const char* a_ptr(const GemmX& g, const Unit& u) const { return (const char*)g.A + ((size_t)u.pm * BM * g.lda + (size_t)(u.pn >> 1) * 384) * 2; }
    __device__ __forceinline__ const char* b_ptr(const GemmX& g, const Unit& u) const { return (const char*)g.Bt + (size_t)u.pn * BM * g.ldb * 2; }
};

typedef unsigned u32x2 __attribute__((ext_vector_type(2)));
constexpr float RMS_EPS = 1e-6f;
__device__ __forceinline__ float rstd2048(const float* rss, int row) { return rsqrtf(rss[row] * (1.0f / 2048.0f) + RMS_EPS); }

struct EpiP1 {
    static constexpr bool PERM = true, AFTER_DRAIN = false;
    bf16_t* big; bf16_t* mkv; const float* rss;
    __device__ __forceinline__ void operator()(const f32x4 (&acc)[2][2][4][2], const Unit& u, int wr, int wc, int fr, int fq) const {
        const int row0 = u.pm * BM + wr * 64 + fr;
        bf16_t* base; size_t ld;
        if (u.pm < 64) { ld = 8192; base = big + (u.pn < 6 ? u.pn * 256 : 3072 + (u.pn - 6) * 256); }
        else { ld = 2048; base = mkv - (size_t)16384 * 2048 + (u.pn - 8) * 256; }
        base += wc * 32 + 8 * fq;
#pragma unroll
        for (int ai = 0; ai < 2; ++ai)
#pragma unroll
            for (int m = 0; m < 4; ++m) { const int row = row0 + ai * HALF + m * 16; const float sc = rstd2048(rss, row); bf16_t* rowp = base + (size_t)row * ld;
#pragma unroll
                for (int bj = 0; bj < 2; ++bj) { const f32x4 v0 = acc[ai][bj][m][0] * sc, v1 = acc[ai][bj][m][1] * sc;
                    u32x4 w; w.x = cvt_pk_bf16(v0[0], v0[1]); w.y = cvt_pk_bf16(v0[2], v0[3]); w.z = cvt_pk_bf16(v1[0], v1[1]); w.w = cvt_pk_bf16(v1[2], v1[3]);
                    *(u32x4*)(rowp + bj * HALF) = w; } }
    }
};
struct EpiPool {
    static constexpr bool PERM = true, AFTER_DRAIN = false;
    bf16_t* big;
    __device__ __forceinline__ void operator()(const f32x4 (&acc)[2][2][4][2], const Unit& u, int wr, int wc, int fr, int fq) const {
        const int row0 = u.pm * BM + wr * 64 + fr; const int g = u.pn >> 1, half = u.pn & 1;
        bf16_t* base = big + 3584 + g * 384 + half * 256 + wc * 32 + 8 * fq;
#pragma unroll
        for (int ai = 0; ai < 2; ++ai)
#pragma unroll
            for (int m = 0; m < 4; ++m) { bf16_t* rowp = base + (size_t)(row0 + ai * HALF + m * 16) * 8192;
#pragma unroll
                for (int bj = 0; bj < 2; ++bj) { if (bj == 1 && half == 1) continue;
                    const f32x4 v0 = acc[ai][bj][m][0], v1 = acc[ai][bj][m][1];
                    u32x4 w; w.x = cvt_pk_bf16(v0[0], v0[1]); w.y = cvt_pk_bf16(v0[2], v0[3]); w.z = cvt_pk_bf16(v1[0], v1[1]); w.w = cvt_pk_bf16(v1[2], v1[3]);
                    *(u32x4*)(rowp + bj * HALF) = w; } }
    }
};
struct EpiRelu2 {
    static constexpr bool PERM = true, AFTER_DRAIN = false;
    bf16_t* big; const float* rss;
    __device__ __forceinline__ void operator()(const f32x4 (&acc)[2][2][4][2], const Unit& u, int wr, int wc, int fr, int fq) const {
        const int row0 = u.pm * BM + wr * 64 + fr;
        bf16_t* base = big + u.pn * BM + wc * 32 + 8 * fq;
#pragma unroll
        for (int ai = 0; ai < 2; ++ai)
#pragma unroll
            for (int m = 0; m < 4; ++m) { const int row = row0 + ai * HALF + m * 16; const float sc = rstd2048(rss, row); bf16_t* rowp = base + (size_t)row * 8192;
#pragma unroll
                for (int bj = 0; bj < 2; ++bj) { f32x4 v0 = acc[ai][bj][m][0] * sc, v1 = acc[ai][bj][m][1] * sc;
#pragma unroll
                    for (int e = 0; e < 4; ++e) { v0[e] = fmaxf(v0[e], 0.f); v0[e] *= v0[e]; v1[e] = fmaxf(v1[e], 0.f); v1[e] *= v1[e]; }
                    u32x4 w; w.x = cvt_pk_bf16(v0[0], v0[1]); w.y = cvt_pk_bf16(v0[2], v0[3]); w.z = cvt_pk_bf16(v1[0], v1[1]); w.w = cvt_pk_bf16(v1[2], v1[3]);
                    *(u32x4*)(rowp + bj * HALF) = w; } }
    }
};
struct EpiResid {
    static constexpr bool PERM = false, AFTER_DRAIN = false;
    const float* base; float* out; bf16_t* xb; float* rss_out;
    __device__ __forceinline__ void operator()(const f32x4 (&acc)[2][2][4][2], const Unit& u, int wr, int wc, int fr, int fq) const {
        const int row0 = u.pm * BM + wr * 64 + fr; const int col0 = u.pn * BM + wc * 32 + 4 * fq;
#pragma unroll
        for (int ai = 0; ai < 2; ++ai)
#pragma unroll
            for (int m = 0; m < 4; ++m) { const int row = row0 + ai * HALF + m * 16; const size_t off = (size_t)row * 2048 + col0; float ss = 0.f;
#pragma unroll
                for (int bj = 0; bj < 2; ++bj)
#pragma unroll
                    for (int n = 0; n < 2; ++n) { const f32x4 bs = *(const f32x4*)(base + off + bj * HALF + n * 16); const f32x4 o = bs + acc[ai][bj][m][n];
                        *(f32x4*)(out + off + bj * HALF + n * 16) = o;
                        if (xb) { u32x2 w; w.x = cvt_pk_bf16(o[0], o[1]); w.y = cvt_pk_bf16(o[2], o[3]); *(u32x2*)(xb + off + bj * HALF + n * 16) = w; }
                        ss += (o[0] * o[0] + o[1] * o[1]) + (o[2] * o[2] + o[3] * o[3]); }
                if (rss_out) { ss += __shfl_xor(ss, 16); ss += __shfl_xor(ss, 32); if (fq == 0) __hip_atomic_fetch_add(rss_out + row, ss, __ATOMIC_RELAXED, __HIP_MEMORY_SCOPE_AGENT); }
                if (m & 1) asm volatile("" ::: "memory"); }
    }
};
struct EpiP6 {
    static constexpr bool PERM = false, AFTER_DRAIN = false;
    bf16_t* big; const float* rss; const float* kgain; const float* qgain; const float* rope;
    __device__ __forceinline__ void operator()(const f32x4 (&acc)[2][2][4][2], const Unit& u, int wr, int wc, int fr, int fq) const {
        const int row0 = u.pm * BM + wr * 64 + fr; const int pn = u.pn;
        const int kind = (pn < 6) ? 1 : (pn >= 12 && pn < 18) ? 2 : 0;
        bf16_t* basep = big + pn * BM + wc * 64 + 4 * fq;
        if (kind == 0) {
#pragma unroll
            for (int ai = 0; ai < 2; ++ai)
#pragma unroll
                for (int m = 0; m < 4; ++m) { const int row = row0 + ai * HALF + m * 16; const float sc = rstd2048(rss, row); bf16_t* rowp = basep + (size_t)row * 8192;
#pragma unroll
                    for (int bj = 0; bj < 2; ++bj)
#pragma unroll
                        for (int n = 0; n < 2; ++n) { const f32x4 v = acc[ai][bj][m][n] * sc; u32x2 w; w.x = cvt_pk_bf16(v[0], v[1]); w.y = cvt_pk_bf16(v[2], v[3]); *(u32x2*)(rowp + bj * 32 + n * 16) = w; } }
        } else {
            const float* gp = (kind == 1 ? kgain : qgain) + 4 * fq; const float osc = (kind == 2) ? (0.125f * 1.4426950408889634f) : 1.0f;
            f32x4 gv[2][2];
#pragma unroll
            for (int bj = 0; bj < 2; ++bj)
#pragma unroll
                for (int n = 0; n < 2; ++n) gv[bj][n] = *(const f32x4*)(gp + bj * 32 + n * 16) * osc;
#pragma unroll
            for (int ai = 0; ai < 2; ++ai)
#pragma unroll
                for (int m = 0; m < 4; ++m) { const int row = row0 + ai * HALF + m * 16; const float sc = rstd2048(rss, row); bf16_t* rowp = basep + (size_t)row * 8192;
                    f32x4 v[2][2]; float ss = 0.f;
#pragma unroll
                    for (int bj = 0; bj < 2; ++bj)
#pragma unroll
                        for (int n = 0; n < 2; ++n) { v[bj][n] = acc[ai][bj][m][n] * sc; const f32x4 x = v[bj][n]; ss += (x[0] * x[0] + x[1] * x[1]) + (x[2] * x[2] + x[3] * x[3]); }
                    ss += __shfl_xor(ss, 16); ss += __shfl_xor(ss, 32);
                    const float r = rsqrtf(ss * (1.0f / 64.0f) + RMS_EPS);
#pragma unroll
                    for (int bj = 0; bj < 2; ++bj)
#pragma unroll
                        for (int n = 0; n < 2; ++n) v[bj][n] = v[bj][n] * r * gv[bj][n];
                    {
                        const float* rp = rope + (size_t)(row & 2047) * 16 + 4 * (fq & 1);
                        const f32x4 cs = *(const f32x4*)rp, sn = *(const f32x4*)(rp + 8);
                        f32x4 y = v[0][0], oth;
#pragma unroll
                        for (int e = 0; e < 4; ++e) oth[e] = __shfl_xor(y[e], 32);
                        const float sg = (fq < 2) ? -1.0f : 1.0f;
                        v[0][0] = y * cs + oth * (sn * sg);
                    }
#pragma unroll
                    for (int bj = 0; bj < 2; ++bj)
#pragma unroll
                        for (int n = 0; n < 2; ++n) { const f32x4 x = v[bj][n]; u32x2 w; w.x = cvt_pk_bf16(x[0], x[1]); w.y = cvt_pk_bf16(x[2], x[3]); *(u32x2*)(rowp + bj * 32 + n * 16) = w; } }
        }
    }
};
template <class Epi, class Sched, bool ALIGN_EPI = false, bool SP2 = false>
__device__ __forceinline__ void gemm_phase(PG8_LAS unsigned char* lds, const GemmX g, const Sched& S, const Epi& E) {
    int tid_ = threadIdx.x; asm volatile("" : "+v"(tid_));
    const int tid = tid_, wid = __builtin_amdgcn_readfirstlane(tid >> 6), lane = tid & 63, wr = wid >> 2, wc = wid & 3, fr = lane & 15, fq = lane >> 4;
    const int K = g.K, nt = K / BK;
    unsigned voffA[2], voffB[2];
#pragma unroll
    for (int i = 0; i < 2; ++i) { int R, C; stage_rc(tid * 16 + i * 8192, R, C); const int Rb = Epi::PERM ? ((R & ~31) + perm32(R & 31)) : R;
        voffA[i] = (unsigned)(R * g.lda + C) * 2u; voffB[i] = (unsigned)(Rb * g.ldb + C) * 2u; }
    const size_t kstep = (size_t)(BK * 2);
    const size_t hsA = (size_t)HALF * g.lda * 2, hsB = (size_t)HALF * g.ldb * 2;
    const unsigned ldsw = (unsigned)wid * 1024u;
    const int aoff = lds_byte(wr * 64 + fr, fq * 8), boff = lds_byte(wc * 32 + fr, fq * 8);
#define PG8_SA(b, h) (((b) * 2 + (h)) * HTB)
#define PG8_SB(b, h) ((4 + (b) * 2 + (h)) * HTB)
#define PG8_STAGE(bufoff, gbase, voff) do { _Pragma("unroll") for (int _i = 0; _i < 2; ++_i) \
        __builtin_amdgcn_global_load_lds((const unsigned*)((const char*)(gbase) + (voff)[_i]), (PG8_LAS unsigned*)(lds + (bufoff) + ldsw + _i * 8192), 16, 0, 0); } while (0)
#define PG8_LDA(dst, b, h) do { _Pragma("unroll") for (int m = 0; m < 4; ++m) _Pragma("unroll") for (int k = 0; k < 2; ++k) dst[m][k] = *(const PG8_LAS bf16x8*)(lds + PG8_SA(b, h) + aoff + m * 2048 + k * 1024); } while (0)
#define PG8_LDB(dst, b, h) do { _Pragma("unroll") for (int n = 0; n < 2; ++n) _Pragma("unroll") for (int k = 0; k < 2; ++k) dst[n][k] = *(const PG8_LAS bf16x8*)(lds + PG8_SB(b, h) + boff + n * 2048 + k * 1024); } while (0)
#define PG8_MMA(ai, bj, At, Bt) do { __builtin_amdgcn_s_setprio(1); _Pragma("unroll") for (int m = 0; m < 4; ++m) _Pragma("unroll") for (int n = 0; n < 2; ++n) _Pragma("unroll") for (int k = 0; k < 2; ++k) \
        acc[ai][bj][m][n] = __builtin_amdgcn_mfma_f32_16x16x32_bf16(Bt[n][k], At[m][k], acc[ai][bj][m][n], 0, 0, 0); __builtin_amdgcn_s_setprio(0); } while (0)
#define PG8_WAIT_V(n) asm volatile("s_waitcnt vmcnt(" #n ")" ::: "memory")
#define PG8_WAIT_L(n) asm volatile("s_waitcnt lgkmcnt(" #n ")" ::: "memory")
#define PG8_BAR __builtin_amdgcn_s_barrier()
#define PG8_SCHED __builtin_amdgcn_sched_barrier(0)
    Unit cur, nxt; int ui = 0;
    if (!S.next(0, cur)) return;
    f32x4 acc[2][2][4][2];
#pragma unroll
    for (int a = 0; a < 2; ++a)
#pragma unroll
        for (int b = 0; b < 2; ++b)
#pragma unroll
            for (int m = 0; m < 4; ++m)
#pragma unroll
                for (int n = 0; n < 2; ++n) acc[a][b][m][n] = (f32x4){0.f, 0.f, 0.f, 0.f};
    bf16x8 At[4][2], B0[2][2], B1[2][2];
    const char* cA = S.a_ptr(g, cur); const char* cB = S.b_ptr(g, cur);
    S.a_ready(cur);
    if constexpr (SP2) {
        PG8_STAGE(PG8_SB(0, 0), cB, voffB); PG8_STAGE(PG8_SB(0, 1), cB + hsB, voffB); PG8_STAGE(PG8_SA(0, 0), cA, voffA); PG8_STAGE(PG8_SA(0, 1), cA + hsA, voffA);
        if (wr == 1) PG8_BAR;
        PG8_WAIT_V(2); PG8_BAR;
        PG8_STAGE(PG8_SB(1, 0), cB + kstep, voffB); PG8_STAGE(PG8_SA(1, 0), cA + kstep, voffA); PG8_STAGE(PG8_SB(1, 1), cB + hsB + kstep, voffB);
        PG8_WAIT_V(6); PG8_BAR;
    } else {
        PG8_STAGE(PG8_SB(0, 0), cB, voffB); PG8_STAGE(PG8_SA(0, 0), cA, voffA); PG8_STAGE(PG8_SB(0, 1), cB + hsB, voffB); PG8_STAGE(PG8_SA(0, 1), cA + hsA, voffA);
        if (wr == 1) PG8_BAR;
        PG8_WAIT_V(4); PG8_BAR;
        PG8_STAGE(PG8_SB(1, 0), cB + kstep, voffB); PG8_STAGE(PG8_SA(1, 0), cA + kstep, voffA); PG8_STAGE(PG8_SB(1, 1), cB + hsB + kstep, voffB);
        PG8_WAIT_V(6); PG8_BAR;
    }
    for (;;) {
        const bool has_next = S.next(ui + 1, nxt);
        const char* nA = has_next ? S.a_ptr(g, nxt) : cA; const char* nB = has_next ? S.b_ptr(g, nxt) : cB;
        for (int t = 0; t < nt; t += 2) {
            const bool last = (t == nt - 2);
            const char* a1 = cA + (size_t)(t + 1) * kstep;
            const char* a2 = last ? nA : cA + (size_t)(t + 2) * kstep; const char* b2 = last ? nB : cB + (size_t)(t + 2) * kstep;
            const char* a3 = a2 + kstep; const char* b3 = b2 + kstep;
            if (last && has_next) S.a_ready(nxt);
            if constexpr (SP2) {
            PG8_LDB(B0, 0, 0); PG8_LDB(B1, 0, 1); PG8_SCHED; PG8_LDA(At, 0, 0); PG8_STAGE(PG8_SA(1, 1), a1 + hsA, voffA);
            PG8_WAIT_V(8); PG8_WAIT_L(0); PG8_BAR; PG8_MMA(0, 0, At, B0); PG8_MMA(0, 1, At, B1); PG8_BAR; PG8_SCHED;
            PG8_LDA(At, 0, 1); PG8_STAGE(PG8_SB(0, 0), b2, voffB); PG8_STAGE(PG8_SB(0, 1), b2 + hsB, voffB); PG8_STAGE(PG8_SA(0, 0), a2, voffA);
            PG8_WAIT_V(8); PG8_WAIT_L(0); PG8_BAR; PG8_MMA(1, 0, At, B0); PG8_MMA(1, 1, At, B1); PG8_BAR; PG8_SCHED;
            PG8_LDB(B0, 1, 0); PG8_LDB(B1, 1, 1); PG8_SCHED; PG8_LDA(At, 1, 0); PG8_STAGE(PG8_SA(0, 1), a2 + hsA, voffA);
            PG8_WAIT_V(8); PG8_WAIT_L(0); PG8_BAR; PG8_MMA(0, 0, At, B0); PG8_MMA(0, 1, At, B1); PG8_BAR; PG8_SCHED;
            PG8_LDA(At, 1, 1); PG8_STAGE(PG8_SB(1, 0), b3, voffB); PG8_STAGE(PG8_SB(1, 1), b3 + hsB, voffB); PG8_STAGE(PG8_SA(1, 0), a3, voffA);
            PG8_WAIT_V(8); PG8_WAIT_L(0); PG8_BAR; PG8_MMA(1, 0, At, B0); PG8_MMA(1, 1, At, B1); PG8_BAR; PG8_SCHED;
            } else {
            PG8_LDB(B0, 0, 0); PG8_SCHED; PG8_LDA(At, 0, 0); PG8_STAGE(PG8_SA(1, 1), a1 + hsA, voffA);
            PG8_WAIT_L(8); PG8_BAR; PG8_WAIT_L(0); PG8_MMA(0, 0, At, B0); PG8_BAR; PG8_SCHED;
            PG8_LDB(B1, 0, 1); PG8_STAGE(PG8_SB(0, 0), b2, voffB);
            PG8_BAR; PG8_WAIT_L(0); PG8_MMA(0, 1, At, B1); PG8_BAR;
            PG8_LDA(At, 0, 1); PG8_STAGE(PG8_SA(0, 0), a2, voffA);
            PG8_BAR; PG8_WAIT_L(0); PG8_MMA(1, 0, At, B0); PG8_BAR; PG8_SCHED;
            PG8_STAGE(PG8_SB(0, 1), b2 + hsB, voffB);
            PG8_WAIT_V(6); PG8_BAR; PG8_MMA(1, 1, At, B1); PG8_BAR;
            PG8_LDB(B0, 1, 0); PG8_SCHED; PG8_LDA(At, 1, 0); PG8_STAGE(PG8_SA(0, 1), a2 + hsA, voffA);
            PG8_WAIT_L(8); PG8_BAR; PG8_WAIT_L(0); PG8_MMA(0, 0, At, B0); PG8_BAR; PG8_SCHED;
            PG8_LDB(B1, 1, 1); PG8_STAGE(PG8_SB(1, 0), b3, voffB);
            PG8_BAR; PG8_WAIT_L(0); PG8_MMA(0, 1, At, B1); PG8_BAR;
            PG8_LDA(At, 1, 1); PG8_STAGE(PG8_SA(1, 0), a3, voffA);
            PG8_BAR; PG8_WAIT_L(0); PG8_MMA(1, 0, At, B0); PG8_BAR; PG8_SCHED;
            PG8_STAGE(PG8_SB(1, 1), b3 + hsB, voffB);
            PG8_WAIT_V(6); PG8_BAR; PG8_MMA(1, 1, At, B1); PG8_BAR;
            }
        }
        if constexpr (ALIGN_EPI) { if (wr == 0) PG8_BAR; }
        if constexpr (!Epi::AFTER_DRAIN) { E(acc, cur, wr, wc, fr, fq); S.done(cur); }
        if (!has_next) break;
#pragma unroll
        for (int a = 0; a < 2; ++a)
#pragma unroll
            for (int b = 0; b < 2; ++b)
#pragma unroll
                for (int m = 0; m < 4; ++m)
#pragma unroll
                    for (int n = 0; n < 2; ++n) acc[a][b][m][n] = (f32x4){0.f, 0.f, 0.f, 0.f};
        cur = nxt; cA = nA; cB = nB; ++ui;
        if constexpr (ALIGN_EPI) { if (wr == 1) PG8_BAR; }
    }
    PG8_WAIT_V(0);
    if constexpr (!ALIGN_EPI) { if (wr == 0) PG8_BAR; }
    PG8_BAR;
    if constexpr (Epi::AFTER_DRAIN) { E.fused(acc, cur, wr, wc, fr, fq, lds, wid, lane); S.done(cur); }
#undef PG8_SA
#undef PG8_SB
#undef PG8_STAGE
#undef PG8_LDA
#undef PG8_LDB
#undef PG8_MMA
#undef PG8_WAIT_V
#undef PG8_WAIT_L
#undef PG8_BAR
#undef PG8_SCHED
}
}

#include <hip/hip_bf16.h>
#include <cmath>
namespace attn_body {
using bf16=__hip_bfloat16;
using bf16x8=__attribute__((ext_vector_type(8)))short;
using s16x4=__attribute__((ext_vector_type(4)))short;
using f32x16=__attribute__((ext_vector_type(16)))float;
using u32x4=__attribute__((ext_vector_type(4)))unsigned;
constexpr int BATCH=8,SEQ=2048,D=64,DM=8192;
constexpr int NW=8,QBLK=32,QB=QBLK*NW,KVBLK=64,NQB=SEQ/QB;
constexpr int ATTN_PITCH=DM, ATTN_UNIT_ROWS=QB;
__device__ __forceinline__ int crow(int r,int hi){return (r&3)+8*(r>>2)+4*hi;}
#define SBAR() __builtin_amdgcn_sched_barrier(0)
__device__ __forceinline__ void cmask(f32x16&p0,f32x16&p1,int jb,int qrel,int hi){
  const float NEG=-INFINITY; int kb=64*jb+4*hi;
  #pragma unroll
  for(int r=0;r<16;++r){int kv=kb+(r&3)+8*(r>>2); if(kv>qrel)p0[r]=NEG; if(kv+32>qrel)p1[r]=NEG;}
}

constexpr int NSLOT=3, SLOTB=8192;
constexpr int LDS_K=0, LDS_V=NSLOT*SLOTB, LDS_WS=2*NSLOT*SLOTB, LDS_OST=LDS_WS+NW*64*4, LDS_BYTES=LDS_OST+NW*4096;
constexpr float C2=0.125f*1.4426950408889634f;
__device__ __forceinline__ void glds16(const void*gsrc,unsigned lds_dst){unsigned keep;
  asm volatile("s_mov_b32 %0, m0\n\ts_mov_b32 m0, %2\n\ts_nop 0\n\tglobal_load_lds_dwordx4 %1, off\n\ts_mov_b32 m0, %0":"=&s"(keep):"v"(gsrc),"s"(lds_dst):"memory");}
__device__ __forceinline__ float max3f(float a,float b,float c){float r;asm("v_max3_f32 %0, %1, %2, %3":"=v"(r):"v"(a),"v"(b),"v"(c));return r;}
__device__ __forceinline__ float max2f(float a,float b){float r;asm("v_max_f32_e32 %0, %1, %2":"=v"(r):"v"(a),"v"(b));return r;}
__device__ __forceinline__ float fadd_s(float a,float b){float r;asm("v_add_f32_e32 %0, %1, %2":"=v"(r):"v"(a),"v"(b));return r;}
__device__ __forceinline__ float fsub_s(float a,float b){float r;asm("v_sub_f32_e32 %0, %1, %2":"=v"(r):"v"(a),"v"(b));return r;}
typedef float f32x2_t __attribute__((ext_vector_type(2))); typedef __bf16 bf16x2_t __attribute__((ext_vector_type(2)));
__device__ __forceinline__ unsigned cvtpk_s(float lo,float hi){f32x2_t v={lo,hi};bf16x2_t b=__builtin_convertvector(v,bf16x2_t);return __builtin_bit_cast(unsigned,b);}
#define WAIT_BAR(N) asm volatile("s_waitcnt vmcnt(" #N ") lgkmcnt(0)\n\ts_barrier":::"memory")

__device__ __forceinline__ void qkt(f32x16&p0,f32x16&p1,const char*Kslot,const bf16x8*qr,const f32x16&negm,int r32,int hi){
  const char*kb=Kslot+hi*1024+r32*16;
  #pragma unroll
  for(int d0=0;d0<4;++d0){
    const bf16x8 b0=*reinterpret_cast<const bf16x8*>(kb+d0*2048);
    const bf16x8 b1=*reinterpret_cast<const bf16x8*>(kb+d0*2048+512);
    if(d0==0){p0=__builtin_amdgcn_mfma_f32_32x32x16_bf16(b0,qr[0],negm,0,0,0);p1=__builtin_amdgcn_mfma_f32_32x32x16_bf16(b1,qr[0],negm,0,0,0);}
    else{p0=__builtin_amdgcn_mfma_f32_32x32x16_bf16(b0,qr[d0],p0,0,0,0);p1=__builtin_amdgcn_mfma_f32_32x32x16_bf16(b1,qr[d0],p1,0,0,0);}}
}
typedef __attribute__((address_space(3))) const char* lds_cptr;
typedef short v4i16_t __attribute__((ext_vector_type(4)));
__device__ __forceinline__ void kload8(bf16x8*kf,lds_cptr kp){
  kf[0]=*(const __attribute__((address_space(3))) bf16x8*)(kp);      kf[1]=*(const __attribute__((address_space(3))) bf16x8*)(kp+512);
  kf[2]=*(const __attribute__((address_space(3))) bf16x8*)(kp+2048); kf[3]=*(const __attribute__((address_space(3))) bf16x8*)(kp+2560);
  kf[4]=*(const __attribute__((address_space(3))) bf16x8*)(kp+4096); kf[5]=*(const __attribute__((address_space(3))) bf16x8*)(kp+4608);
  kf[6]=*(const __attribute__((address_space(3))) bf16x8*)(kp+6144); kf[7]=*(const __attribute__((address_space(3))) bf16x8*)(kp+6656);
}
__device__ __forceinline__ void kload2(bf16x8*kf,lds_cptr kp,int j){ kf[2*j]=*(const __attribute__((address_space(3))) bf16x8*)(kp+j*2048); kf[2*j+1]=*(const __attribute__((address_space(3))) bf16x8*)(kp+j*2048+512); }
__device__ __forceinline__ s16x4 vtr(lds_cptr p){ return __builtin_bit_cast(s16x4,__builtin_amdgcn_ds_read_tr16_b64_v4i16((__attribute__((address_space(3))) v4i16_t*)p)); }
__device__ __forceinline__ float rowmax(const f32x16&p0,const f32x16&p1){
  float a=max3f(p0[0],p0[1],p1[0]),b=max3f(p0[2],p0[3],p1[1]);a=max3f(a,p1[2],p1[3]);
  #pragma unroll
  for(int r=4;r<16;r+=4){a=max3f(a,p0[r],p0[r+1]);b=max3f(b,p0[r+2],p0[r+3]);a=max3f(a,p1[r],p1[r+1]);b=max3f(b,p1[r+2],p1[r+3]);}
  const float m=max2f(a,b);
  auto rr=__builtin_amdgcn_permlane32_swap(__float_as_uint(m),__float_as_uint(m),false,false);
  return max2f(__uint_as_float(rr[0]),__uint_as_float(rr[1]));
}
__device__ __forceinline__ void pv(f32x16*o,int vb,bf16x8 pa0,bf16x8 pa1,bf16x8 pa2,bf16x8 pa3){
  #pragma unroll
  for(int d0=0;d0<2;++d0){s16x4 lo[4],hi[4];
    #pragma unroll
    for(int ks=0;ks<4;++ks){
      asm volatile("ds_read_b64_tr_b16 %0,%1 offset:%c2":"=&v"(lo[ks]):"v"(vb),"i"(d0*4096+ks*1024):"memory");
      asm volatile("ds_read_b64_tr_b16 %0,%1 offset:%c2":"=&v"(hi[ks]):"v"(vb),"i"(d0*4096+ks*1024+512):"memory");}
    asm volatile("s_waitcnt lgkmcnt(0)":::"memory");SBAR();
    #define PK(k) (bf16x8){lo[k][0],lo[k][1],lo[k][2],lo[k][3],hi[k][0],hi[k][1],hi[k][2],hi[k][3]}
    o[d0]=__builtin_amdgcn_mfma_f32_32x32x16_bf16(pa0,PK(0),o[d0],0,0,0);
    o[d0]=__builtin_amdgcn_mfma_f32_32x32x16_bf16(pa1,PK(1),o[d0],0,0,0);
    o[d0]=__builtin_amdgcn_mfma_f32_32x32x16_bf16(pa2,PK(2),o[d0],0,0,0);
    o[d0]=__builtin_amdgcn_mfma_f32_32x32x16_bf16(pa3,PK(3),o[d0],0,0,0);
    #undef PK
  }
}

#ifndef ATTN_STORE16
#define ATTN_STORE16(p,v) (*(u32x4*)(p)=(v))
#endif
template<int THRL> __device__ __forceinline__ void attn_unit(int b,int h,int qb,const bf16*Q,const bf16*__restrict__ K,const bf16*__restrict__ V,bf16*O,char*shm){
  int tid_=threadIdx.x; asm volatile("":"+v"(tid_)); const int tid=tid_,lane=tid&63,r32=lane&31,hi=lane>>5; const int wid=__builtin_amdgcn_readfirstlane(tid>>6);
  const long rowbase=(long)b*SEQ; const int q0=qb*QB;
  const bf16*Qw=Q+(rowbase+q0+wid*QBLK)*DM+h*D;
  const bf16*Kh=K+rowbase*DM+h*D,*Vh=V+rowbase*DM+h*D;
  const unsigned lds0=(unsigned)(uintptr_t)shm;
  float*wsf=(float*)(shm+LDS_WS)+wid*64;
  const bf16*ksrc=Kh+(long)lane*DM+wid*8;
  const bf16*vsrc=Vh+(long)(16*(wid&3)+(lane>>2))*DM+(wid>>2)*32+(lane&3)*8;
  const unsigned kdst=lds0+LDS_K+wid*1024, vdst=lds0+LDS_V+wid*1024;
  #define DMA_K(t,slot) glds16(ksrc+(long)(t)*KVBLK*DM,(unsigned)__builtin_amdgcn_readfirstlane(kdst+(slot)))
  #define DMA_V(t,slot) glds16(vsrc+(long)(t)*KVBLK*DM,(unsigned)__builtin_amdgcn_readfirstlane(vdst+(slot)))
  const int vb0=(int)(lds0+LDS_V)+((lane>>4)&1)*32+(lane&3)*8+(4*hi+((lane&15)>>2))*64;
  const char*Kbase=shm+LDS_K; bf16x8 kf[8];
  const lds_cptr shm3=(lds_cptr)shm; const lds_cptr kp0=shm3+LDS_K+hi*1024+r32*16; const lds_cptr vp0=shm3+LDS_V+((lane>>4)&1)*32+(lane&3)*8+(4*hi+((lane&15)>>2))*64;
  const int NT=(q0+QB)/KVBLK;
  DMA_K(0,0);DMA_V(0,0);DMA_K(1,SLOTB);
  bf16x8 qr[4];
  #pragma unroll
  for(int d0=0;d0<4;++d0)qr[d0]=*reinterpret_cast<const bf16x8*>(&Qw[(long)r32*DM+d0*16+hi*8]);
  float mhat=0.f,l_reg=0.f;f32x16 o[2];o[0]=f32x16{};o[1]=f32x16{};f32x16 negm=f32x16{};asm volatile("":"+v"(negm));
  const int qrel=wid*QBLK+r32;
  #define CMASK(P0,P1,t) do{int jb_=(t)-(NT-4); if(jb_>=0)cmask(P0,P1,jb_,qrel,hi);}while(0)
  bool resc=false;
  #define START(P0,P1) do{ const float rm=rowmax(P0,P1); resc=false; \
    { const float dl=rm; mhat=fadd_s(mhat,dl); \
      _Pragma("unroll") for(int r=0;r<16;++r){P0[r]=fsub_s(P0[r],dl);P1[r]=fsub_s(P1[r],dl);} \
      _Pragma("unroll") for(int r=0;r<16;++r)negm[r]=-mhat; asm volatile("":"+v"(negm)); } \
    _Pragma("unroll") for(int r=0;r<16;++r)P0[r]=__builtin_amdgcn_exp2f(P0[r]); }while(0)
  #define RESC() do{ if(resc){ asm volatile("s_waitcnt lgkmcnt(0)":::"memory"); \
      _Pragma("unroll") for(int d_=0;d_<2;++d_) _Pragma("unroll") for(int r=0;r<16;++r)o[d_][r]*=wsf[crow(r,hi)]; } }while(0)
  f32x16 pA0,pA1,pB0,pB1;
  int sl_prev=0,sl_cur=0,sl_next=SLOTB;
  #define ROT() do{sl_prev=sl_cur;sl_cur=sl_next;sl_next=(sl_next==(NSLOT-1)*SLOTB)?0:sl_next+SLOTB;}while(0)
  DMA_K(2,2*SLOTB);
  WAIT_BAR(3);
  qkt(pA0,pA1,Kbase,qr,negm,r32,hi);asm volatile("s_nop 15\n\ts_nop 7":"+v"(pA0),"+v"(pA1));CMASK(pA0,pA1,0);
  START(pA0,pA1);
  _Pragma("unroll") for(int r=0;r<16;++r)pA1[r]=__builtin_amdgcn_exp2f(pA1[r]);
  WAIT_BAR(0);
  DMA_K(3,0);DMA_V(1,SLOTB);
  ROT();
  kload8(kf,kp0+sl_cur);
  WAIT_BAR(2);
  s16x4 vlo[8],vhi[8]; u32x4 pw0,pw1,pw2,pw3;
  #define PKW(P,B) cvtpk_s(P[B],P[B+1])
  #define PAF(k) __builtin_bit_cast(bf16x8,pw##k)
  #define VFR(i) (bf16x8){vlo[i][0],vlo[i][1],vlo[i][2],vlo[i][3],vhi[i][0],vhi[i][1],vhi[i][2],vhi[i][3]}
  #define PIN(x) asm volatile("":"+v"(x))
  #define MX3(a,b,c) __builtin_fmaxf(__builtin_fmaxf((a),(b)),(c))
  #define GAPA(MF,A0,A1,A2,A3,W0,W1,PW) do{ MF; sacc+=A0; sacc+=A1; sacc+=A2; sacc+=A3; PIN(sacc); W0; W1; PIN(PW); SBAR(); }while(0)
  #define EX(v) __builtin_amdgcn_exp2f(v)
  #define GAPB(MF,X,B) do{ MF; X[B]=EX(X[B]); X[B+1]=EX(X[B+1]); X[B+2]=EX(X[B+2]); X[B+3]=EX(X[B+3]); PIN(X); SBAR(); }while(0)
  #define VRD(i) do{ vlo[i]=vtr(vp_+(((i)>>2)*4096+((i)&3)*1024)); vhi[i]=vtr(vp_+(((i)>>2)*4096+((i)&3)*1024+512)); }while(0)
  #define KRD(G,j) do{ if(G){ kload2(kf,kp0+sl_next,j); SBAR(); } }while(0)
  #define STEP(C0,C1,P0,P1,t,GK,GV,GL) do{ SBAR(); \
    const lds_cptr vp_=vp0+sl_prev; \
    VRD(0); SBAR(); float sacc=(P0[0]+P0[1]); \
    GAPA(C0=__builtin_amdgcn_mfma_f32_32x32x16_bf16(kf[0],qr[0],negm,0,0,0), P0[2],P0[3],P0[4],P0[5],     pw0[0]=PKW(P0,0), pw0[1]=PKW(P0,2), pw0); \
    VRD(4); SBAR(); GAPA(C1=__builtin_amdgcn_mfma_f32_32x32x16_bf16(kf[1],qr[0],negm,0,0,0), P0[6],P0[7],P0[8],P0[9],     pw0[2]=PKW(P0,4), pw0[3]=PKW(P0,6), pw0); \
    VRD(1); SBAR(); GAPA(C0=__builtin_amdgcn_mfma_f32_32x32x16_bf16(kf[2],qr[1],C0,0,0,0),   P0[10],P0[11],P0[12],P0[13], pw1[0]=PKW(P0,8), pw1[1]=PKW(P0,10), pw1); \
    VRD(5); SBAR(); GAPA(C1=__builtin_amdgcn_mfma_f32_32x32x16_bf16(kf[3],qr[1],C1,0,0,0),   P0[14],P0[15],P1[0],P1[1],   pw1[2]=PKW(P0,12),pw1[3]=PKW(P0,14), pw1); \
    VRD(2); SBAR(); GAPA(C0=__builtin_amdgcn_mfma_f32_32x32x16_bf16(kf[4],qr[2],C0,0,0,0),   P1[2],P1[3],P1[4],P1[5],     pw2[0]=PKW(P1,0), pw2[1]=PKW(P1,2), pw2); \
    VRD(6); SBAR(); GAPA(C1=__builtin_amdgcn_mfma_f32_32x32x16_bf16(kf[5],qr[2],C1,0,0,0),   P1[6],P1[7],P1[8],P1[9],     pw2[2]=PKW(P1,4), pw2[3]=PKW(P1,6), pw2); \
    VRD(3); SBAR(); GAPA(C0=__builtin_amdgcn_mfma_f32_32x32x16_bf16(kf[6],qr[3],C0,0,0,0),   P1[10],P1[11],P1[12],P1[13], pw3[0]=PKW(P1,8), pw3[1]=PKW(P1,10), pw3); \
    VRD(7); SBAR(); GAPA(C1=__builtin_amdgcn_mfma_f32_32x32x16_bf16(kf[7],qr[3],C1,0,0,0),   P1[14],P1[15],0.f,0.f,       pw3[2]=PKW(P1,12),pw3[3]=PKW(P1,14), pw3); \
    l_reg+=sacc; \
    if(GK){DMA_K((t)+3,sl_cur);} if(GV){DMA_V((t)+1,sl_next);} \
    CMASK(C0,C1,t); \
    { float a=MX3(C0[0],C0[1],C1[0]),b=MX3(C0[2],C0[3],C1[1]); a=MX3(a,C1[2],C1[3]); \
      _Pragma("unroll") for(int r=4;r<16;r+=4){a=MX3(a,C0[r],C0[r+1]);b=MX3(b,C0[r+2],C0[r+3]);a=MX3(a,C1[r],C1[r+1]);b=MX3(b,C1[r+2],C1[r+3]);} \
      float rm=__builtin_fmaxf(a,b); { auto rr=__builtin_amdgcn_permlane32_swap(__float_as_uint(rm),__float_as_uint(rm),false,false); rm=__builtin_fmaxf(__uint_as_float(rr[0]),__uint_as_float(rr[1])); } \
      resc=false; \
      if(__builtin_expect(__any(rm>(float)THRL),0)){ const float dl=__builtin_fmaxf(rm,0.f); mhat+=dl; \
        _Pragma("unroll") for(int r=0;r<16;++r){C0[r]-=dl;C1[r]-=dl;} \
        _Pragma("unroll") for(int r=0;r<16;++r)negm[r]=-mhat; asm volatile("":"+v"(negm)); \
        const float f=__builtin_amdgcn_exp2f(-dl); l_reg*=f; if(hi==0)wsf[r32]=f; resc=true; } } \
    SBAR(); \
    GAPB(o[0]=__builtin_amdgcn_mfma_f32_32x32x16_bf16(PAF(0),VFR(0),o[0],0,0,0), C0,0); \
    GAPB(o[1]=__builtin_amdgcn_mfma_f32_32x32x16_bf16(PAF(0),VFR(4),o[1],0,0,0), C0,4); \
    KRD(GL,0); GAPB(o[0]=__builtin_amdgcn_mfma_f32_32x32x16_bf16(PAF(1),VFR(1),o[0],0,0,0), C0,8); \
    KRD(GL,1); GAPB(o[1]=__builtin_amdgcn_mfma_f32_32x32x16_bf16(PAF(1),VFR(5),o[1],0,0,0), C0,12); \
    KRD(GL,2); GAPB(o[0]=__builtin_amdgcn_mfma_f32_32x32x16_bf16(PAF(2),VFR(2),o[0],0,0,0), C1,0); \
    KRD(GL,3); GAPB(o[1]=__builtin_amdgcn_mfma_f32_32x32x16_bf16(PAF(2),VFR(6),o[1],0,0,0), C1,4); \
    GAPB(o[0]=__builtin_amdgcn_mfma_f32_32x32x16_bf16(PAF(3),VFR(3),o[0],0,0,0), C1,8); \
    GAPB(o[1]=__builtin_amdgcn_mfma_f32_32x32x16_bf16(PAF(3),VFR(7),o[1],0,0,0), C1,12); \
    }while(0)
  int t=1;
  #undef CMASK
  #define CMASK(P0,P1,t) do{}while(0)
  for(;t+5<NT;t+=2){
    STEP(pB0,pB1,pA0,pA1,t,true,true,true);     WAIT_BAR(2); RESC(); ROT();
    STEP(pA0,pA1,pB0,pB1,t+1,true,true,true);   WAIT_BAR(2); RESC(); ROT();
  }
  #undef CMASK
  #define CMASK(P0,P1,t) do{int jb_=(t)-(NT-4); if(jb_>=0)cmask(P0,P1,jb_,qrel,hi);}while(0)
  #define ENDW(tt) do{ if((tt)+3<NT){WAIT_BAR(2);} else if((tt)+2<NT){WAIT_BAR(1);} else {WAIT_BAR(0);} }while(0)
  for(;t+1<NT;t+=2){
    STEP(pB0,pB1,pA0,pA1,t,(t+3<NT),(t+1<NT),(t+1<NT));       ENDW(t);   RESC(); ROT();
    STEP(pA0,pA1,pB0,pB1,t+1,(t+4<NT),(t+2<NT),(t+2<NT));     ENDW(t+1); RESC(); ROT();
  }
  STEP(pB0,pB1,pA0,pA1,NT-1,false,false,false); RESC();
  { float sacc=pB0[0]+pB0[1]; _Pragma("unroll") for(int r=2;r<16;++r)sacc+=pB0[r]; _Pragma("unroll") for(int r=0;r<16;++r)sacc+=pB1[r]; l_reg+=sacc;
    pw0=(u32x4){PKW(pB0,0),PKW(pB0,2),PKW(pB0,4),PKW(pB0,6)};pw1=(u32x4){PKW(pB0,8),PKW(pB0,10),PKW(pB0,12),PKW(pB0,14)};pw2=(u32x4){PKW(pB1,0),PKW(pB1,2),PKW(pB1,4),PKW(pB1,6)};pw3=(u32x4){PKW(pB1,8),PKW(pB1,10),PKW(pB1,12),PKW(pB1,14)};
    SBAR(); pv(o,vb0+sl_cur,PAF(0),PAF(1),PAF(2),PAF(3)); }
  #undef PKW
  #undef PAF
  #undef VFR
  #undef PIN
  #undef MX3
  #undef GAPA
  #undef GAPB
  #undef EX
  #undef VRD
  #undef KRD
  #undef STEP
  #undef ENDW
  {auto rr=__builtin_amdgcn_permlane32_swap(__float_as_uint(l_reg),__float_as_uint(l_reg),false,false);l_reg=__uint_as_float(rr[0])+__uint_as_float(rr[1]);}
  if(hi==0)wsf[32+r32]=l_reg;asm volatile("s_waitcnt lgkmcnt(0)":::"memory");
  float rli[16];
  #pragma unroll
  for(int r=0;r<16;++r)rli[r]=__builtin_amdgcn_rcpf(wsf[32+crow(r,hi)]);
  bf16*Ow=O+(rowbase+q0+wid*QBLK)*DM+h*D;
  { bf16*stg=(bf16*)(shm+LDS_OST)+wid*2048;
    #pragma unroll
    for(int r=0;r<16;++r){const int orow=crow(r,hi);
      #pragma unroll
      for(int d0=0;d0<2;++d0)stg[orow*64+d0*32+r32]=__float2bfloat16(o[d0][r]*rli[r]);}
    asm volatile("s_waitcnt lgkmcnt(0)":::"memory");
    #pragma unroll
    for(int i=0;i<4;++i){const int row=i*8+(lane>>3),ch=lane&7; const u32x4 v=*(const u32x4*)(stg+row*64+ch*8); ATTN_STORE16(Ow+(long)row*DM+ch*8,v);} }
  asm volatile("s_waitcnt lgkmcnt(0)\n\ts_barrier":::"memory");
  #undef DMA_K
  #undef DMA_V
  #undef CMASK
  #undef START
  #undef RESC
  #undef ROT
}
constexpr int ATTN_LDS_BYTES=LDS_BYTES;
#undef SBAR
#undef WAIT_BAR
}

#define LAS __attribute__((address_space(3)))
typedef unsigned short bf16;
typedef unsigned v4u __attribute__((ext_vector_type(4)));
typedef unsigned v2u __attribute__((ext_vector_type(2)));
typedef float f32x4 __attribute__((ext_vector_type(4)));
typedef float f32x16 __attribute__((ext_vector_type(16)));
typedef short bf16x8 __attribute__((ext_vector_type(8)));
typedef short s16x4 __attribute__((ext_vector_type(4)));
constexpr float RMS_EPS = 1e-6f;
constexpr int NWAVES = 8, NTHREADS = 512;
constexpr int M = 16384, DM = 2048, SEQ = 2048, MEMROWS = 2048, BIGP = 8192;
constexpr size_t MiB = 1u << 20;
constexpr size_t WS_SMALL = 0;
constexpr size_t WS_BAR = 1 * MiB;
constexpr size_t WS_W1 = 2 * MiB;
constexpr size_t WS_POOL = 18 * MiB;
constexpr size_t WS_WO0 = 20 * MiB, WS_WO1 = 28 * MiB;
constexpr size_t WS_W6 = 36 * MiB;
constexpr size_t WS_WF1 = 56 * MiB;
constexpr size_t WS_WF2 = 88 * MiB;
constexpr size_t WS_MKV = 120 * MiB;
constexpr size_t WS_XB = 128 * MiB;
constexpr size_t WS_BIG = 200 * MiB;
constexpr size_t WS_END = 456 * MiB;
constexpr int LDS_BYTES = 147456;

__device__ __forceinline__ unsigned f2bf(float f) { unsigned u = __builtin_bit_cast(unsigned, f); return (u + 0x7fffu + ((u >> 16) & 1u)) >> 16; }
__device__ __forceinline__ unsigned pk2(float lo, float hi) { return f2bf(lo) | (f2bf(hi) << 16); }
__device__ __forceinline__ float bflo(unsigned w) { return __builtin_bit_cast(float, w << 16); }
__device__ __forceinline__ float bfhi(unsigned w) { return __builtin_bit_cast(float, w & 0xffff0000u); }
#define LDS_WAIT() asm volatile("s_waitcnt lgkmcnt(0)" ::: "memory")
__device__ __forceinline__ float wave_sum(float v) {
#pragma unroll
    for (int o = 1; o < 64; o <<= 1) v += __shfl_xor(v, o);
    return v;
}

typedef unsigned gu32_unused_t;
#define RLX_AGENT __ATOMIC_RELAXED, __HIP_MEMORY_SCOPE_AGENT
#define XB_TMO      128
#define XB_XCNT(j)  (256  + 64 * (j))
#define XB_XSUB(j)  (1280 + 64 * (j))
#define XB_XGEN(j)  (2304 + 64 * (j))
#define XB_TOP      3328
#define XB_TOPGEN   3392
#define XCD_BAR_WORDS 3456
#define XB_SPIN_CAP (1u << 18)

__device__ __forceinline__ unsigned xb_ld(unsigned* p)              { return __hip_atomic_load(p, __ATOMIC_RELAXED, __HIP_MEMORY_SCOPE_AGENT); }
__device__ __forceinline__ unsigned xb_add(unsigned* p, unsigned v) { return __hip_atomic_fetch_add(p, v, __ATOMIC_RELAXED, __HIP_MEMORY_SCOPE_AGENT); }
__device__ __forceinline__ unsigned xb_xcc_id() { return (unsigned)__builtin_amdgcn_s_getreg((3 << 11) | 20) & 0xFu; }
#define XB_SPIN(cond, bar) do { unsigned _sp = 0; while (cond) { __builtin_amdgcn_s_sleep(1); \
    if ((++_sp & 255u) == 0u) { if (xb_ld(&(bar)[XB_TMO])) break; if (_sp > XB_SPIN_CAP) { atomicAdd(&(bar)[XB_TMO], 1u); break; } } } } while (0)

struct XcdBarrier {
    unsigned* bar; unsigned x;
    volatile LAS unsigned* st;
};

__device__ __forceinline__ XcdBarrier xcd_barrier_post(unsigned* bar, volatile LAS unsigned* st) {
    XcdBarrier b; b.bar = bar; b.x = xb_xcc_id(); b.st = st;
    if (threadIdx.x == 0) (void)xb_add(&bar[XB_XCNT(b.x)], 1u);
    return b;
}
__device__ __forceinline__ void xcd_barrier_complete(unsigned* bar, unsigned x, unsigned& nloc, unsigned& nx) {
    const unsigned G = gridDim.x * gridDim.y * gridDim.z;
    unsigned sum, cnt, mine, sp = 0u;
    for (;;) {
        sum = 0u; cnt = 0u; mine = 0u;
#pragma unroll
        for (unsigned j = 0; j < 16; ++j) { const unsigned c = xb_ld(&bar[XB_XCNT(j)]); sum += c; cnt += (c > 0u) ? 1u : 0u; mine = (j == x) ? c : mine; }
        if (sum == G) break;
        __builtin_amdgcn_s_sleep(1);
        if ((++sp & 255u) == 0u) { if (xb_ld(&bar[XB_TMO])) break; if (sp > XB_SPIN_CAP) { atomicAdd(&bar[XB_TMO], 1u); break; } }
    }
    nloc = mine > 0u ? mine : 1u; nx = cnt > 0u ? cnt : 1u;
}

__device__ __forceinline__ void xcd_barrier(const XcdBarrier& b) {
    asm volatile("s_waitcnt vmcnt(0)" ::: "memory");
    __syncthreads();
    if (threadIdx.x == 0) {
        unsigned* bar = b.bar;
        __builtin_amdgcn_s_waitcnt(0);
        unsigned nloc = b.st[0], nx = b.st[1];
        if (nloc == 0u) { xcd_barrier_complete(bar, b.x, nloc, nx); b.st[0] = nloc; b.st[1] = nx; }
        const unsigned old = xb_add(&bar[XB_XSUB(b.x)], 1u);
        const unsigned gen = old / nloc;
        if (old + 1u == (gen + 1u) * nloc) {
            __builtin_amdgcn_fence(__ATOMIC_RELEASE, "agent");
            asm volatile("s_waitcnt vmcnt(0)" ::: "memory");
            const unsigned og = xb_add(&bar[XB_TOP], 1u);
            const unsigned tg = og / nx;
            if (og + 1u == (tg + 1u) * nx) xb_add(&bar[XB_TOPGEN], 1u);
            else XB_SPIN(xb_ld(&bar[XB_TOPGEN]) == tg, bar);
            __builtin_amdgcn_fence(__ATOMIC_ACQUIRE, "agent");
            xb_add(&bar[XB_XGEN(b.x)], 1u);
            asm volatile("s_waitcnt vmcnt(0)" ::: "memory");
        } else {
            XB_SPIN(xb_ld(&bar[XB_XGEN(b.x)]) == gen, bar);
            __builtin_amdgcn_fence(__ATOMIC_ACQUIRE, "agent");
            asm volatile("s_waitcnt vmcnt(0)" ::: "memory");
        }
    }
    __syncthreads();
}


struct TJob { const float* W; int K, N; bf16* WT; int row_off; const float* kgain; const float* nscale; int kperm, sigma; };
__device__ __forceinline__ void transpose_item(const TJob& j, LAS float* scr, int item, int lane) {
    const int nblk = j.N / 32, kb = item / nblk, nb = item % nblk, k0 = 64 * kb, n0 = 32 * nb;
    const float ns = j.nscale ? j.nscale[n0 + (lane & 31)] : 1.0f;
    const float* wp = j.W + (size_t)(k0 + (lane >> 5)) * j.N + n0 + (lane & 31);
    float v[32];
#pragma unroll
    for (int i = 0; i < 32; ++i) v[i] = wp[(size_t)(2 * i) * j.N];
    const int c = lane & 7;
    f32x4 g0 = (f32x4){1.f, 1.f, 1.f, 1.f}, g1 = g0;
    if (j.kgain) { g0 = *(const f32x4*)(j.kgain + k0 + 8 * c); g1 = *(const f32x4*)(j.kgain + k0 + 8 * c + 4); }
#pragma unroll
    for (int i = 0; i < 32; ++i) scr[(2 * i + (lane >> 5)) * 33 + (lane & 31)] = v[i] * ns;
    LDS_WAIT(); asm volatile("" ::: "memory");
    const int kd = j.kperm ? ((k0 + 512) & 2047) : k0;
    int nd0 = n0;
    if (j.sigma) { const int tile = n0 >> 8, grp = (n0 & 255) >> 5; nd0 = tile * 256 + (4 * (grp & 1) + (grp >> 1)) * 32; }
#pragma unroll
    for (int jj = 0; jj < 4; ++jj) { const int n = (lane >> 3) + 8 * jj; const LAS float* s = scr + (8 * c) * 33 + n;
        v4u o; o.x = pk2(s[0 * 33] * g0.x, s[1 * 33] * g0.y); o.y = pk2(s[2 * 33] * g0.z, s[3 * 33] * g0.w); o.z = pk2(s[4 * 33] * g1.x, s[5 * 33] * g1.y); o.w = pk2(s[6 * 33] * g1.z, s[7 * 33] * g1.w);
        *(v4u*)(j.WT + (size_t)(j.row_off + nd0 + n) * j.K + kd + 8 * c) = o; }
    LDS_WAIT(); asm volatile("" ::: "memory");
}
__device__ __forceinline__ void run_tjob(const TJob& j, LAS float* scr, int gw, int NGW, int lane, int& cursor) {
    const int nitems = (j.K / 64) * (j.N / 32);
    int first = (gw - cursor % NGW + NGW) % NGW;
    for (int it = first; it < nitems; it += NGW) transpose_item(j, scr, it, lane);
    cursor += nitems;
}
__device__ __forceinline__ void row_to_bf16(const float* xrow, bf16* orow, float* rss, int lane) {
    const f32x4* xr = (const f32x4*)xrow + lane;
    f32x4 v[8]; float s = 0.f;
#pragma unroll
    for (int jx = 0; jx < 8; ++jx) { v[jx] = xr[64 * jx]; s += (v[jx].x * v[jx].x + v[jx].y * v[jx].y) + (v[jx].z * v[jx].z + v[jx].w * v[jx].w); }
    s = wave_sum(s);
    unsigned long long* o8 = (unsigned long long*)orow + lane;
#pragma unroll
    for (int jx = 0; jx < 8; ++jx) o8[64 * jx] = (unsigned long long)pk2(v[jx].x, v[jx].y) | ((unsigned long long)pk2(v[jx].z, v[jx].w) << 32);
    if (lane == 0) *rss = s;
}

constexpr int MA_KP = 272, MA_VP = 528;
constexpr int MA_K_OFF = 0, MA_V_OFF = 256 * MA_KP;
static_assert(MA_V_OFF + 128 * MA_VP <= 139264, "mem-attn LDS");
__device__ __forceinline__ void memattn_unit(bf16* qp, const bf16* kp, const bf16* vp, const float* qg, const float* kg, LAS unsigned char* lds, int wid, int lane) {
    __syncthreads();
    {
        const int c = lane & 15; f32x4 g0 = *(const f32x4*)(kg + 8 * c), g1 = *(const f32x4*)(kg + 8 * c + 4);
#pragma unroll 2
        for (int it = 0; it < 8; ++it) { const int r = it * 32 + wid * 4 + (lane >> 4);
            const v4u w = *(const v4u*)(kp + (size_t)r * 2048 + 8 * c);
            float f[8] ; f[0] = bflo(w.x); f[1] = bfhi(w.x); f[2] = bflo(w.y); f[3] = bfhi(w.y); f[4] = bflo(w.z); f[5] = bfhi(w.z); f[6] = bflo(w.w); f[7] = bfhi(w.w);
            float ss = 0.f;
#pragma unroll
            for (int e = 0; e < 8; ++e) ss += f[e] * f[e];
            ss += __shfl_xor(ss, 1); ss += __shfl_xor(ss, 2); ss += __shfl_xor(ss, 4); ss += __shfl_xor(ss, 8);
            const float rs = rsqrtf(ss * (1.0f / 128.0f) + RMS_EPS);
            v4u o; o.x = pk2(f[0] * rs * g0.x, f[1] * rs * g0.y); o.y = pk2(f[2] * rs * g0.z, f[3] * rs * g0.w); o.z = pk2(f[4] * rs * g1.x, f[5] * rs * g1.y); o.w = pk2(f[6] * rs * g1.z, f[7] * rs * g1.w);
            *(LAS v4u*)(lds + MA_K_OFF + r * MA_KP + 16 * c) = o; }
    }
    {
        const int kv = 64 * (wid & 3) + lane;
#pragma unroll 2
        for (int it = 0; it < 8; ++it) { const int c = 8 * (wid >> 2) + it;
            const v4u w = *(const v4u*)(vp + (size_t)kv * 2048 + 8 * c);
            LAS unsigned short* d = (LAS unsigned short*)(lds + MA_V_OFF + (8 * c) * MA_VP + 2 * kv);
            d[0 * (MA_VP / 2)] = (unsigned short)(w.x & 0xffffu); d[1 * (MA_VP / 2)] = (unsigned short)(w.x >> 16);
            d[2 * (MA_VP / 2)] = (unsigned short)(w.y & 0xffffu); d[3 * (MA_VP / 2)] = (unsigned short)(w.y >> 16);
            d[4 * (MA_VP / 2)] = (unsigned short)(w.z & 0xffffu); d[5 * (MA_VP / 2)] = (unsigned short)(w.z >> 16);
            d[6 * (MA_VP / 2)] = (unsigned short)(w.w & 0xffffu); d[7 * (MA_VP / 2)] = (unsigned short)(w.w >> 16); }
    }
    const int r32 = lane & 31, hh = lane >> 5;
    bf16* qrow = qp + (size_t)(wid * 32 + r32) * BIGP;
    bf16x8 qr[8];
    {
        v4u qw[8]; float ss = 0.f;
#pragma unroll
        for (int d0 = 0; d0 < 8; ++d0) { qw[d0] = *(const v4u*)(qrow + 16 * d0 + 8 * hh);
            const float a0 = bflo(qw[d0].x), a1 = bfhi(qw[d0].x), a2 = bflo(qw[d0].y), a3 = bfhi(qw[d0].y), a4 = bflo(qw[d0].z), a5 = bfhi(qw[d0].z), a6 = bflo(qw[d0].w), a7 = bfhi(qw[d0].w);
            ss += (a0 * a0 + a1 * a1) + (a2 * a2 + a3 * a3) + (a4 * a4 + a5 * a5) + (a6 * a6 + a7 * a7); }
        ss += __shfl_xor(ss, 32);
        const float rs = rsqrtf(ss * (1.0f / 128.0f) + RMS_EPS) * (0.08838834764831845f * 1.4426950408889634f);
#pragma unroll
        for (int d0 = 0; d0 < 8; ++d0) { const f32x4 g0 = *(const f32x4*)(qg + 16 * d0 + 8 * hh), g1 = *(const f32x4*)(qg + 16 * d0 + 8 * hh + 4);
            v4u o; o.x = pk2(bflo(qw[d0].x) * rs * g0.x, bfhi(qw[d0].x) * rs * g0.y); o.y = pk2(bflo(qw[d0].y) * rs * g0.z, bfhi(qw[d0].y) * rs * g0.w);
            o.z = pk2(bflo(qw[d0].z) * rs * g1.x, bfhi(qw[d0].z) * rs * g1.y); o.w = pk2(bflo(qw[d0].w) * rs * g1.z, bfhi(qw[d0].w) * rs * g1.w);
            qr[d0] = __builtin_bit_cast(bf16x8, o); }
    }
    __syncthreads();
    f32x16 o[4]; o[0] = f32x16{}; o[1] = f32x16{}; o[2] = f32x16{}; o[3] = f32x16{};
    float lsum = 0.f;
    const LAS unsigned char* kbase = lds + MA_K_OFF + r32 * MA_KP + 16 * hh;
    const LAS unsigned char* vbase = lds + MA_V_OFF + r32 * MA_VP + 8 * hh;
#pragma unroll 1
    for (int kb = 0; kb < 8; ++kb) {
        f32x16 x = f32x16{};
#pragma unroll
        for (int d0 = 0; d0 < 8; ++d0) { const bf16x8 kf = *(const LAS bf16x8*)(kbase + kb * 32 * MA_KP + 32 * d0);
            x = __builtin_amdgcn_mfma_f32_32x32x16_bf16(kf, qr[d0], x, 0, 0, 0); }
        float sacc = 0.f;
#pragma unroll
        for (int r = 0; r < 16; ++r) { x[r] = __builtin_amdgcn_exp2f(x[r]); sacc += x[r]; }
        lsum += sacc;
        v4u pw0, pw1;
        pw0.x = pk2(x[0], x[1]); pw0.y = pk2(x[2], x[3]); pw0.z = pk2(x[4], x[5]); pw0.w = pk2(x[6], x[7]);
        pw1.x = pk2(x[8], x[9]); pw1.y = pk2(x[10], x[11]); pw1.z = pk2(x[12], x[13]); pw1.w = pk2(x[14], x[15]);
        const bf16x8 p0 = __builtin_bit_cast(bf16x8, pw0), p1 = __builtin_bit_cast(bf16x8, pw1);
#pragma unroll
        for (int db = 0; db < 4; ++db) {
            const LAS unsigned char* vb = vbase + db * 32 * MA_VP + kb * 64;
            const v2u a0 = *(const LAS v2u*)(vb), a1 = *(const LAS v2u*)(vb + 16), b0 = *(const LAS v2u*)(vb + 32), b1 = *(const LAS v2u*)(vb + 48);
            v4u f0; f0.x = a0.x; f0.y = a0.y; f0.z = a1.x; f0.w = a1.y;
            v4u f1; f1.x = b0.x; f1.y = b0.y; f1.z = b1.x; f1.w = b1.y;
            o[db] = __builtin_amdgcn_mfma_f32_32x32x16_bf16(__builtin_bit_cast(bf16x8, f0), p0, o[db], 0, 0, 0);
            o[db] = __builtin_amdgcn_mfma_f32_32x32x16_bf16(__builtin_bit_cast(bf16x8, f1), p1, o[db], 0, 0, 0);
        }
    }
    lsum += __shfl_xor(lsum, 32);
    const float rl = 1.0f / lsum;
#pragma unroll
    for (int db = 0; db < 4; ++db)
#pragma unroll
        for (int g = 0; g < 4; ++g) { v2u w; w.x = pk2(o[db][4 * g] * rl, o[db][4 * g + 1] * rl); w.y = pk2(o[db][4 * g + 2] * rl, o[db][4 * g + 3] * rl);
            *(v2u*)(qrow + 32 * db + 8 * g + 4 * hh) = w; }
}
#ifdef DBGCHK
__device__ __forceinline__ float bf2f(bf16 v) { return __builtin_bit_cast(float, (unsigned)v << 16); }
__device__ __forceinline__ unsigned hsh(unsigned s, unsigned k) { unsigned h = s * 2654435761u + k * 40503u + 12345u; h ^= h >> 13; h *= 2246822519u; h ^= h >> 16; return h; }
__device__ __forceinline__ void chk(unsigned* flag, int stage, float got, float want, float tol) { if (!(fabsf(got - want) <= tol * (fabsf(want) + 1.0f))) atomicMin(flag, (unsigned)stage); }
__device__ __forceinline__ float row_rstd(const float* xr, int lane) { float s = 0.f; for (int k = lane; k < 2048; k += 64) s += xr[k] * xr[k]; s = wave_sum(s); return rsqrtf(s * (1.0f / 2048.0f) + RMS_EPS); }
__device__ __forceinline__ float row_dot(const float* xr, const float* g, const float* W, int ldw, int col, int lane) { float s = 0.f; for (int k = lane; k < 2048; k += 64) s += xr[k] * (g ? g[k] : 1.0f) * W[(size_t)k * ldw + col]; return wave_sum(s); }
__device__ __forceinline__ void chk_memattn(unsigned* flag, int stage, const float* xr, const float* g, const float* W, int ldw, int wcol, const bf16* kp, const bf16* vp, const float* qg, const float* kg, const bf16* got, LAS float* scr, int lane) {
    const float rs = row_rstd(xr, lane);
    for (int d = 0; d < 128; ++d) { const float v = row_dot(xr, g, W, ldw, wcol + d, lane) * rs; if (lane == 0) scr[d] = v; }
    LDS_WAIT();
    float ss = 0.f; for (int d = 0; d < 128; ++d) ss += scr[d] * scr[d];
    const float qr = rsqrtf(ss * (1.0f / 128.0f) + RMS_EPS);
    float sc[4], mx = -1e30f;
#pragma unroll
    for (int i = 0; i < 4; ++i) { const int j = lane + 64 * i; float ks = 0.f; for (int d = 0; d < 128; ++d) { const float kv = bf2f(kp[(size_t)j * 2048 + d]); ks += kv * kv; }
        const float kr = rsqrtf(ks * (1.0f / 128.0f) + RMS_EPS); float s = 0.f;
        for (int d = 0; d < 128; ++d) s += scr[d] * qr * qg[d] * bf2f(kp[(size_t)j * 2048 + d]) * kr * kg[d];
        sc[i] = s * 0.08838834764831845f; mx = fmaxf(mx, sc[i]); }
    for (int o = 1; o < 64; o <<= 1) mx = fmaxf(mx, __shfl_xor(mx, o));
    float l = 0.f;
#pragma unroll
    for (int i = 0; i < 4; ++i) { sc[i] = expf(sc[i] - mx); l += sc[i]; }
    l = wave_sum(l);
#pragma unroll
    for (int i = 0; i < 4; ++i) scr[128 + lane + 64 * i] = sc[i] / l;
    LDS_WAIT();
    for (int dd = 0; dd < 2; ++dd) { const int d = lane + 64 * dd; float o = 0.f; for (int j = 0; j < 256; ++j) o += scr[128 + j] * bf2f(vp[(size_t)j * 2048 + d]);
        chk(flag, stage, bf2f(got[d]), o, 0.05f); }
    LDS_WAIT();
}
__device__ __forceinline__ float naive_diff(const bf16* big, int row, int qcol, int kcol, int vcol, LAS float* scr, int lane) {
    const int b = row >> 11, t = row & 2047; const bf16* q = big + (size_t)row * BIGP + qcol;
    float mx = -1e30f;
    for (int j = lane; j <= t; j += 64) { const bf16* k = big + (size_t)(b * 2048 + j) * BIGP + kcol; float s = 0.f; for (int d = 0; d < 64; ++d) s += bf2f(q[d]) * bf2f(k[d]); scr[j] = s; mx = fmaxf(mx, s); }
    for (int o = 1; o < 64; o <<= 1) mx = fmaxf(mx, __shfl_xor(mx, o));
    float l = 0.f; for (int j = lane; j <= t; j += 64) { const float p = exp2f(scr[j] - mx); scr[j] = p; l += p; } l = wave_sum(l);
    LDS_WAIT();
    float o = 0.f; for (int j = 0; j <= t; ++j) o += scr[j] * bf2f(big[(size_t)(b * 2048 + j) * BIGP + vcol + lane]);
    LDS_WAIT();
    return o / l;
}
#endif
struct DiffUnit { int row, qb; };
__device__ __forceinline__ bool diff_next(int vcu, int G, int i, DiffUnit& u) {
    const int rep = i / 12, k = i - rep * 12; const int p = (vcu >> 1) + rep * (G >> 1); if (p >= 128) return false;
    const int role = vcu & 1;
    if (k < 8) { u.row = 3 * p + role; u.qb = 7 - k; }
    else { const int jx = k - 8; u.row = 3 * p + 2; u.qb = role == 0 ? ((jx & 1) ? (jx >> 1) : 7 - (jx >> 1)) : ((jx & 1) ? 2 + (jx >> 1) : 5 - (jx >> 1)); }
    return true;
}

struct Args { const float* in[20]; float* out; unsigned char* ws; int ph_lo, ph_hi; };

__global__ void __launch_bounds__(NTHREADS, 2) mega_fwd(Args args) {
    extern __shared__ __attribute__((aligned(16))) unsigned char lds_raw[];
    LAS unsigned char* lds = (LAS unsigned char*)lds_raw;
    cg::grid_group grid = cg::this_grid();
    { volatile LAS unsigned* st_ = (volatile LAS unsigned*)(lds + LDS_BYTES - 64); if (threadIdx.x < 2) st_[threadIdx.x] = 0u; __syncthreads();
      (void)xcd_barrier_post((unsigned*)(args.ws + WS_BAR), st_); }
#define TIDS() int tid_ = threadIdx.x; asm volatile("" : "+v"(tid_)); const int tid = tid_, lane = tid & 63, wid = __builtin_amdgcn_readfirstlane(tid >> 6); \
    int bx_ = blockIdx.x; asm volatile("" : "+s"(bx_)); const int bx = bx_, G = gridDim.x, vcu = (G % 8 == 0) ? (bx % 8) * (G / 8) + bx / 8 : bx, gw = vcu * NWAVES + wid, NGW = G * NWAVES; \
    LAS float* scr = (LAS float*)(lds + wid * 16384); (void)tid; (void)lane; (void)gw; (void)NGW; (void)scr; (void)vcu
    typedef const __attribute__((address_space(4))) Args* kargp_t;
#define KARG() kargp_t ap = (kargp_t)__builtin_amdgcn_kernarg_segment_ptr(); asm volatile("" : "+s"(ap)); unsigned char* ws = ap->ws; (void)ws
#define INP(k) (ap->in[k])
#define WSP(T, off) ((T*)(ws + (off)))
#define lamp WSP(float, WS_SMALL)
#define rss0 WSP(float, WS_SMALL + 65536)
#define rss1 WSP(float, WS_SMALL + 196608)
#define rss2 WSP(float, WS_SMALL + 262144)
#define rss3 WSP(float, WS_SMALL + 327680)
#define rope WSP(float, WS_SMALL + 524288)
#define W1 WSP(bf16, WS_W1)
#define WPOOL WSP(bf16, WS_POOL)
#define WO0 WSP(bf16, WS_WO0)
#define WO1 WSP(bf16, WS_WO1)
#define W6 WSP(bf16, WS_W6)
#define WF1 WSP(bf16, WS_WF1)
#define WF2 WSP(bf16, WS_WF2)
#define MKV WSP(bf16, WS_MKV)
#define XB WSP(bf16, WS_XB)
#define BIG WSP(bf16, WS_BIG)
#define DFLAG WSP(unsigned, WS_SMALL + 1024)
#define x_in INP(0)
#define mem_in INP(1)
#define mix_norm INP(2)
#define w_in INP(3)
#define w_out INP(4)
#define mem_norm INP(5)
#define w_mem_kv INP(6)
#define mem_q_norm INP(7)
#define mem_k_norm INP(8)
#define ffn_norm INP(9)
#define w_ff1 INP(10)
#define w_ff2 INP(11)
#define pool_w INP(12)
#define pool_scale INP(13)
#define kv_norm INP(14)
#define w_kv INP(15)
#define k_norm INP(16)
#define q_norm INP(17)
#define diff_lambda INP(18)
#define subln_norm INP(19)
#define out_p (ap->out)
#define IN(k) true
#define CGSYNC() do { asm volatile("s_waitcnt vmcnt(0) lgkmcnt(0)" ::: "memory"); grid.sync(); asm volatile("buffer_inv sc1\n\ts_waitcnt vmcnt(0)" ::: "memory"); } while (0)
#define GSYNC() do { kargp_t ap_ = (kargp_t)__builtin_amdgcn_kernarg_segment_ptr(); asm volatile("" : "+s"(ap_)); XcdBarrier b_; b_.bar = (unsigned*)(ap_->ws + WS_BAR); b_.x = xb_xcc_id(); \
    b_.st = (volatile LAS unsigned*)(lds + LDS_BYTES - 64); xcd_barrier(b_); } while (0)
#define SEAM(k) do { if (IN(k) && IN((k) + 1)) GSYNC(); } while (0)

    if (IN(0)) {
        KARG(); TIDS();
        int cursor = 0;
        { TJob j{w_in, 2048, 2048, W1, 0, mix_norm, nullptr, 0, 0}; run_tjob(j, scr, gw, NGW, lane, cursor); }
        { TJob j{w_mem_kv, 2048, 1024, W1, 2048, mem_norm, nullptr, 0, 0}; run_tjob(j, scr, gw, NGW, lane, cursor); }
        { TJob j{w_mem_kv + (size_t)2048 * 1024, 2048, 1024, W1, 3072, mem_norm + 2048, nullptr, 0, 0}; run_tjob(j, scr, gw, NGW, lane, cursor); }
#pragma unroll 1
        for (int g = 0; g < 4; ++g) { TJob j{pool_w + (size_t)g * 384 * 384, 384, 384, WPOOL, g * 512, nullptr, pool_scale + g * 384, 0, 0}; run_tjob(j, scr, gw, NGW, lane, cursor); }
        { TJob j{w_out, 2048, 2048, WO0, 0, nullptr, nullptr, 1, 0}; run_tjob(j, scr, gw, NGW, lane, cursor); }
        { TJob j{w_out + (size_t)2048 * 2048, 2048, 2048, WO1, 0, nullptr, nullptr, 1, 0}; run_tjob(j, scr, gw, NGW, lane, cursor); }
        { TJob j{w_kv, 2048, 3072, W6, 0, kv_norm, nullptr, 0, 1}; run_tjob(j, scr, gw, NGW, lane, cursor); }
        { TJob j{w_in + (size_t)2048 * 2048, 2048, 2048, W6, 3072, mix_norm + 2048, nullptr, 0, 1}; run_tjob(j, scr, gw, NGW, lane, cursor); }
        { TJob j{w_ff1, 2048, 8192, WF1, 0, ffn_norm, nullptr, 0, 0}; run_tjob(j, scr, gw, NGW, lane, cursor); }
        { TJob j{w_ff2, 8192, 2048, WF2, 0, nullptr, nullptr, 0, 0}; run_tjob(j, scr, gw, NGW, lane, cursor); }
        for (int i = gw * 64 + lane; i < 4 * 128 * 384 / 8; i += NGW * 64) { const int g = i / (128 * 48), r = i % (128 * 48); *(v4u*)(WPOOL + (size_t)(g * 512 + 384) * 384 + (size_t)r * 8) = (v4u){0u, 0u, 0u, 0u}; }
        for (int m = gw; m < M + MEMROWS; m += NGW) row_to_bf16(m < M ? x_in + (size_t)m * DM : mem_in + (size_t)(m - M) * DM, XB + (size_t)m * DM, rss0 + m, lane);
        for (int i = gw * 64 + lane; i < 3 * 16384; i += NGW * 64) rss1[i] = 0.f;
        for (int i = gw * 64 + lane; i < 2048 * 8; i += NGW * 64) { const int pos = i >> 3, fi = i & 7;
            const double invf = fi == 0 ? 1.0 : fi == 1 ? 0.19392274474868576 : fi == 2 ? 0.03760603093086393 : fi == 3 ? 0.007292664737217109 : fi == 4 ? 0.001414213562373095 : fi == 5 ? 0.0002742481756762073 : fi == 6 ? 5.318295896944988e-05 : 1.031338537721246e-05;
            double rev = (double)pos * invf * 0.15915494309189535; rev -= __builtin_rint(rev);
            rope[pos * 16 + fi] = __builtin_amdgcn_cosf((float)rev); rope[pos * 16 + 8 + fi] = __builtin_amdgcn_sinf((float)rev); }
#ifdef DBGCHK
        if (gw == 0 && lane == 0) DFLAG[0] = 0xffffffffu;
#endif
        if (gw == 0) { float a = diff_lambda[lane] * diff_lambda[64 + lane], b = diff_lambda[128 + lane] * diff_lambda[192 + lane]; a = wave_sum(a); b = wave_sum(b);
            if (lane == 0) lamp[0] = expf(a) - expf(b) + 0.35550906759096934f; }
    }
    CGSYNC();
    if (IN(1)) {
        KARG(); TIDS();
        pg8::GemmX g{XB, W1, M + MEMROWS, 4096, 2048, 2048, 2048}; pg8::SchedP1 S; S.init(G, bx);
        pg8::EpiP1 E{BIG, MKV, rss0};
        pg8::gemm_phase<pg8::EpiP1, pg8::SchedP1, true, true>(lds, g, S, E);
    }
    SEAM(1);
#ifdef DBGCHK
    { KARG(); TIDS(); if (gw < 64) { const int s_ = gw; (void)s_;
        { const int row = hsh(s_, 1) % 16384, col = hsh(s_, 2) % 2048; const float* xr = x_in + (size_t)row * 2048;
          const float want = row_dot(xr, mix_norm, w_in, 2048, col, lane) * row_rstd(xr, lane);
          chk(DFLAG, 1, bf2f(BIG[(size_t)row * BIGP + (col < 1536 ? col : 3072 + col - 1536)]), want, 0.03f); }
        { const int mrow = hsh(s_, 3) % 2048, mcol = hsh(s_, 4) % 2048, layer = mcol >> 10; const float* xr = mem_in + (size_t)mrow * 2048;
          const float want = row_dot(xr, mem_norm + layer * 2048, w_mem_kv + (size_t)layer * 2048 * 1024, 1024, mcol & 1023, lane) * row_rstd(xr, lane);
          chk(DFLAG, 2, bf2f(MKV[(size_t)mrow * 2048 + mcol]), want, 0.03f); }
    } GSYNC(); }
#endif

    if (IN(2)) {
        KARG(); TIDS();
        for (int it = gw; it < 3072; it += NGW) {
            const int span = it % 3, rb = it / 3, m0 = rb * 16, t0 = m0 & 2047;
            const int col = span * 512 + lane * 8; const int w = 2 << (col / 384);
            const bf16* src = BIG + (size_t)m0 * BIGP + col; bf16* dst = BIG + (size_t)m0 * BIGP + 1536 + col;
            float s[8];
#pragma unroll
            for (int e = 0; e < 8; ++e) s[e] = 0.f;
            if (t0 > 0) {
#pragma unroll 1
                for (int jx = 1; jx <= 16; ++jx) if (jx <= w) {     const v4u q = *(const v4u*)(src - (size_t)jx * BIGP);
                    s[0] += bflo(q.x); s[1] += bfhi(q.x); s[2] += bflo(q.y); s[3] += bfhi(q.y); s[4] += bflo(q.z); s[5] += bfhi(q.z); s[6] += bflo(q.w); s[7] += bfhi(q.w); }
            }
#pragma unroll 1
            for (int r = 0; r < 16; ++r) { const int t = t0 + r; const v4u q = *(const v4u*)(src + (size_t)r * BIGP);
                float c[8]; c[0] = bflo(q.x); c[1] = bfhi(q.x); c[2] = bflo(q.y); c[3] = bfhi(q.y); c[4] = bflo(q.z); c[5] = bfhi(q.z); c[6] = bflo(q.w); c[7] = bfhi(q.w);
#pragma unroll
                for (int e = 0; e < 8; ++e) s[e] += c[e];
                if (t >= w) { const v4u p = *(const v4u*)(src + (size_t)(r - w) * BIGP);
                    s[0] -= bflo(p.x); s[1] -= bfhi(p.x); s[2] -= bflo(p.y); s[3] -= bfhi(p.y); s[4] -= bflo(p.z); s[5] -= bfhi(p.z); s[6] -= bflo(p.w); s[7] -= bfhi(p.w); }
                const float ic = 1.0f / (float)((t + 1) < w ? (t + 1) : w);
                v4u o; o.x = pk2(s[0] * ic - c[0], s[1] * ic - c[1]); o.y = pk2(s[2] * ic - c[2], s[3] * ic - c[3]); o.z = pk2(s[4] * ic - c[4], s[5] * ic - c[5]); o.w = pk2(s[6] * ic - c[6], s[7] * ic - c[7]);
                *(v4u*)(dst + (size_t)r * BIGP) = o; }
        }
        for (int u = vcu; u < 256; u += G) { const int b = u >> 5, h = (u >> 3) & 3, qb = u & 7;
            memattn_unit(BIG + (size_t)(b * SEQ + qb * 256) * BIGP + 3072 + 128 * h, MKV + (size_t)(b * 256) * 2048 + 128 * h, MKV + (size_t)(b * 256) * 2048 + 512 + 128 * h, mem_q_norm, mem_k_norm, lds, wid, lane); }
        __syncthreads();
    }
    SEAM(2);
#ifdef DBGCHK
    { KARG(); TIDS(); if (gw < 64) { const int s_ = gw; (void)s_;
        { const int row = hsh(s_, 5) % 16384, col = hsh(s_, 6) % 1536, w = 2 << (col / 384), t = row & 2047; float sum = 0.f; const int n = (t + 1) < w ? (t + 1) : w;
          for (int j = 0; j < n; ++j) sum += bf2f(BIG[(size_t)(row - j) * BIGP + col]);
          const float want = sum / (float)n - bf2f(BIG[(size_t)row * BIGP + col]);
          chk(DFLAG, 3, bf2f(BIG[(size_t)row * BIGP + 1536 + col]), want, 0.03f); }
        if (s_ < 16) { const int row = hsh(s_, 7) % 16384, h = s_ & 3, b = row >> 11;
          chk_memattn(DFLAG, 4, x_in + (size_t)row * 2048, mix_norm, w_in, 2048, 1536 + 128 * h, MKV + (size_t)(b * 256) * 2048 + 128 * h, MKV + (size_t)(b * 256) * 2048 + 512 + 128 * h,
                      mem_q_norm, mem_k_norm, BIG + (size_t)row * BIGP + 3072 + 128 * h, scr, lane); }
    } GSYNC(); }
#endif

    if (IN(3)) {
        KARG(); TIDS();
        pg8::GemmX g{BIG + 1536, WPOOL, M, 2048, 384, BIGP, 384}; pg8::SchedPool S; S.init(G, bx);
        pg8::EpiPool E{BIG};
        pg8::gemm_phase<pg8::EpiPool, pg8::SchedPool, true, true>(lds, g, S, E);
    }
    SEAM(3);
#ifdef DBGCHK
    { KARG(); TIDS(); if (gw < 64) { const int s_ = gw; (void)s_;
        { const int row = hsh(s_, 8) % 16384, col = hsh(s_, 9) % 1536, g = col / 384, d = col % 384; float sum = 0.f;
          for (int c = lane; c < 384; c += 64) sum += bf2f(BIG[(size_t)row * BIGP + 1536 + 384 * g + c]) * pool_w[((size_t)g * 384 + c) * 384 + d];
          const float want = wave_sum(sum) * pool_scale[col];
          chk(DFLAG, 5, bf2f(BIG[(size_t)row * BIGP + 3584 + col]), want, 0.03f); }
    } GSYNC(); }
#endif

#pragma unroll 1
    for (int layer = 0; layer < 2; ++layer) {
        const int pb = 4 + layer * 10;
        if (layer == 1) {
            if (IN(11)) {
                KARG(); TIDS();
                pg8::GemmX g{XB, W6, M, 5120, 2048, 2048, 2048}; pg8::SchedStd S; S.init(M, 5120, G, bx);
                pg8::EpiP6 E{BIG, rss2, k_norm, q_norm, rope};
                pg8::gemm_phase<pg8::EpiP6, pg8::SchedStd, true, true>(lds, g, S, E);
            }
            SEAM(11);
#ifdef DBGCHK
            { KARG(); TIDS(); if (gw < 64) { const int s_ = gw;
              const int row = hsh(s_, 14) % 16384, hh = hsh(s_, 15) % 12, kind = s_ & 3; const float* xr = out_p + (size_t)row * 2048; const float rs = row_rstd(xr, lane);
              const float* Wp = kind == 2 ? w_in + (size_t)2048 * 2048 : w_kv; const float* gp = kind == 2 ? mix_norm + 2048 : kv_norm; const int ldw = kind == 2 ? 2048 : 3072;
              const int wcol = (kind == 0 ? 0 : kind == 1 ? 768 : kind == 2 ? 768 : 1536) + hh * 64; const int bcol = (kind == 0 ? 0 : kind == 1 ? 768 : kind == 2 ? 3840 : 1536) + hh * 64;
              for (int d = 0; d < 64; ++d) { const float v = row_dot(xr, gp, Wp, ldw, wcol + d, lane) * rs; if (lane == 0) scr[d] = v; }
              LDS_WAIT();
              float y = scr[lane];
              if (kind != 3) { float ss = 0.f; for (int d = 0; d < 64; ++d) ss += scr[d] * scr[d]; const float r = rsqrtf(ss * (1.0f / 64.0f) + RMS_EPS);
                y = y * r * (kind == 2 ? q_norm[lane] * (0.125f * 1.4426950408889634f) : k_norm[lane]); scr[64 + lane] = y; LDS_WAIT();
                if (lane < 16) { const int i = lane & 7; const float c = rope[(size_t)(row & 2047) * 16 + i], sn = rope[(size_t)(row & 2047) * 16 + 8 + i];
                  y = lane < 8 ? scr[64 + lane] * c - scr[64 + lane + 8] * sn : scr[64 + lane - 8] * sn + scr[64 + lane] * c; } }
              chk(DFLAG, 9, bf2f(BIG[(size_t)row * BIGP + bcol + lane]), y, 0.03f);
              LDS_WAIT();
            } GSYNC(); }
#endif

            if (IN(12)) {
                KARG(); TIDS();
                DiffUnit du;
                for (int i = 0; diff_next(vcu, G, i, du); ++i) {
                    const int b = du.row / 48, vh = du.row % 48, h = vh >> 2, map = (vh >> 1) & 1, half = vh & 1;
                    attn_body::attn_unit<8>(b, 0, du.qb, (const attn_body::bf16*)(BIG + 3072 + map * 768 + h * 64), (const attn_body::bf16*)(BIG + map * 768 + h * 64),
                                            (const attn_body::bf16*)(BIG + 1536 + h * 128 + half * 64), (attn_body::bf16*)(BIG + 5120 + map * 1536 + h * 128 + half * 64), (char*)lds_raw);
                }
                for (int u = vcu; u < 256; u += G) { const int b = u >> 5, h = (u >> 3) & 3, qb = u & 7;
                    memattn_unit(BIG + (size_t)(b * SEQ + qb * 256) * BIGP + 4608 + 128 * h, MKV + (size_t)(b * 256) * 2048 + 1024 + 128 * h, MKV + (size_t)(b * 256) * 2048 + 1536 + 128 * h,
                                 mem_q_norm + 128, mem_k_norm + 128, lds, wid, lane); }
                __syncthreads();
            }
            SEAM(12);
#ifdef DBGCHK
            { KARG(); TIDS(); if (gw < 64) { const int s_ = gw;
              { const int row = hsh(s_, 16) % 16384, hh = hsh(s_, 17) % 12, map = s_ & 1, half = (s_ >> 1) & 1;
                const float o = naive_diff(BIG, row, 3072 + map * 768 + hh * 64, map * 768 + hh * 64, 1536 + hh * 128 + half * 64, scr, lane);
                chk(DFLAG, 10, bf2f(BIG[(size_t)row * BIGP + 5120 + map * 1536 + hh * 128 + half * 64 + lane]), o, 0.03f); }
              if (s_ < 16) { const int row = hsh(s_, 18) % 16384, h = s_ & 3, b = row >> 11;
                chk_memattn(DFLAG, 11, out_p + (size_t)row * 2048, mix_norm + 2048, w_in + (size_t)2048 * 2048, 2048, 1536 + 128 * h, MKV + (size_t)(b * 256) * 2048 + 1024 + 128 * h, MKV + (size_t)(b * 256) * 2048 + 1536 + 128 * h,
                            mem_q_norm + 128, mem_k_norm + 128, BIG + (size_t)row * BIGP + 4608 + 128 * h, scr, lane); }
            } GSYNC(); }
#endif

            if (IN(13)) {
                KARG(); TIDS();
                const float lam = lamp[0]; const int sub = lane >> 4, c = lane & 15;
                const f32x4 g0 = *(const f32x4*)(subln_norm + 8 * c) * (1.0f - 0.35550906759096934f), g1 = *(const f32x4*)(subln_norm + 8 * c + 4) * (1.0f - 0.35550906759096934f);
                for (int idx = gw * 4 + sub; idx < M * 12; idx += NGW * 4) { const int row = idx / 12, h = idx - row * 12;
                    bf16* pa = BIG + (size_t)row * BIGP + 5120 + h * 128 + 8 * c;
                    const v4u a = *(const v4u*)pa, bq = *(const v4u*)(pa + 1536);
                    float f[8]; f[0] = bflo(a.x) - lam * bflo(bq.x); f[1] = bfhi(a.x) - lam * bfhi(bq.x); f[2] = bflo(a.y) - lam * bflo(bq.y); f[3] = bfhi(a.y) - lam * bfhi(bq.y);
                    f[4] = bflo(a.z) - lam * bflo(bq.z); f[5] = bfhi(a.z) - lam * bfhi(bq.z); f[6] = bflo(a.w) - lam * bflo(bq.w); f[7] = bfhi(a.w) - lam * bfhi(bq.w);
                    float ss = 0.f;
#pragma unroll
                    for (int e = 0; e < 8; ++e) ss += f[e] * f[e];
                    ss += __shfl_xor(ss, 1); ss += __shfl_xor(ss, 2); ss += __shfl_xor(ss, 4); ss += __shfl_xor(ss, 8);
                    const float rs = rsqrtf(ss * (1.0f / 128.0f) + RMS_EPS);
                    v4u o; o.x = pk2(f[0] * rs * g0.x, f[1] * rs * g0.y); o.y = pk2(f[2] * rs * g0.z, f[3] * rs * g0.w); o.z = pk2(f[4] * rs * g1.x, f[5] * rs * g1.y); o.w = pk2(f[6] * rs * g1.z, f[7] * rs * g1.w);
                    *(v4u*)pa = o; }
                int cursor = 0;
                { TJob j{w_ff1 + (size_t)2048 * 8192, 2048, 8192, WF1, 0, ffn_norm + 2048, nullptr, 0, 0}; run_tjob(j, scr, gw, NGW, lane, cursor); }
                { TJob j{w_ff2 + (size_t)8192 * 2048, 8192, 2048, WF2, 0, nullptr, nullptr, 0, 0}; run_tjob(j, scr, gw, NGW, lane, cursor); }
            }
            SEAM(13);
#ifdef DBGCHK
            { KARG(); TIDS(); if (gw < 64) { const int s_ = gw;
              const int row = hsh(s_, 19) % 16384, hh = hsh(s_, 20) % 12;
              float la = 0.f, lb = 0.f; for (int i = 0; i < 64; ++i) { la += diff_lambda[i] * diff_lambda[64 + i]; lb += diff_lambda[128 + i] * diff_lambda[192 + i]; }
              const float lam = expf(la) - expf(lb) + 0.35550906759096934f; chk(DFLAG, 13, lamp[0], lam, 0.001f);
              const float a0 = naive_diff(BIG, row, 3072 + hh * 64, hh * 64, 1536 + hh * 128, scr, lane) - lam * naive_diff(BIG, row, 3840 + hh * 64, 768 + hh * 64, 1536 + hh * 128, scr, lane);
              const float a1 = naive_diff(BIG, row, 3072 + hh * 64, hh * 64, 1536 + hh * 128 + 64, scr, lane) - lam * naive_diff(BIG, row, 3840 + hh * 64, 768 + hh * 64, 1536 + hh * 128 + 64, scr, lane);
              const float r = rsqrtf(wave_sum(a0 * a0 + a1 * a1) * (1.0f / 128.0f) + RMS_EPS);
              chk(DFLAG, 12, bf2f(BIG[(size_t)row * BIGP + 5120 + hh * 128 + lane]), a0 * r * subln_norm[lane] * (1.0f - 0.35550906759096934f), 0.03f);
              chk(DFLAG, 12, bf2f(BIG[(size_t)row * BIGP + 5120 + hh * 128 + 64 + lane]), a1 * r * subln_norm[64 + lane] * (1.0f - 0.35550906759096934f), 0.03f);
            } GSYNC(); }
#endif

        }
        if (IN(pb)) {
            KARG(); TIDS();
            pg8::GemmX g{BIG + (layer == 0 ? 3072 : 4608), layer == 0 ? WO0 : WO1, M, 2048, 2048, BIGP, 2048}; pg8::SchedStd S; S.init(M, 2048, G, bx);
            pg8::EpiResid E{layer == 0 ? x_in : out_p, out_p, XB, layer == 0 ? rss1 : rss3};
            pg8::gemm_phase<pg8::EpiResid, pg8::SchedStd, true, true>(lds, g, S, E);
        }
        SEAM(pb);
#ifdef DBGCHK
        if (layer == 0) { KARG(); TIDS(); if (gw < 64) { const int s_ = gw;
          const int row = hsh(s_, 10) % 16384, col = hsh(s_, 11) % 2048; float sum = 0.f;
          for (int k = lane; k < 2048; k += 64) sum += bf2f(BIG[(size_t)row * BIGP + (k < 1536 ? 3584 + k : 3072 + k - 1536)]) * w_out[(size_t)k * 2048 + col];
          const float want = x_in[(size_t)row * 2048 + col] + wave_sum(sum);
          chk(DFLAG, 6, out_p[(size_t)row * 2048 + col], want, 0.01f);
          chk(DFLAG, 7, bf2f(XB[(size_t)row * 2048 + col]), out_p[(size_t)row * 2048 + col], 0.01f);
          const float r1 = row_rstd(out_p + (size_t)row * 2048, lane); chk(DFLAG, 7, pg8::rstd2048(rss1, row), r1, 0.001f);
        } GSYNC(); }
#endif

        if (IN(pb + 1)) {
            KARG(); TIDS();
            pg8::GemmX g{XB, WF1, M, 8192, 2048, 2048, 2048}; pg8::SchedStd S; S.init(M, 8192, G, bx);
            pg8::EpiRelu2 E{BIG, layer == 0 ? rss1 : rss3};
            pg8::gemm_phase<pg8::EpiRelu2, pg8::SchedStd, true, true>(lds, g, S, E);
        }
        SEAM(pb + 1);
#ifdef DBGCHK
        { KARG(); TIDS(); if (gw < 64) { const int s_ = gw;
          const int row = hsh(s_, 12) % 16384, col = hsh(s_, 13) % 8192; const float* xr = out_p + (size_t)row * 2048;
          float v = row_dot(xr, ffn_norm + layer * 2048, w_ff1 + (size_t)layer * 2048 * 8192, 8192, col, lane) * row_rstd(xr, lane); v = fmaxf(v, 0.f); v *= v;
          chk(DFLAG, layer == 0 ? 8 : 15, bf2f(BIG[(size_t)row * BIGP + col]), v, 0.03f);
        } GSYNC(); }
#endif

        if (IN(pb + 2)) {
            KARG(); TIDS();
            pg8::GemmX g{BIG, WF2, M, 2048, 8192, BIGP, 8192}; pg8::SchedStd S; S.init(M, 2048, G, bx);
            pg8::EpiResid E{out_p, out_p, layer == 0 ? XB : nullptr, layer == 0 ? rss2 : nullptr};
            pg8::gemm_phase<pg8::EpiResid, pg8::SchedStd, true, true>(lds, g, S, E);
        }
        if (layer == 0) { if (IN(6) && IN(11)) GSYNC(); }
    }
#ifdef DBGCHK
    { GSYNC(); KARG(); if (blockIdx.x == 0 && threadIdx.x == 0) { const unsigned f = DFLAG[0]; if (f != 0xffffffffu) out_p[0] = 100.0f * (float)f; } }
#endif
#undef IN
#undef SEAM
#undef rope
#undef lamp
}

extern "C" void kernel_launch(void* const* d_in, const int* in_sizes, int n_in, void* d_out, int out_size, void* d_ws, size_t ws_size, hipStream_t stream) {
    static int grid = 0;
    if (grid == 0) {
        if (n_in != 20 || out_size != M * DM || ws_size < WS_END) { fprintf(stderr, "kernel_launch: unexpected shapes (n_in %d out %d ws %zu)\n", n_in, out_size, ws_size); grid = -1; return; }
        int dev = 0, cus = 0, per_cu = 0;
        (void)hipGetDevice(&dev); (void)hipDeviceGetAttribute(&cus, hipDeviceAttributeMultiprocessorCount, dev);
        if (hipFuncSetAttribute((const void*)mega_fwd, hipFuncAttributeMaxDynamicSharedMemorySize, LDS_BYTES) != hipSuccess) { fprintf(stderr, "kernel_launch: hipFuncSetAttribute failed\n"); grid = -1; return; }
        (void)hipOccupancyMaxActiveBlocksPerMultiprocessor(&per_cu, (const void*)mega_fwd, NTHREADS, LDS_BYTES);
        (void)hipGetLastError();
        if (per_cu < 1) { fprintf(stderr, "kernel_launch: occupancy query says %d blocks per CU\n", per_cu); per_cu = 1; }
        grid = cus * 1;
        fprintf(stderr, "kernel_launch: grid %d (cus %d, per_cu %d), ws %zu\n", grid, cus, per_cu, ws_size);
    }
    if (grid < 0) return;
    if (hipMemsetAsync((char*)d_ws + WS_BAR, 0, 16384, stream) != hipSuccess) { fprintf(stderr, "kernel_launch: memset failed\n"); return; }
    Args a{};
    for (int i = 0; i < 20; ++i) a.in[i] = (const float*)d_in[i];
    a.out = (float*)d_out; a.ws = (unsigned char*)d_ws; a.ph_lo = 0; a.ph_hi = 100;
    void* kargs[] = {&a};
    hipError_t e = hipLaunchCooperativeKernel((const void*)mega_fwd, dim3(grid), dim3(NTHREADS), kargs, LDS_BYTES, stream);
    if (e != hipSuccess) fprintf(stderr, "kernel_launch: cooperative launch failed: %s (grid %d)\n", hipGetErrorString(e), grid);
}
```

```cpp
#include <hip/hip_runtime.h>
#include <hip/hip_cooperative_groups.h>
#include <cstdio>
#include <cstdint>
namespace cg = cooperative_groups;
namespace pg8 {
#define PG8_LAS __attribute__((address_space(3)))
typedef unsigned short bf16_t;
typedef short bf16x8 __attribute__((ext_vector_type(8)));
typedef float f32x4 __attribute__((ext_vector_type(4)));
typedef unsigned u32x4 __attribute__((ext_vector_type(4)));
constexpr int BM = 256, BK = 64, HALF = 128, HTB = HALF * BK * 2  , STAGE_BYTES = 8 * HTB, NXCD = 8, WGM = 8;

__host__ __device__ __forceinline__ int lds_byte(int r, int c) { const int st = (r >> 4) * 2 + (c >> 5), rr = r & 15, cc = c & 31, ob = rr * 64 + cc * 2; return st * 1024 + (ob ^ (((ob >> 9) & 1) << 5)); }
__host__ __device__ __forceinline__ void stage_rc(int b, int& R, int& C) { const int st = b / 1024, sb = b % 1024, swz = sb ^ (((sb >> 9) & 1) << 5); R = (st >> 1) * 16 + swz / 64; C = (st & 1) * 32 + (swz % 64) / 2; }
__host__ __device__ __forceinline__ int perm32(int rho) { const int n = rho >> 4, i = rho & 15; return 8 * (i >> 2) + 4 * n + (i & 3); }

struct Unit { int pm, pn; };
struct Gemm { const bf16_t* A; const bf16_t* Bt; int M, N, K; };

struct StaticOrder {
    int nM, nN, nwg, G, c, wgm;
    __host__ __device__ void init(int M, int N, int G_, int c_, int wgm_ = WGM) { nM = M / BM; nN = N / BM; nwg = nM * nN; G = G_; c = c_; wgm = wgm_; }
    __host__ __device__ bool next(int i, Unit& u) const {
        const long L = (long)i * G + c; if (L >= nwg) return false;
        int wgid = (int)L; { const int q = nwg / NXCD, r = nwg % NXCD, xcd = wgid % NXCD, off = wgid / NXCD; wgid = (xcd < r ? xcd * (q + 1) : r * (q + 1) + (xcd - r) * q) + off; }
        const int nig = wgm * nN, gid = wgid / nig, fm = gid * wgm, gsz = (nM - fm) < wgm ? (nM - fm) : wgm;
        u.pm = fm + ((wgid % nig) % gsz); u.pn = (wgid % nig) / gsz; return true;
    }
    __device__ __forceinline__ void a_ready(const Unit&) const {}
    __device__ __forceinline__ void done(const Unit&) const {}
};

__device__ __forceinline__ unsigned cvt_pk_bf16(float lo, float hi) { unsigned r; asm volatile("v_cvt_pk_bf16_f32 %0, %1, %2" : "=v"(r) : "v"(lo), "v"(hi)); return r; }
typedef float f32x2 __attribute__((ext_vector_type(2)));
struct GemmX { const bf16_t* A; const bf16_t* Bt; int M, N, K, lda, ldb; };
struct SchedStd : StaticOrder {
    __device__ __forceinline__ const char* a_ptr(const GemmX& g, const Unit& u) const { return (const char*)g.A + (size_t)u.pm * BM * g.lda * 2; }
    __device__ __forceinline__ const char* b_ptr(const GemmX& g, const Unit& u) const { return (const char*)g.Bt + (size_t)u.pn * BM * g.ldb * 2; }
};
struct SchedMem {
    int c;
    __device__ void init(int c_) { c = c_; }
    __device__ bool next(int i, Unit& u) const { if (i > 0 || c >= 64) return false; u.pm = 64 + (c >> 3); u.pn = 8 + (c & 7); return true; }
    __device__ __forceinline__ void a_ready(const Unit&) const {}
    __device__ __forceinline__ void done(const Unit&) const {}
    __device__ __forceinline__ const char* a_ptr(const GemmX& g, const Unit& u) const { return (const char*)g.A + (size_t)u.pm * BM * g.lda * 2; }
    __device__ __forceinline__ const char* b_ptr(const GemmX& g, const Unit& u) const { return (const char*)g.Bt + (size_t)u.pn * BM * g.ldb * 2; }
};
struct SchedPool {
    int G, c;
    __device__ void init(int G_, int c_) { G = G_; c = c_; }
    __device__ bool next(int i, Unit& u) const {
        const int L = i * G + c; if (L >= 512) return false;
        u.pm = (L >> 1) & 63; u.pn = ((L >> 7) << 1) | (L & 1); return true;
    }
    __device__ __forceinline__ void a_ready(const Unit&) const {}
    __device__ __forceinline__ void done(const Unit&) const {}
    __device__ __forceinline__ const char* a_ptr(const GemmX& g, const Unit& u) const { return (const char*)g.A + ((size_t)u.pm * BM * g.lda + (size_t)(u.pn >> 1) * 384) * 2; }
    __device__ __forceinline__ const char* b_ptr(const GemmX& g, const Unit& u) const { return (const char*)g.Bt + (size_t)u.pn * BM * g.ldb * 2; }
};

typedef unsigned u32x2 __attribute__((ext_vector_type(2)));
constexpr float RMS_EPS = 1e-6f;
constexpr int BIGP_ = 8256;
__device__ __forceinline__ float rstd2048(const float* rss, int row) { return rsqrtf(rss[row] * (1.0f / 2048.0f) + RMS_EPS); }
struct RowScale {
    PG8_LAS const float* tab; int pm0; const float* part;
    __device__ __forceinline__ float get(int pm, int rloc) const { return tab[rloc]; }
};

struct EpiP1 {
    static constexpr bool PERM = true, AFTER_DRAIN = false;
    bf16_t* big; bf16_t* mkv; const float* rss;
    __device__ __forceinline__ void operator()(const f32x4 (&acc)[2][2][4][2], const Unit& u, int wr, int wc, int fr, int fq) const {
        const int row0 = u.pm * BM + wr * 64 + fr;
        bf16_t* base; size_t ld;
        if (u.pm < 64) { ld = BIGP_; base = big + (u.pn < 6 ? u.pn * 256 : 3072 + (u.pn - 6) * 256); }
        else { ld = 2048; base = mkv - (size_t)16384 * 2048 + (u.pn - 8) * 256; }
        base += wc * 32 + 8 * fq;
#pragma unroll
        for (int ai = 0; ai < 2; ++ai)
#pragma unroll
            for (int m = 0; m < 4; ++m) { const int row = row0 + ai * HALF + m * 16; const float sc = rstd2048(rss, row); bf16_t* rowp = base + (size_t)row * ld;
#pragma unroll
                for (int bj = 0; bj < 2; ++bj) { const f32x4 v0 = acc[ai][bj][m][0] * sc, v1 = acc[ai][bj][m][1] * sc;
                    u32x4 w; w.x = cvt_pk_bf16(v0[0], v0[1]); w.y = cvt_pk_bf16(v0[2], v0[3]); w.z = cvt_pk_bf16(v1[0], v1[1]); w.w = cvt_pk_bf16(v1[2], v1[3]);
                    *(u32x4*)(rowp + bj * HALF) = w; } }
    }
};
struct EpiPool {
    static constexpr bool PERM = true, AFTER_DRAIN = false;
    bf16_t* big;
    __device__ __forceinline__ void operator()(const f32x4 (&acc)[2][2][4][2], const Unit& u, int wr, int wc, int fr, int fq) const {
        const int row0 = u.pm * BM + wr * 64 + fr; const int g = u.pn >> 1, half = u.pn & 1;
        bf16_t* base = big + 3584 + g * 384 + half * 256 + wc * 32 + 8 * fq;
#pragma unroll
        for (int ai = 0; ai < 2; ++ai)
#pragma unroll
            for (int m = 0; m < 4; ++m) { bf16_t* rowp = base + (size_t)(row0 + ai * HALF + m * 16) * BIGP_;
#pragma unroll
                for (int bj = 0; bj < 2; ++bj) { if (bj == 1 && half == 1) continue;
                    const f32x4 v0 = acc[ai][bj][m][0], v1 = acc[ai][bj][m][1];
                    u32x4 w; w.x = cvt_pk_bf16(v0[0], v0[1]); w.y = cvt_pk_bf16(v0[2], v0[3]); w.z = cvt_pk_bf16(v1[0], v1[1]); w.w = cvt_pk_bf16(v1[2], v1[3]);
                    *(u32x4*)(rowp + bj * HALF) = w; } }
    }
};
struct EpiRelu2 {
    static constexpr bool PERM = true, AFTER_DRAIN = false;
    bf16_t* big; RowScale rs;
    __device__ __forceinline__ void operator()(const f32x4 (&acc)[2][2][4][2], const Unit& u, int wr, int wc, int fr, int fq) const {
        const int row0 = u.pm * BM + wr * 64 + fr;
        bf16_t* base = big + u.pn * BM + wc * 32 + 8 * fq;
#pragma unroll
        for (int ai = 0; ai < 2; ++ai)
#pragma unroll
            for (int m = 0; m < 4; ++m) { const int row = row0 + ai * HALF + m * 16; const float sc = rs.get(u.pm, wr * 64 + fr + ai * HALF + m * 16); bf16_t* rowp = base + (size_t)row * BIGP_;
#pragma unroll
                for (int bj = 0; bj < 2; ++bj) { f32x4 v0 = acc[ai][bj][m][0] * sc, v1 = acc[ai][bj][m][1] * sc;
#pragma unroll
                    for (int e = 0; e < 4; ++e) { v0[e] = fmaxf(v0[e], 0.f); v0[e] *= v0[e]; v1[e] = fmaxf(v1[e], 0.f); v1[e] *= v1[e]; }
                    u32x4 w; w.x = cvt_pk_bf16(v0[0], v0[1]); w.y = cvt_pk_bf16(v0[2], v0[3]); w.z = cvt_pk_bf16(v1[0], v1[1]); w.w = cvt_pk_bf16(v1[2], v1[3]);
                    *(u32x4*)(rowp + bj * HALF) = w; } }
    }
};
struct EpiResid {
    static constexpr bool PERM = true, AFTER_DRAIN = false;
    const float* base_f32; float* out_f32; bf16_t* xb; float* rss_out;
    __device__ __forceinline__ void finish(const f32x4& o0, const f32x4& o1, size_t off, float& ss) const {
        if (out_f32) { *(f32x4*)(out_f32 + off) = o0; *(f32x4*)(out_f32 + off + 4) = o1; }
        else { u32x4 w; w.x = cvt_pk_bf16(o0[0], o0[1]); w.y = cvt_pk_bf16(o0[2], o0[3]); w.z = cvt_pk_bf16(o1[0], o1[1]); w.w = cvt_pk_bf16(o1[2], o1[3]); *(u32x4*)(xb + off) = w; }
        ss += ((o0[0] * o0[0] + o0[1] * o0[1]) + (o0[2] * o0[2] + o0[3] * o0[3])) + ((o1[0] * o1[0] + o1[1] * o1[1]) + (o1[2] * o1[2] + o1[3] * o1[3]));
    }
    __device__ __forceinline__ void operator()(const f32x4 (&acc)[2][2][4][2], const Unit& u, int wr, int wc, int fr, int fq) const {
        const int row0 = u.pm * BM + wr * 64 + fr; const int col0 = u.pn * BM + wc * 32 + 8 * fq;
        if (base_f32) {
#pragma unroll
            for (int ai = 0; ai < 2; ++ai) {
                f32x4 bs[4][2][2];
#pragma unroll
                for (int m = 0; m < 4; ++m)
#pragma unroll
                    for (int bj = 0; bj < 2; ++bj)
#pragma unroll
                        for (int n = 0; n < 2; ++n) bs[m][bj][n] = *(const f32x4*)(base_f32 + (size_t)(row0 + ai * HALF + m * 16) * 2048 + col0 + bj * HALF + n * 4);
#pragma unroll
                for (int m = 0; m < 4; ++m) { const int row = row0 + ai * HALF + m * 16; const size_t off = (size_t)row * 2048 + col0; float ss = 0.f;
#pragma unroll
                    for (int bj = 0; bj < 2; ++bj) finish(bs[m][bj][0] + acc[ai][bj][m][0], bs[m][bj][1] + acc[ai][bj][m][1], off + bj * HALF, ss);
                    if (rss_out) { ss += __shfl_xor(ss, 16); ss += __shfl_xor(ss, 32); if (fq == 0) rss_out[(size_t)(u.pn * 4 + wc) * 16384 + row] = ss; } }
                asm volatile("" ::: "memory");
            }
        } else {
            u32x4 bs[2][4][2];
#pragma unroll
            for (int ai = 0; ai < 2; ++ai)
#pragma unroll
                for (int m = 0; m < 4; ++m)
#pragma unroll
                    for (int bj = 0; bj < 2; ++bj) bs[ai][m][bj] = *(const u32x4*)(xb + (size_t)(row0 + ai * HALF + m * 16) * 2048 + col0 + bj * HALF);
#pragma unroll
            for (int ai = 0; ai < 2; ++ai)
#pragma unroll
                for (int m = 0; m < 4; ++m) { const int row = row0 + ai * HALF + m * 16; const size_t off = (size_t)row * 2048 + col0; float ss = 0.f;
#pragma unroll
                    for (int bj = 0; bj < 2; ++bj) { const u32x4 b = bs[ai][m][bj]; f32x4 o0, o1;
                        o0[0] = __builtin_bit_cast(float, b.x << 16) + acc[ai][bj][m][0][0]; o0[1] = __builtin_bit_cast(float, b.x & 0xffff0000u) + acc[ai][bj][m][0][1];
                        o0[2] = __builtin_bit_cast(float, b.y << 16) + acc[ai][bj][m][0][2]; o0[3] = __builtin_bit_cast(float, b.y & 0xffff0000u) + acc[ai][bj][m][0][3];
                        o1[0] = __builtin_bit_cast(float, b.z << 16) + acc[ai][bj][m][1][0]; o1[1] = __builtin_bit_cast(float, b.z & 0xffff0000u) + acc[ai][bj][m][1][1];
                        o1[2] = __builtin_bit_cast(float, b.w << 16) + acc[ai][bj][m][1][2]; o1[3] = __builtin_bit_cast(float, b.w & 0xffff0000u) + acc[ai][bj][m][1][3];
                        finish(o0, o1, off + bj * HALF, ss); }
                    if (rss_out) { ss += __shfl_xor(ss, 16); ss += __shfl_xor(ss, 32); if (fq == 0) rss_out[(size_t)(u.pn * 4 + wc) * 16384 + row] = ss; } }
        }
    }
};
struct EpiP6 {
    static constexpr bool PERM = true, AFTER_DRAIN = false;
    bf16_t* big; RowScale rs; const float* kgain; const float* qgain; const float* rope;
    __device__ __forceinline__ void operator()(const f32x4 (&acc)[2][2][4][2], const Unit& u, int wr, int wc, int fr, int fq) const {
        const int row0 = u.pm * BM + wr * 64 + fr; const int pn = u.pn;
        const int kind = (pn < 6) ? 1 : (pn >= 12 && pn < 18) ? 2 : 0;
        bf16_t* basep = big + pn * BM + wc * 64 + 8 * fq;
        if (kind == 0) {
#pragma unroll
            for (int ai = 0; ai < 2; ++ai)
#pragma unroll
                for (int m = 0; m < 4; ++m) { const int row = row0 + ai * HALF + m * 16; const float sc = rs.get(u.pm, wr * 64 + fr + ai * HALF + m * 16); bf16_t* rowp = basep + (size_t)row * BIGP_;
#pragma unroll
                    for (int bj = 0; bj < 2; ++bj) { const f32x4 v0 = acc[ai][bj][m][0] * sc, v1 = acc[ai][bj][m][1] * sc;
                        u32x4 w; w.x = cvt_pk_bf16(v0[0], v0[1]); w.y = cvt_pk_bf16(v0[2], v0[3]); w.z = cvt_pk_bf16(v1[0], v1[1]); w.w = cvt_pk_bf16(v1[2], v1[3]); *(u32x4*)(rowp + bj * 32) = w; } }
        } else {
            const float* gp = (kind == 1 ? kgain : qgain) + 8 * fq; const float osc = (kind == 2) ? (0.125f * 1.4426950408889634f) : 1.0f;
            f32x4 gv[2][2];
#pragma unroll
            for (int bj = 0; bj < 2; ++bj)
#pragma unroll
                for (int n = 0; n < 2; ++n) gv[bj][n] = *(const f32x4*)(gp + bj * 32 + n * 4) * osc;
            const float sg = (fq == 0) ? -1.0f : 1.0f;
#pragma unroll
            for (int ai = 0; ai < 2; ++ai)
#pragma unroll
                for (int m = 0; m < 4; ++m) { const int row = row0 + ai * HALF + m * 16; const float sc = rs.get(u.pm, wr * 64 + fr + ai * HALF + m * 16); bf16_t* rowp = basep + (size_t)row * BIGP_;
                    f32x4 v[2][2]; float ss = 0.f;
#pragma unroll
                    for (int bj = 0; bj < 2; ++bj)
#pragma unroll
                        for (int n = 0; n < 2; ++n) { v[bj][n] = acc[ai][bj][m][n] * sc; const f32x4 x = v[bj][n]; ss += (x[0] * x[0] + x[1] * x[1]) + (x[2] * x[2] + x[3] * x[3]); }
                    ss += __shfl_xor(ss, 16); ss += __shfl_xor(ss, 32);
                    const float r = rsqrtf(ss * (1.0f / 64.0f) + RMS_EPS);
#pragma unroll
                    for (int bj = 0; bj < 2; ++bj)
#pragma unroll
                        for (int n = 0; n < 2; ++n) v[bj][n] = v[bj][n] * r * gv[bj][n];
                    {
                        const float* rp = rope + (size_t)(row & 2047) * 16;
#pragma unroll
                        for (int n = 0; n < 2; ++n) { const f32x4 cs = *(const f32x4*)(rp + 4 * n), sn = *(const f32x4*)(rp + 8 + 4 * n);
                            const f32x4 y = v[0][n]; f32x4 oth;
#pragma unroll
                            for (int e = 0; e < 4; ++e) oth[e] = __shfl_xor(y[e], 16);
                            const f32x4 res = y * cs + oth * (sn * sg);
                            if (fq < 2) v[0][n] = res; }
                    }
#pragma unroll
                    for (int bj = 0; bj < 2; ++bj) { const f32x4 v0 = v[bj][0], v1 = v[bj][1];
                        u32x4 w; w.x = cvt_pk_bf16(v0[0], v0[1]); w.y = cvt_pk_bf16(v0[2], v0[3]); w.z = cvt_pk_bf16(v1[0], v1[1]); w.w = cvt_pk_bf16(v1[2], v1[3]); *(u32x4*)(rowp + bj * 32) = w; } }
        }
    }
};
template <class Epi, class Sched, bool ALIGN_EPI = false, bool SP2 = false>
__device__ __forceinline__ void gemm_phase(PG8_LAS unsigned char* lds, const GemmX g, const Sched& S, const Epi& E) {
    int tid_ = threadIdx.x; asm volatile("" : "+v"(tid_));
    const int tid = tid_, wid = __builtin_amdgcn_readfirstlane(tid >> 6), lane = tid & 63, wr = wid >> 2, wc = wid & 3, fr = lane & 15, fq = lane >> 4;
    const int K = g.K, nt = K / BK;
    unsigned voffA[2], voffB[2];
#pragma unroll
    for (int i = 0; i < 2; ++i) { int R, C; stage_rc(tid * 16 + i * 8192, R, C); const int Rb = Epi::PERM ? ((R & ~31) + perm32(R & 31)) : R;
        voffA[i] = (unsigned)(R * g.lda + C) * 2u; voffB[i] = (unsigned)(Rb * g.ldb + C) * 2u; }
    const size_t kstep = (size_t)(BK * 2);
    const size_t hsA = (size_t)HALF * g.lda * 2, hsB = (size_t)HALF * g.ldb * 2;
    const unsigned ldsw = (unsigned)wid * 1024u;
    const int aoff = lds_byte(wr * 64 + fr, fq * 8), boff = lds_byte(wc * 32 + fr, fq * 8);
#define PG8_SA(b, h) (((b) * 2 + (h)) * HTB)
#define PG8_SB(b, h) ((4 + (b) * 2 + (h)) * HTB)
#define PG8_STAGE(bufoff, gbase, voff) do { _Pragma("unroll") for (int _i = 0; _i < 2; ++_i) \
        __builtin_amdgcn_global_load_lds((const unsigned*)((const char*)(gbase) + (voff)[_i]), (PG8_LAS unsigned*)(lds + (bufoff) + ldsw + _i * 8192), 16, 0, 0); } while (0)
#define PG8_LDA(dst, b, h) do { _Pragma("unroll") for (int m = 0; m < 4; ++m) _Pragma("unroll") for (int k = 0; k < 2; ++k) dst[m][k] = *(const PG8_LAS bf16x8*)(lds + PG8_SA(b, h) + aoff + m * 2048 + k * 1024); } while (0)
#define PG8_LDB(dst, b, h) do { _Pragma("unroll") for (int n = 0; n < 2; ++n) _Pragma("unroll") for (int k = 0; k < 2; ++k) dst[n][k] = *(const PG8_LAS bf16x8*)(lds + PG8_SB(b, h) + boff + n * 2048 + k * 1024); } while (0)
#define PG8_MMA(ai, bj, At, Bt) do { __builtin_amdgcn_s_setprio(1); _Pragma("unroll") for (int m = 0; m < 4; ++m) _Pragma("unroll") for (int n = 0; n < 2; ++n) _Pragma("unroll") for (int k = 0; k < 2; ++k) \
        acc[ai][bj][m][n] = __builtin_amdgcn_mfma_f32_16x16x32_bf16(Bt[n][k], At[m][k], acc[ai][bj][m][n], 0, 0, 0); __builtin_amdgcn_s_setprio(0); } while (0)
#define PG8_WAIT_V(n) asm volatile("s_waitcnt vmcnt(" #n ")" ::: "memory")
#define PG8_WAIT_L(n) asm volatile("s_waitcnt lgkmcnt(" #n ")" ::: "memory")
#define PG8_BAR __builtin_amdgcn_s_barrier()
#define PG8_SCHED __builtin_amdgcn_sched_barrier(0)
    Unit cur, nxt; int ui = 0;
    if (!S.next(0, cur)) return;
    f32x4 acc[2][2][4][2];
#pragma unroll
    for (int a = 0; a < 2; ++a)
#pragma unroll
        for (int b = 0; b < 2; ++b)
#pragma unroll
            for (int m = 0; m < 4; ++m)
#pragma unroll
                for (int n = 0; n < 2; ++n) acc[a][b][m][n] = (f32x4){0.f, 0.f, 0.f, 0.f};
    bf16x8 At[4][2], B0[2][2], B1[2][2];
    const char* cA = S.a_ptr(g, cur); const char* cB = S.b_ptr(g, cur);
    S.a_ready(cur);
    if constexpr (SP2) {
        PG8_STAGE(PG8_SB(0, 0), cB, voffB); PG8_STAGE(PG8_SB(0, 1), cB + hsB, voffB); PG8_STAGE(PG8_SA(0, 0), cA, voffA); PG8_STAGE(PG8_SA(0, 1), cA + hsA, voffA);
        if (wr == 1) PG8_BAR;
        PG8_WAIT_V(2); PG8_BAR;
        PG8_STAGE(PG8_SB(1, 0), cB + kstep, voffB); PG8_STAGE(PG8_SA(1, 0), cA + kstep, voffA); PG8_STAGE(PG8_SB(1, 1), cB + hsB + kstep, voffB);
        PG8_WAIT_V(6); PG8_BAR;
    } else {
        PG8_STAGE(PG8_SB(0, 0), cB, voffB); PG8_STAGE(PG8_SA(0, 0), cA, voffA); PG8_STAGE(PG8_SB(0, 1), cB + hsB, voffB); PG8_STAGE(PG8_SA(0, 1), cA + hsA, voffA);
        if (wr == 1) PG8_BAR;
        PG8_WAIT_V(4); PG8_BAR;
        PG8_STAGE(PG8_SB(1, 0), cB + kstep, voffB); PG8_STAGE(PG8_SA(1, 0), cA + kstep, voffA); PG8_STAGE(PG8_SB(1, 1), cB + hsB + kstep, voffB);
        PG8_WAIT_V(6); PG8_BAR;
    }
    for (;;) {
        const bool has_next = S.next(ui + 1, nxt);
        const char* nA = has_next ? S.a_ptr(g, nxt) : cA; const char* nB = has_next ? S.b_ptr(g, nxt) : cB;
        for (int t = 0; t < nt; t += 2) {
            const bool last = (t == nt - 2);
            const char* a1 = cA + (size_t)(t + 1) * kstep;
            const char* a2 = last ? nA : cA + (size_t)(t + 2) * kstep; const char* b2 = last ? nB : cB + (size_t)(t + 2) * kstep;
            const char* a3 = a2 + kstep; const char* b3 = b2 + kstep;
            if (last && has_next) S.a_ready(nxt);
            if constexpr (SP2) {
            PG8_LDB(B0, 0, 0); PG8_LDB(B1, 0, 1); PG8_SCHED; PG8_LDA(At, 0, 0); PG8_STAGE(PG8_SA(1, 1), a1 + hsA, voffA);
            PG8_WAIT_V(8); PG8_WAIT_L(0); PG8_BAR; PG8_MMA(0, 0, At, B0); PG8_MMA(0, 1, At, B1); PG8_BAR; PG8_SCHED;
            PG8_LDA(At, 0, 1); PG8_STAGE(PG8_SB(0, 0), b2, voffB); PG8_STAGE(PG8_SB(0, 1), b2 + hsB, voffB); PG8_STAGE(PG8_SA(0, 0), a2, voffA);
            PG8_WAIT_V(8); PG8_WAIT_L(0); PG8_BAR; PG8_MMA(1, 0, At, B0); PG8_MMA(1, 1, At, B1); PG8_BAR; PG8_SCHED;
            PG8_LDB(B0, 1, 0); PG8_LDB(B1, 1, 1); PG8_SCHED; PG8_LDA(At, 1, 0); PG8_STAGE(PG8_SA(0, 1), a2 + hsA, voffA);
            PG8_WAIT_V(8); PG8_WAIT_L(0); PG8_BAR; PG8_MMA(0, 0, At, B0); PG8_MMA(0, 1, At, B1); PG8_BAR; PG8_SCHED;
            PG8_LDA(At, 1, 1); PG8_STAGE(PG8_SB(1, 0), b3, voffB); PG8_STAGE(PG8_SB(1, 1), b3 + hsB, voffB); PG8_STAGE(PG8_SA(1, 0), a3, voffA);
            PG8_WAIT_V(8); PG8_WAIT_L(0); PG8_BAR; PG8_MMA(1, 0, At, B0); PG8_MMA(1, 1, At, B1); PG8_BAR; PG8_SCHED;
            } else {
            PG8_LDB(B0, 0, 0); PG8_SCHED; PG8_LDA(At, 0, 0); PG8_STAGE(PG8_SA(1, 1), a1 + hsA, voffA);
            PG8_WAIT_L(8); PG8_BAR; PG8_WAIT_L(0); PG8_MMA(0, 0, At, B0); PG8_BAR; PG8_SCHED;
            PG8_LDB(B1, 0, 1); PG8_STAGE(PG8_SB(0, 0), b2, voffB);
            PG8_BAR; PG8_WAIT_L(0); PG8_MMA(0, 1, At, B1); PG8_BAR;
            PG8_LDA(At, 0, 1); PG8_STAGE(PG8_SA(0, 0), a2, voffA);
            PG8_BAR; PG8_WAIT_L(0); PG8_MMA(1, 0, At, B0); PG8_BAR; PG8_SCHED;
            PG8_STAGE(PG8_SB(0, 1), b2 + hsB, voffB);
            PG8_WAIT_V(6); PG8_BAR; PG8_MMA(1, 1, At, B1); PG8_BAR;
            PG8_LDB(B0, 1, 0); PG8_SCHED; PG8_LDA(At, 1, 0); PG8_STAGE(PG8_SA(0, 1), a2 + hsA, voffA);
            PG8_WAIT_L(8); PG8_BAR; PG8_WAIT_L(0); PG8_MMA(0, 0, At, B0); PG8_BAR; PG8_SCHED;
            PG8_LDB(B1, 1, 1); PG8_STAGE(PG8_SB(1, 0), b3, voffB);
            PG8_BAR; PG8_WAIT_L(0); PG8_MMA(0, 1, At, B1); PG8_BAR;
            PG8_LDA(At, 1, 1); PG8_STAGE(PG8_SA(1, 0), a3, voffA);
            PG8_BAR; PG8_WAIT_L(0); PG8_MMA(1, 0, At, B0); PG8_BAR; PG8_SCHED;
            PG8_STAGE(PG8_SB(1, 1), b3 + hsB, voffB);
            PG8_WAIT_V(6); PG8_BAR; PG8_MMA(1, 1, At, B1); PG8_BAR;
            }
        }
        if constexpr (ALIGN_EPI) { if (wr == 0) PG8_BAR; }
        if constexpr (!Epi::AFTER_DRAIN) { E(acc, cur, wr, wc, fr, fq); S.done(cur); }
        if (!has_next) break;
#pragma unroll
        for (int a = 0; a < 2; ++a)
#pragma unroll
            for (int b = 0; b < 2; ++b)
#pragma unroll
                for (int m = 0; m < 4; ++m)
#pragma unroll
                    for (int n = 0; n < 2; ++n) acc[a][b][m][n] = (f32x4){0.f, 0.f, 0.f, 0.f};
        cur = nxt; cA = nA; cB = nB; ++ui;
        if constexpr (ALIGN_EPI) { if (wr == 1) PG8_BAR; }
    }
    PG8_WAIT_V(0);
    if constexpr (!ALIGN_EPI) { if (wr == 0) PG8_BAR; }
    PG8_BAR;
    if constexpr (Epi::AFTER_DRAIN) { E.fused(acc, cur, wr, wc, fr, fq, lds, wid, lane); S.done(cur); }
#undef PG8_SA
#undef PG8_SB
#undef PG8_STAGE
#undef PG8_LDA
#undef PG8_LDB
#undef PG8_MMA
#undef PG8_WAIT_V
#undef PG8_WAIT_L
#undef PG8_BAR
#undef PG8_SCHED
}
}

#include <hip/hip_bf16.h>
#include <cmath>
namespace attn_body {
using bf16=__hip_bfloat16;
using bf16x8=__attribute__((ext_vector_type(8)))short;
using s16x4=__attribute__((ext_vector_type(4)))short;
using f32x16=__attribute__((ext_vector_type(16)))float;
using u32x4=__attribute__((ext_vector_type(4)))unsigned;
constexpr int BATCH=8,SEQ=2048,D=64,DM=8256;
constexpr int NW=8,QBLK=32,QB=QBLK*NW,KVBLK=64,NQB=SEQ/QB;
constexpr int ATTN_PITCH=DM, ATTN_UNIT_ROWS=QB;
__device__ __forceinline__ int crow(int r,int hi){return (r&3)+8*(r>>2)+4*hi;}
#define SBAR() __builtin_amdgcn_sched_barrier(0)
__device__ __forceinline__ void cmask(f32x16&p0,f32x16&p1,int jb,int qrel,int hi){
  const float NEG=-INFINITY; int kb=64*jb+4*hi;
  #pragma unroll
  for(int r=0;r<16;++r){int kv=kb+(r&3)+8*(r>>2); if(kv>qrel)p0[r]=NEG; if(kv+32>qrel)p1[r]=NEG;}
}

constexpr int NSLOT=3, SLOTB=8192;
constexpr int LDS_K=0, LDS_V=NSLOT*SLOTB, LDS_WS=2*NSLOT*SLOTB, LDS_OST=LDS_WS+NW*64*4, LDS_BYTES=LDS_OST+NW*4096;
constexpr float C2=0.125f*1.4426950408889634f;
__device__ __forceinline__ void glds16(const void*gsrc,unsigned lds_dst){unsigned keep;
  asm volatile("s_mov_b32 %0, m0\n\ts_mov_b32 m0, %2\n\ts_nop 0\n\tglobal_load_lds_dwordx4 %1, off\n\ts_mov_b32 m0, %0":"=&s"(keep):"v"(gsrc),"s"(lds_dst):"memory");}
__device__ __forceinline__ float max3f(float a,float b,float c){float r;asm("v_max3_f32 %0, %1, %2, %3":"=v"(r):"v"(a),"v"(b),"v"(c));return r;}
__device__ __forceinline__ float max2f(float a,float b){float r;asm("v_max_f32_e32 %0, %1, %2":"=v"(r):"v"(a),"v"(b));return r;}
__device__ __forceinline__ float fadd_s(float a,float b){float r;asm("v_add_f32_e32 %0, %1, %2":"=v"(r):"v"(a),"v"(b));return r;}
__device__ __forceinline__ float fsub_s(float a,float b){float r;asm("v_sub_f32_e32 %0, %1, %2":"=v"(r):"v"(a),"v"(b));return r;}
typedef float f32x2_t __attribute__((ext_vector_type(2))); typedef __bf16 bf16x2_t __attribute__((ext_vector_type(2)));
__device__ __forceinline__ unsigned cvtpk_s(float lo,float hi){f32x2_t v={lo,hi};bf16x2_t b=__builtin_convertvector(v,bf16x2_t);return __builtin_bit_cast(unsigned,b);}
#define WAIT_BAR(N) asm volatile("s_waitcnt vmcnt(" #N ") lgkmcnt(0)\n\ts_barrier":::"memory")

__device__ __forceinline__ void qkt(f32x16&p0,f32x16&p1,const char*Kslot,const bf16x8*qr,const f32x16&negm,int r32,int hi){
  const char*kb=Kslot+hi*1024+r32*16;
  #pragma unroll
  for(int d0=0;d0<4;++d0){
    const bf16x8 b0=*reinterpret_cast<const bf16x8*>(kb+d0*2048);
    const bf16x8 b1=*reinterpret_cast<const bf16x8*>(kb+d0*2048+512);
    if(d0==0){p0=__builtin_amdgcn_mfma_f32_32x32x16_bf16(b0,qr[0],negm,0,0,0);p1=__builtin_amdgcn_mfma_f32_32x32x16_bf16(b1,qr[0],negm,0,0,0);}
    else{p0=__builtin_amdgcn_mfma_f32_32x32x16_bf16(b0,qr[d0],p0,0,0,0);p1=__builtin_amdgcn_mfma_f32_32x32x16_bf16(b1,qr[d0],p1,0,0,0);}}
}
typedef __attribute__((address_space(3))) const char* lds_cptr;
typedef short v4i16_t __attribute__((ext_vector_type(4)));
__device__ __forceinline__ void kload8(bf16x8*kf,lds_cptr kp){
  kf[0]=*(const __attribute__((address_space(3))) bf16x8*)(kp);      kf[1]=*(const __attribute__((address_space(3))) bf16x8*)(kp+512);
  kf[2]=*(const __attribute__((address_space(3))) bf16x8*)(kp+2048); kf[3]=*(const __attribute__((address_space(3))) bf16x8*)(kp+2560);
  kf[4]=*(const __attribute__((address_space(3))) bf16x8*)(kp+4096); kf[5]=*(const __attribute__((address_space(3))) bf16x8*)(kp+4608);
  kf[6]=*(const __attribute__((address_space(3))) bf16x8*)(kp+6144); kf[7]=*(const __attribute__((address_space(3))) bf16x8*)(kp+6656);
}
__device__ __forceinline__ void kload2(bf16x8*kf,lds_cptr kp,int j){ kf[2*j]=*(const __attribute__((address_space(3))) bf16x8*)(kp+j*2048); kf[2*j+1]=*(const __attribute__((address_space(3))) bf16x8*)(kp+j*2048+512); }
__device__ __forceinline__ s16x4 vtr(lds_cptr p){ return __builtin_bit_cast(s16x4,__builtin_amdgcn_ds_read_tr16_b64_v4i16((__attribute__((address_space(3))) v4i16_t*)p)); }
__device__ __forceinline__ float rowmax(const f32x16&p0,const f32x16&p1){
  float a=max3f(p0[0],p0[1],p1[0]),b=max3f(p0[2],p0[3],p1[1]);a=max3f(a,p1[2],p1[3]);
  #pragma unroll
  for(int r=4;r<16;r+=4){a=max3f(a,p0[r],p0[r+1]);b=max3f(b,p0[r+2],p0[r+3]);a=max3f(a,p1[r],p1[r+1]);b=max3f(b,p1[r+2],p1[r+3]);}
  const float m=max2f(a,b);
  auto rr=__builtin_amdgcn_permlane32_swap(__float_as_uint(m),__float_as_uint(m),false,false);
  return max2f(__uint_as_float(rr[0]),__uint_as_float(rr[1]));
}
__device__ __forceinline__ void pv(f32x16*o,int vb,bf16x8 pa0,bf16x8 pa1,bf16x8 pa2,bf16x8 pa3){
  #pragma unroll
  for(int d0=0;d0<2;++d0){s16x4 lo[4],hi[4];
    #pragma unroll
    for(int ks=0;ks<4;++ks){
      asm volatile("ds_read_b64_tr_b16 %0,%1 offset:%c2":"=&v"(lo[ks]):"v"(vb),"i"(d0*4096+ks*1024):"memory");
      asm volatile("ds_read_b64_tr_b16 %0,%1 offset:%c2":"=&v"(hi[ks]):"v"(vb),"i"(d0*4096+ks*1024+512):"memory");}
    asm volatile("s_waitcnt lgkmcnt(0)":::"memory");SBAR();
    #define PK(k) (bf16x8){lo[k][0],lo[k][1],lo[k][2],lo[k][3],hi[k][0],hi[k][1],hi[k][2],hi[k][3]}
    o[d0]=__builtin_amdgcn_mfma_f32_32x32x16_bf16(pa0,PK(0),o[d0],0,0,0);
    o[d0]=__builtin_amdgcn_mfma_f32_32x32x16_bf16(pa1,PK(1),o[d0],0,0,0);
    o[d0]=__builtin_amdgcn_mfma_f32_32x32x16_bf16(pa2,PK(2),o[d0],0,0,0);
    o[d0]=__builtin_amdgcn_mfma_f32_32x32x16_bf16(pa3,PK(3),o[d0],0,0,0);
    #undef PK
  }
}

#ifndef ATTN_STORE16
#define ATTN_STORE16(p,v) (*(u32x4*)(p)=(v))
#endif
template<int THRL> __device__ __forceinline__ void attn_unit(int b,int h,int qb,const bf16*Q,const bf16*__restrict__ K,const bf16*__restrict__ V,bf16*O,char*shm){
  int tid_=threadIdx.x; asm volatile("":"+v"(tid_)); const int tid=tid_,lane=tid&63,r32=lane&31,hi=lane>>5; const int wid=__builtin_amdgcn_readfirstlane(tid>>6);
  const long rowbase=(long)b*SEQ; const int q0=qb*QB;
  const bf16*Qw=Q+(rowbase+q0+wid*QBLK)*DM+h*D;
  const bf16*Kh=K+rowbase*DM+h*D,*Vh=V+rowbase*DM+h*D;
  const unsigned lds0=(unsigned)(uintptr_t)shm;
  float*wsf=(float*)(shm+LDS_WS)+wid*64;
  const bf16*ksrc=Kh+(long)lane*DM+wid*8;
  const bf16*vsrc=Vh+(long)(16*(wid&3)+(lane>>2))*DM+(wid>>2)*32+(lane&3)*8;
  const unsigned kdst=lds0+LDS_K+wid*1024, vdst=lds0+LDS_V+wid*1024;
  #define DMA_K(t,slot) glds16(ksrc+(long)(t)*KVBLK*DM,(unsigned)__builtin_amdgcn_readfirstlane(kdst+(slot)))
  #define DMA_V(t,slot) glds16(vsrc+(long)(t)*KVBLK*DM,(unsigned)__builtin_amdgcn_readfirstlane(vdst+(slot)))
  const int vb0=(int)(lds0+LDS_V)+((lane>>4)&1)*32+(lane&3)*8+(4*hi+((lane&15)>>2))*64;
  const char*Kbase=shm+LDS_K; bf16x8 kf[8];
  const lds_cptr shm3=(lds_cptr)shm; const lds_cptr kp0=shm3+LDS_K+hi*1024+r32*16; const lds_cptr vp0=shm3+LDS_V+((lane>>4)&1)*32+(lane&3)*8+(4*hi+((lane&15)>>2))*64;
  const int NT=(q0+QB)/KVBLK;
  DMA_K(0,0);DMA_V(0,0);DMA_K(1,SLOTB);
  bf16x8 qr[4];
  #pragma unroll
  for(int d0=0;d0<4;++d0)qr[d0]=*reinterpret_cast<const bf16x8*>(&Qw[(long)r32*DM+d0*16+hi*8]);
  float mhat=0.f,l_reg=0.f;f32x16 o[2];o[0]=f32x16{};o[1]=f32x16{};f32x16 negm=f32x16{};asm volatile("":"+v"(negm));
  const int qrel=wid*QBLK+r32;
  #define CMASK(P0,P1,t) do{int jb_=(t)-(NT-4); if(jb_>=0)cmask(P0,P1,jb_,qrel,hi);}while(0)
  bool resc=false;
  #define START(P0,P1) do{ const float rm=rowmax(P0,P1); resc=false; \
    { const float dl=rm; mhat=fadd_s(mhat,dl); \
      _Pragma("unroll") for(int r=0;r<16;++r){P0[r]=fsub_s(P0[r],dl);P1[r]=fsub_s(P1[r],dl);} \
      _Pragma("unroll") for(int r=0;r<16;++r)negm[r]=-mhat; asm volatile("":"+v"(negm)); } \
    _Pragma("unroll") for(int r=0;r<16;++r)P0[r]=__builtin_amdgcn_exp2f(P0[r]); }while(0)
  #define RESC() do{ if(resc){ asm volatile("s_waitcnt lgkmcnt(0)":::"memory"); \
      _Pragma("unroll") for(int d_=0;d_<2;++d_) _Pragma("unroll") for(int r=0;r<16;++r)o[d_][r]*=wsf[crow(r,hi)]; } }while(0)
  f32x16 pA0,pA1,pB0,pB1;
  int sl_prev=0,sl_cur=0,sl_next=SLOTB;
  #define ROT() do{sl_prev=sl_cur;sl_cur=sl_next;sl_next=(sl_next==(NSLOT-1)*SLOTB)?0:sl_next+SLOTB;}while(0)
  DMA_K(2,2*SLOTB);
  WAIT_BAR(3);
  qkt(pA0,pA1,Kbase,qr,negm,r32,hi);asm volatile("s_nop 15\n\ts_nop 7":"+v"(pA0),"+v"(pA1));CMASK(pA0,pA1,0);
  START(pA0,pA1);
  _Pragma("unroll") for(int r=0;r<16;++r)pA1[r]=__builtin_amdgcn_exp2f(pA1[r]);
  WAIT_BAR(0);
  DMA_K(3,0);DMA_V(1,SLOTB);
  ROT();
  kload8(kf,kp0+sl_cur);
  WAIT_BAR(2);
  s16x4 vlo[8],vhi[8]; u32x4 pw0,pw1,pw2,pw3;
  #define PKW(P,B) cvtpk_s(P[B],P[B+1])
  #define PAF(k) __builtin_bit_cast(bf16x8,pw##k)
  #define VFR(i) (bf16x8){vlo[i][0],vlo[i][1],vlo[i][2],vlo[i][3],vhi[i][0],vhi[i][1],vhi[i][2],vhi[i][3]}
  #define PIN(x) asm volatile("":"+v"(x))
  #define MX3(a,b,c) __builtin_fmaxf(__builtin_fmaxf((a),(b)),(c))
  #define GAPA(MF,A0,A1,A2,A3,W0,W1,PW) do{ MF; sacc+=A0; sacc+=A1; sacc+=A2; sacc+=A3; PIN(sacc); W0; W1; PIN(PW); SBAR(); }while(0)
  #define EX(v) __builtin_amdgcn_exp2f(v)
  #define GAPB(MF,X,B) do{ MF; X[B]=EX(X[B]); X[B+1]=EX(X[B+1]); X[B+2]=EX(X[B+2]); X[B+3]=EX(X[B+3]); PIN(X); SBAR(); }while(0)
  #define VRD(i) do{ vlo[i]=vtr(vp_+(((i)>>2)*4096+((i)&3)*1024)); vhi[i]=vtr(vp_+(((i)>>2)*4096+((i)&3)*1024+512)); }while(0)
  #define KRD(G,j) do{ if(G){ kload2(kf,kp0+sl_next,j); SBAR(); } }while(0)
  #define STEP(C0,C1,P0,P1,t,GK,GV,GL) do{ SBAR(); \
    const lds_cptr vp_=vp0+sl_prev; \
    VRD(0); SBAR(); float sacc=(P0[0]+P0[1]); \
    GAPA(C0=__builtin_amdgcn_mfma_f32_32x32x16_bf16(kf[0],qr[0],negm,0,0,0), P0[2],P0[3],P0[4],P0[5],     pw0[0]=PKW(P0,0), pw0[1]=PKW(P0,2), pw0); \
    VRD(4); SBAR(); GAPA(C1=__builtin_amdgcn_mfma_f32_32x32x16_bf16(kf[1],qr[0],negm,0,0,0), P0[6],P0[7],P0[8],P0[9],     pw0[2]=PKW(P0,4), pw0[3]=PKW(P0,6), pw0); \
    VRD(1); SBAR(); GAPA(C0=__builtin_amdgcn_mfma_f32_32x32x16_bf16(kf[2],qr[1],C0,0,0,0),   P0[10],P0[11],P0[12],P0[13], pw1[0]=PKW(P0,8), pw1[1]=PKW(P0,10), pw1); \
    VRD(5); SBAR(); GAPA(C1=__builtin_amdgcn_mfma_f32_32x32x16_bf16(kf[3],qr[1],C1,0,0,0),   P0[14],P0[15],P1[0],P1[1],   pw1[2]=PKW(P0,12),pw1[3]=PKW(P0,14), pw1); \
    VRD(2); SBAR(); GAPA(C0=__builtin_amdgcn_mfma_f32_32x32x16_bf16(kf[4],qr[2],C0,0,0,0),   P1[2],P1[3],P1[4],P1[5],     pw2[0]=PKW(P1,0), pw2[1]=PKW(P1,2), pw2); \
    VRD(6); SBAR(); GAPA(C1=__builtin_amdgcn_mfma_f32_32x32x16_bf16(kf[5],qr[2],C1,0,0,0),   P1[6],P1[7],P1[8],P1[9],     pw2[2]=PKW(P1,4), pw2[3]=PKW(P1,6), pw2); \
    VRD(3); SBAR(); GAPA(C0=__builtin_amdgcn_mfma_f32_32x32x16_bf16(kf[6],qr[3],C0,0,0,0),   P1[10],P1[11],P1[12],P1[13], pw3[0]=PKW(P1,8), pw3[1]=PKW(P1,10), pw3); \
    VRD(7); SBAR(); GAPA(C1=__builtin_amdgcn_mfma_f32_32x32x16_bf16(kf[7],qr[3],C1,0,0,0),   P1[14],P1[15],0.f,0.f,       pw3[2]=PKW(P1,12),pw3[3]=PKW(P1,14), pw3); \
    l_reg+=sacc; \
    if(GK){DMA_K((t)+3,sl_cur);} if(GV){DMA_V((t)+1,sl_next);} \
    CMASK(C0,C1,t); \
    { float a=MX3(C0[0],C0[1],C1[0]),b=MX3(C0[2],C0[3],C1[1]); a=MX3(a,C1[2],C1[3]); \
      _Pragma("unroll") for(int r=4;r<16;r+=4){a=MX3(a,C0[r],C0[r+1]);b=MX3(b,C0[r+2],C0[r+3]);a=MX3(a,C1[r],C1[r+1]);b=MX3(b,C1[r+2],C1[r+3]);} \
      float rm=__builtin_fmaxf(a,b); { auto rr=__builtin_amdgcn_permlane32_swap(__float_as_uint(rm),__float_as_uint(rm),false,false); rm=__builtin_fmaxf(__uint_as_float(rr[0]),__uint_as_float(rr[1])); } \
      resc=false; \
      if(__builtin_expect(__any(rm>(float)THRL),0)){ const float dl=__builtin_fmaxf(rm,0.f); mhat+=dl; \
        _Pragma("unroll") for(int r=0;r<16;++r){C0[r]-=dl;C1[r]-=dl;} \
        _Pragma("unroll") for(int r=0;r<16;++r)negm[r]=-mhat; asm volatile("":"+v"(negm)); \
        const float f=__builtin_amdgcn_exp2f(-dl); l_reg*=f; if(hi==0)wsf[r32]=f; resc=true; } } \
    SBAR(); \
    GAPB(o[0]=__builtin_amdgcn_mfma_f32_32x32x16_bf16(PAF(0),VFR(0),o[0],0,0,0), C0,0); \
    GAPB(o[1]=__builtin_amdgcn_mfma_f32_32x32x16_bf16(PAF(0),VFR(4),o[1],0,0,0), C0,4); \
    KRD(GL,0); GAPB(o[0]=__builtin_amdgcn_mfma_f32_32x32x16_bf16(PAF(1),VFR(1),o[0],0,0,0), C0,8); \
    KRD(GL,1); GAPB(o[1]=__builtin_amdgcn_mfma_f32_32x32x16_bf16(PAF(1),VFR(5),o[1],0,0,0), C0,12); \
    KRD(GL,2); GAPB(o[0]=__builtin_amdgcn_mfma_f32_32x32x16_bf16(PAF(2),VFR(2),o[0],0,0,0), C1,0); \
    KRD(GL,3); GAPB(o[1]=__builtin_amdgcn_mfma_f32_32x32x16_bf16(PAF(2),VFR(6),o[1],0,0,0), C1,4); \
    GAPB(o[0]=__builtin_amdgcn_mfma_f32_32x32x16_bf16(PAF(3),VFR(3),o[0],0,0,0), C1,8); \
    GAPB(o[1]=__builtin_amdgcn_mfma_f32_32x32x16_bf16(PAF(3),VFR(7),o[1],0,0,0), C1,12); \
    }while(0)
  int t=1;
  #undef CMASK
  #define CMASK(P0,P1,t) do{}while(0)
  for(;t+5<NT;t+=2){
    STEP(pB0,pB1,pA0,pA1,t,true,true,true);     WAIT_BAR(2); RESC(); ROT();
    STEP(pA0,pA1,pB0,pB1,t+1,true,true,true);   WAIT_BAR(2); RESC(); ROT();
  }
  #undef CMASK
  #define CMASK(P0,P1,t) do{int jb_=(t)-(NT-4); if(jb_>=0)cmask(P0,P1,jb_,qrel,hi);}while(0)
  #define ENDW(tt) do{ if((tt)+3<NT){WAIT_BAR(2);} else if((tt)+2<NT){WAIT_BAR(1);} else {WAIT_BAR(0);} }while(0)
  for(;t+1<NT;t+=2){
    STEP(pB0,pB1,pA0,pA1,t,(t+3<NT),(t+1<NT),(t+1<NT));       ENDW(t);   RESC(); ROT();
    STEP(pA0,pA1,pB0,pB1,t+1,(t+4<NT),(t+2<NT),(t+2<NT));     ENDW(t+1); RESC(); ROT();
  }
  STEP(pB0,pB1,pA0,pA1,NT-1,false,false,false); RESC();
  { float sacc=pB0[0]+pB0[1]; _Pragma("unroll") for(int r=2;r<16;++r)sacc+=pB0[r]; _Pragma("unroll") for(int r=0;r<16;++r)sacc+=pB1[r]; l_reg+=sacc;
    pw0=(u32x4){PKW(pB0,0),PKW(pB0,2),PKW(pB0,4),PKW(pB0,6)};pw1=(u32x4){PKW(pB0,8),PKW(pB0,10),PKW(pB0,12),PKW(pB0,14)};pw2=(u32x4){PKW(pB1,0),PKW(pB1,2),PKW(pB1,4),PKW(pB1,6)};pw3=(u32x4){PKW(pB1,8),PKW(pB1,10),PKW(pB1,12),PKW(pB1,14)};
    SBAR(); pv(o,vb0+sl_cur,PAF(0),PAF(1),PAF(2),PAF(3)); }
  #undef PKW
  #undef PAF
  #undef VFR
  #undef PIN
  #undef MX3
  #undef GAPA
  #undef GAPB
  #undef EX
  #undef VRD
  #undef KRD
  #undef STEP
  #undef ENDW
  {auto rr=__builtin_amdgcn_permlane32_swap(__float_as_uint(l_reg),__float_as_uint(l_reg),false,false);l_reg=__uint_as_float(rr[0])+__uint_as_float(rr[1]);}
  if(hi==0)wsf[32+r32]=l_reg;asm volatile("s_waitcnt lgkmcnt(0)":::"memory");
  float rli[16];
  #pragma unroll
  for(int r=0;r<16;++r)rli[r]=__builtin_amdgcn_rcpf(wsf[32+crow(r,hi)]);
  bf16*Ow=O+(rowbase+q0+wid*QBLK)*DM+h*D;
  { bf16*stg=(bf16*)(shm+LDS_OST)+wid*2048;
    #pragma unroll
    for(int r=0;r<16;++r){const int orow=crow(r,hi);
      #pragma unroll
      for(int d0=0;d0<2;++d0)stg[orow*64+d0*32+r32]=__float2bfloat16(o[d0][r]*rli[r]);}
    asm volatile("s_waitcnt lgkmcnt(0)":::"memory");
    #pragma unroll
    for(int i=0;i<4;++i){const int row=i*8+(lane>>3),ch=lane&7; const u32x4 v=*(const u32x4*)(stg+row*64+ch*8); ATTN_STORE16(Ow+(long)row*DM+ch*8,v);} }
  asm volatile("s_waitcnt lgkmcnt(0)\n\ts_barrier":::"memory");
  #undef DMA_K
  #undef DMA_V
  #undef CMASK
  #undef START
  #undef RESC
  #undef ROT
}
constexpr int ATTN_LDS_BYTES=LDS_BYTES;
#undef SBAR
#undef WAIT_BAR
}

#define LAS __attribute__((address_space(3)))
typedef unsigned short bf16;
typedef unsigned v4u __attribute__((ext_vector_type(4)));
typedef unsigned v2u __attribute__((ext_vector_type(2)));
typedef float f32x4 __attribute__((ext_vector_type(4)));
typedef float f32x16 __attribute__((ext_vector_type(16)));
typedef short bf16x8 __attribute__((ext_vector_type(8)));
typedef short s16x4 __attribute__((ext_vector_type(4)));
constexpr float RMS_EPS = 1e-6f;
constexpr int NWAVES = 8, NTHREADS = 512;
constexpr int M = 16384, DM = 2048, SEQ = 2048, MEMROWS = 2048, BIGP = 8256, WF2P = 8256;
constexpr size_t MiB = 1u << 20;
constexpr size_t WS_SMALL = 0;
constexpr size_t WS_BAR = 1 * MiB;
constexpr size_t WS_W1 = 2 * MiB;
constexpr size_t WS_POOL = 18 * MiB;
constexpr size_t WS_WO0 = 20 * MiB, WS_WO1 = 28 * MiB;
constexpr size_t WS_W6 = 36 * MiB;
constexpr size_t WS_WF1 = 56 * MiB;
constexpr size_t WS_WF2 = 88 * MiB;
constexpr size_t WS_MKV = 122 * MiB;
constexpr size_t WS_XB = 130 * MiB;
constexpr size_t WS_BIG = 202 * MiB;
constexpr size_t WS_WF2B = 460 * MiB;
constexpr size_t WS_END = 493 * MiB;
constexpr int LDS_BYTES = 147456;

__device__ __forceinline__ unsigned f2bf(float f) { unsigned u = __builtin_bit_cast(unsigned, f); return (u + 0x7fffu + ((u >> 16) & 1u)) >> 16; }
__device__ __forceinline__ unsigned pk2(float lo, float hi) { return f2bf(lo) | (f2bf(hi) << 16); }
__device__ __forceinline__ float bflo(unsigned w) { return __builtin_bit_cast(float, w << 16); }
__device__ __forceinline__ float bfhi(unsigned w) { return __builtin_bit_cast(float, w & 0xffff0000u); }
#define LDS_WAIT() asm volatile("s_waitcnt lgkmcnt(0)" ::: "memory")
__device__ __forceinline__ float wave_sum(float v) {
#pragma unroll
    for (int o = 1; o < 64; o <<= 1) v += __shfl_xor(v, o);
    return v;
}

typedef unsigned gu32_unused_t;
#define RLX_AGENT __ATOMIC_RELAXED, __HIP_MEMORY_SCOPE_AGENT
#define XB_TMO      128
#define XB_XCNT(j)  (256  + 64 * (j))
#define XB_XSUB(j)  (1280 + 64 * (j))
#define XB_XGEN(j)  (2304 + 64 * (j))
#define XB_TOP      3328
#define XB_TOPGEN   3392
#define XCD_BAR_WORDS 3456
#define XB_SPIN_CAP (1u << 18)

__device__ __forceinline__ unsigned xb_ld(unsigned* p)              { return __hip_atomic_load(p, __ATOMIC_RELAXED, __HIP_MEMORY_SCOPE_AGENT); }
__device__ __forceinline__ unsigned xb_add(unsigned* p, unsigned v) { return __hip_atomic_fetch_add(p, v, __ATOMIC_RELAXED, __HIP_MEMORY_SCOPE_AGENT); }
__device__ __forceinline__ unsigned xb_xcc_id() { return (unsigned)__builtin_amdgcn_s_getreg((3 << 11) | 20) & 0xFu; }
#define XB_SPIN(cond, bar) do { unsigned _sp = 0; while (cond) { __builtin_amdgcn_s_sleep(1); \
    if ((++_sp & 255u) == 0u) { if (xb_ld(&(bar)[XB_TMO])) break; if (_sp > XB_SPIN_CAP) { atomicAdd(&(bar)[XB_TMO], 1u); break; } } } } while (0)

struct XcdBarrier {
    unsigned* bar; unsigned x;
    volatile LAS unsigned* st;
};

__device__ __forceinline__ XcdBarrier xcd_barrier_post(unsigned* bar, volatile LAS unsigned* st) {
    XcdBarrier b; b.bar = bar; b.x = xb_xcc_id(); b.st = st;
    if (threadIdx.x == 0) (void)xb_add(&bar[XB_XCNT(b.x)], 1u);
    return b;
}
__device__ __forceinline__ void xcd_barrier_complete(unsigned* bar, unsigned x, unsigned& nloc, unsigned& nx) {
    const unsigned G = gridDim.x * gridDim.y * gridDim.z;
    unsigned sum, cnt, mine, sp = 0u;
    for (;;) {
        sum = 0u; cnt = 0u; mine = 0u;
#pragma unroll
        for (unsigned j = 0; j < 16; ++j) { const unsigned c = xb_ld(&bar[XB_XCNT(j)]); sum += c; cnt += (c > 0u) ? 1u : 0u; mine = (j == x) ? c : mine; }
        if (sum == G) break;
        __builtin_amdgcn_s_sleep(1);
        if ((++sp & 255u) == 0u) { if (xb_ld(&bar[XB_TMO])) break; if (sp > XB_SPIN_CAP) { atomicAdd(&bar[XB_TMO], 1u); break; } }
    }
    nloc = mine > 0u ? mine : 1u; nx = cnt > 0u ? cnt : 1u;
}

__device__ __forceinline__ void xcd_barrier(const XcdBarrier& b) {
    asm volatile("s_waitcnt vmcnt(0)" ::: "memory");
    __syncthreads();
    if (threadIdx.x == 0) {
        unsigned* bar = b.bar;
        __builtin_amdgcn_s_waitcnt(0);
        unsigned nloc = b.st[0], nx = b.st[1];
        if (nloc == 0u) { xcd_barrier_complete(bar, b.x, nloc, nx); b.st[0] = nloc; b.st[1] = nx; }
        const unsigned old = xb_add(&bar[XB_XSUB(b.x)], 1u);
        const unsigned gen = old / nloc;
        if (old + 1u == (gen + 1u) * nloc) {
            __builtin_amdgcn_fence(__ATOMIC_RELEASE, "agent");
            asm volatile("s_waitcnt vmcnt(0)" ::: "memory");
            const unsigned og = xb_add(&bar[XB_TOP], 1u);
            const unsigned tg = og / nx;
            if (og + 1u == (tg + 1u) * nx) xb_add(&bar[XB_TOPGEN], 1u);
            else XB_SPIN(xb_ld(&bar[XB_TOPGEN]) == tg, bar);
            __builtin_amdgcn_fence(__ATOMIC_ACQUIRE, "agent");
            xb_add(&bar[XB_XGEN(b.x)], 1u);
            asm volatile("s_waitcnt vmcnt(0)" ::: "memory");
        } else {
            XB_SPIN(xb_ld(&bar[XB_XGEN(b.x)]) == gen, bar);
            __builtin_amdgcn_fence(__ATOMIC_ACQUIRE, "agent");
            asm volatile("s_waitcnt vmcnt(0)" ::: "memory");
        }
    }
    __syncthreads();
}


struct TJob { const float* W; int K, N; bf16* WT; int row_off; const float* kgain; const float* nscale; int kperm, sigma, ldw; };
__device__ __forceinline__ void transpose_item(const TJob& j, LAS float* scr, int item, int lane) {
    const int nblk = j.N / 32, kb = item / nblk, nb = item % nblk, k0 = 64 * kb, n0 = 32 * nb;
    const float ns = j.nscale ? j.nscale[n0 + (lane & 31)] : 1.0f;
    const float* wp = j.W + (size_t)(k0 + (lane >> 5)) * j.N + n0 + (lane & 31);
    float v[32];
#pragma unroll
    for (int i = 0; i < 32; ++i) v[i] = wp[(size_t)(2 * i) * j.N];
    const int c = lane & 7;
    f32x4 g0 = (f32x4){1.f, 1.f, 1.f, 1.f}, g1 = g0;
    if (j.kgain) { g0 = *(const f32x4*)(j.kgain + k0 + 8 * c); g1 = *(const f32x4*)(j.kgain + k0 + 8 * c + 4); }
#pragma unroll
    for (int i = 0; i < 32; ++i) scr[(2 * i + (lane >> 5)) * 33 + (lane & 31)] = v[i] * ns;
    LDS_WAIT(); asm volatile("" ::: "memory");
    const int kd = j.kperm ? ((k0 + 512) & 2047) : k0;
    int nd0 = n0;
    if (j.sigma) { const int tile = n0 >> 8, grp = (n0 & 255) >> 5; nd0 = tile * 256 + (4 * (grp & 1) + (grp >> 1)) * 32; }
#pragma unroll
    for (int jj = 0; jj < 4; ++jj) { const int n = (lane >> 3) + 8 * jj; const LAS float* s = scr + (8 * c) * 33 + n;
        v4u o; o.x = pk2(s[0 * 33] * g0.x, s[1 * 33] * g0.y); o.y = pk2(s[2 * 33] * g0.z, s[3 * 33] * g0.w); o.z = pk2(s[4 * 33] * g1.x, s[5 * 33] * g1.y); o.w = pk2(s[6 * 33] * g1.z, s[7 * 33] * g1.w);
        *(v4u*)(j.WT + (size_t)(j.row_off + nd0 + n) * (j.ldw ? j.ldw : j.K) + kd + 8 * c) = o; }
    LDS_WAIT(); asm volatile("" ::: "memory");
}
__device__ __forceinline__ void run_tjob(const TJob& j, LAS float* scr, int gw, int NGW, int lane, int& cursor) {
    const int nitems = (j.K / 64) * (j.N / 32);
    int first = (gw - cursor % NGW + NGW) % NGW;
    for (int it = first; it < nitems; it += NGW) transpose_item(j, scr, it, lane);
    cursor += nitems;
}
__device__ __forceinline__ void row_to_bf16(const float* xrow, bf16* orow, float* rss, int lane) {
    const f32x4* xr = (const f32x4*)xrow + lane;
    f32x4 v[8]; float s = 0.f;
#pragma unroll
    for (int jx = 0; jx < 8; ++jx) { v[jx] = xr[64 * jx]; s += (v[jx].x * v[jx].x + v[jx].y * v[jx].y) + (v[jx].z * v[jx].z + v[jx].w * v[jx].w); }
    s = wave_sum(s);
    unsigned long long* o8 = (unsigned long long*)orow + lane;
#pragma unroll
    for (int jx = 0; jx < 8; ++jx) o8[64 * jx] = (unsigned long long)pk2(v[jx].x, v[jx].y) | ((unsigned long long)pk2(v[jx].z, v[jx].w) << 32);
    if (lane == 0) *rss = s;
}

constexpr int MA_KP = 272, MA_VP = 528;
constexpr int MA_K_OFF = 0, MA_V_OFF = 256 * MA_KP;
static_assert(MA_V_OFF + 128 * MA_VP <= 139264, "mem-attn LDS");
__device__ __forceinline__ void memattn_unit(bf16* qp, const bf16* kp, const bf16* vp, const float* qg, const float* kg, LAS unsigned char* lds, int wid, int lane) {
    __syncthreads();
    {
        const int c = lane & 15; const f32x4 g0 = *(const f32x4*)(kg + 8 * c), g1 = *(const f32x4*)(kg + 8 * c + 4);
        const int kv = 64 * (wid & 3) + lane;
        v4u kw[8], vw[8];
#pragma unroll
        for (int it = 0; it < 8; ++it) kw[it] = *(const v4u*)(kp + (size_t)(it * 32 + wid * 4 + (lane >> 4)) * 2048 + 8 * c);
#pragma unroll
        for (int it = 0; it < 8; ++it) vw[it] = *(const v4u*)(vp + (size_t)kv * 2048 + 8 * (8 * (wid >> 2) + it));
#pragma unroll
        for (int it = 0; it < 8; ++it) { const int r = it * 32 + wid * 4 + (lane >> 4); const v4u w = kw[it];
            float f[8]; f[0] = bflo(w.x); f[1] = bfhi(w.x); f[2] = bflo(w.y); f[3] = bfhi(w.y); f[4] = bflo(w.z); f[5] = bfhi(w.z); f[6] = bflo(w.w); f[7] = bfhi(w.w);
            float ss = 0.f;
#pragma unroll
            for (int e = 0; e < 8; ++e) ss += f[e] * f[e];
            ss += __shfl_xor(ss, 1); ss += __shfl_xor(ss, 2); ss += __shfl_xor(ss, 4); ss += __shfl_xor(ss, 8);
            const float rs = rsqrtf(ss * (1.0f / 128.0f) + RMS_EPS);
            v4u o; o.x = pk2(f[0] * rs * g0.x, f[1] * rs * g0.y); o.y = pk2(f[2] * rs * g0.z, f[3] * rs * g0.w); o.z = pk2(f[4] * rs * g1.x, f[5] * rs * g1.y); o.w = pk2(f[6] * rs * g1.z, f[7] * rs * g1.w);
            *(LAS v4u*)(lds + MA_K_OFF + r * MA_KP + 16 * c) = o; }
#pragma unroll
        for (int it = 0; it < 8; ++it) { const int cc = 8 * (wid >> 2) + it; const v4u w = vw[it];
            LAS unsigned short* d = (LAS unsigned short*)(lds + MA_V_OFF + (8 * cc) * MA_VP + 2 * kv);
            d[0 * (MA_VP / 2)] = (unsigned short)(w.x & 0xffffu); d[1 * (MA_VP / 2)] = (unsigned short)(w.x >> 16);
            d[2 * (MA_VP / 2)] = (unsigned short)(w.y & 0xffffu); d[3 * (MA_VP / 2)] = (unsigned short)(w.y >> 16);
            d[4 * (MA_VP / 2)] = (unsigned short)(w.z & 0xffffu); d[5 * (MA_VP / 2)] = (unsigned short)(w.z >> 16);
            d[6 * (MA_VP / 2)] = (unsigned short)(w.w & 0xffffu); d[7 * (MA_VP / 2)] = (unsigned short)(w.w >> 16); }
    }
    const int r32 = lane & 31, hh = lane >> 5;
    bf16* qrow = qp + (size_t)(wid * 32 + r32) * BIGP;
    bf16x8 qr[8];
    {
        v4u qw[8]; float ss = 0.f;
#pragma unroll
        for (int d0 = 0; d0 < 8; ++d0) { qw[d0] = *(const v4u*)(qrow + 16 * d0 + 8 * hh);
            const float a0 = bflo(qw[d0].x), a1 = bfhi(qw[d0].x), a2 = bflo(qw[d0].y), a3 = bfhi(qw[d0].y), a4 = bflo(qw[d0].z), a5 = bfhi(qw[d0].z), a6 = bflo(qw[d0].w), a7 = bfhi(qw[d0].w);
            ss += (a0 * a0 + a1 * a1) + (a2 * a2 + a3 * a3) + (a4 * a4 + a5 * a5) + (a6 * a6 + a7 * a7); }
        ss += __shfl_xor(ss, 32);
        const float rs = rsqrtf(ss * (1.0f / 128.0f) + RMS_EPS) * (0.08838834764831845f * 1.4426950408889634f);
#pragma unroll
        for (int d0 = 0; d0 < 8; ++d0) { const f32x4 g0 = *(const f32x4*)(qg + 16 * d0 + 8 * hh), g1 = *(const f32x4*)(qg + 16 * d0 + 8 * hh + 4);
            v4u o; o.x = pk2(bflo(qw[d0].x) * rs * g0.x, bfhi(qw[d0].x) * rs * g0.y); o.y = pk2(bflo(qw[d0].y) * rs * g0.z, bfhi(qw[d0].y) * rs * g0.w);
            o.z = pk2(bflo(qw[d0].z) * rs * g1.x, bfhi(qw[d0].z) * rs * g1.y); o.w = pk2(bflo(qw[d0].w) * rs * g1.z, bfhi(qw[d0].w) * rs * g1.w);
            qr[d0] = __builtin_bit_cast(bf16x8, o); }
    }
    __syncthreads();
    f32x16 o[4]; o[0] = f32x16{}; o[1] = f32x16{}; o[2] = f32x16{}; o[3] = f32x16{};
    float lsum = 0.f;
    const LAS unsigned char* kbase = lds + MA_K_OFF + r32 * MA_KP + 16 * hh;
    const LAS unsigned char* vbase = lds + MA_V_OFF + r32 * MA_VP + 8 * hh;
#pragma unroll 1
    for (int kb = 0; kb < 8; kb += 2) {
        f32x16 x0 = f32x16{}, x1 = f32x16{};
#pragma unroll
        for (int d0 = 0; d0 < 8; ++d0) { const bf16x8 k0 = *(const LAS bf16x8*)(kbase + kb * 32 * MA_KP + 32 * d0), k1 = *(const LAS bf16x8*)(kbase + (kb + 1) * 32 * MA_KP + 32 * d0);
            x0 = __builtin_amdgcn_mfma_f32_32x32x16_bf16(k0, qr[d0], x0, 0, 0, 0); x1 = __builtin_amdgcn_mfma_f32_32x32x16_bf16(k1, qr[d0], x1, 0, 0, 0); }
        float sacc = 0.f;
#pragma unroll
        for (int r = 0; r < 16; ++r) { x0[r] = __builtin_amdgcn_exp2f(x0[r]); x1[r] = __builtin_amdgcn_exp2f(x1[r]); sacc += x0[r] + x1[r]; }
        lsum += sacc;
        v4u pw[4];
        pw[0].x = pk2(x0[0], x0[1]); pw[0].y = pk2(x0[2], x0[3]); pw[0].z = pk2(x0[4], x0[5]); pw[0].w = pk2(x0[6], x0[7]);
        pw[1].x = pk2(x0[8], x0[9]); pw[1].y = pk2(x0[10], x0[11]); pw[1].z = pk2(x0[12], x0[13]); pw[1].w = pk2(x0[14], x0[15]);
        pw[2].x = pk2(x1[0], x1[1]); pw[2].y = pk2(x1[2], x1[3]); pw[2].z = pk2(x1[4], x1[5]); pw[2].w = pk2(x1[6], x1[7]);
        pw[3].x = pk2(x1[8], x1[9]); pw[3].y = pk2(x1[10], x1[11]); pw[3].z = pk2(x1[12], x1[13]); pw[3].w = pk2(x1[14], x1[15]);
#define MA_VF(dst, db_, s_) do { const LAS unsigned char* vb_ = vbase + (db_) * 32 * MA_VP + kb * 64 + (s_) * 32; const v2u a_ = *(const LAS v2u*)(vb_), b_ = *(const LAS v2u*)(vb_ + 16); \
            dst.x = a_.x; dst.y = a_.y; dst.z = b_.x; dst.w = b_.y; } while (0)
        v4u c[4], n[4];
#pragma unroll
        for (int s_ = 0; s_ < 4; ++s_) MA_VF(c[s_], 0, s_);
#pragma unroll
        for (int db = 0; db < 4; ++db) {
            if (db < 3) {
#pragma unroll
                for (int s_ = 0; s_ < 4; ++s_) MA_VF(n[s_], db + 1, s_); }
            __builtin_amdgcn_sched_barrier(0);
#pragma unroll
            for (int s_ = 0; s_ < 4; ++s_) o[db] = __builtin_amdgcn_mfma_f32_32x32x16_bf16(__builtin_bit_cast(bf16x8, c[s_]), __builtin_bit_cast(bf16x8, pw[s_]), o[db], 0, 0, 0);
            __builtin_amdgcn_sched_barrier(0);
#pragma unroll
            for (int s_ = 0; s_ < 4; ++s_) c[s_] = n[s_];
        }
#undef MA_VF
    }
    lsum += __shfl_xor(lsum, 32);
    const float rl = 1.0f / lsum;
#pragma unroll
    for (int db = 0; db < 4; ++db)
#pragma unroll
        for (int g = 0; g < 4; ++g) { v2u w; w.x = pk2(o[db][4 * g] * rl, o[db][4 * g + 1] * rl); w.y = pk2(o[db][4 * g + 2] * rl, o[db][4 * g + 3] * rl);
            *(v2u*)(qrow + 32 * db + 8 * g + 4 * hh) = w; }
}
#ifdef DBGCHK
__device__ __forceinline__ float bf2f(bf16 v) { return __builtin_bit_cast(float, (unsigned)v << 16); }
__device__ __forceinline__ unsigned hsh(unsigned s, unsigned k) { unsigned h = s * 2654435761u + k * 40503u + 12345u; h ^= h >> 13; h *= 2246822519u; h ^= h >> 16; return h; }
__device__ __forceinline__ void chk(unsigned* flag, int stage, float got, float want, float tol) { if (!(fabsf(got - want) <= tol * (fabsf(want) + 1.0f))) atomicMin(flag, (unsigned)stage); }
__device__ __forceinline__ float row_rstd(const float* xr, int lane) { float s = 0.f; for (int k = lane; k < 2048; k += 64) s += xr[k] * xr[k]; s = wave_sum(s); return rsqrtf(s * (1.0f / 2048.0f) + RMS_EPS); }
__device__ __forceinline__ float row_dot(const float* xr, const float* g, const float* W, int ldw, int col, int lane) { float s = 0.f; for (int k = lane; k < 2048; k += 64) s += xr[k] * (g ? g[k] : 1.0f) * W[(size_t)k * ldw + col]; return wave_sum(s); }
__device__ __forceinline__ void chk_memattn(unsigned* flag, int stage, const float* xr, const float* g, const float* W, int ldw, int wcol, const bf16* kp, const bf16* vp, const float* qg, const float* kg, const bf16* got, LAS float* scr, int lane) {
    const float rs = row_rstd(xr, lane);
    for (int d = 0; d < 128; ++d) { const float v = row_dot(xr, g, W, ldw, wcol + d, lane) * rs; if (lane == 0) scr[d] = v; }
    LDS_WAIT();
    float ss = 0.f; for (int d = 0; d < 128; ++d) ss += scr[d] * scr[d];
    const float qr = rsqrtf(ss * (1.0f / 128.0f) + RMS_EPS);
    float sc[4], mx = -1e30f;
#pragma unroll
    for (int i = 0; i < 4; ++i) { const int j = lane + 64 * i; float ks = 0.f; for (int d = 0; d < 128; ++d) { const float kv = bf2f(kp[(size_t)j * 2048 + d]); ks += kv * kv; }
        const float kr = rsqrtf(ks * (1.0f / 128.0f) + RMS_EPS); float s = 0.f;
        for (int d = 0; d < 128; ++d) s += scr[d] * qr * qg[d] * bf2f(kp[(size_t)j * 2048 + d]) * kr * kg[d];
        sc[i] = s * 0.08838834764831845f; mx = fmaxf(mx, sc[i]); }
    for (int o = 1; o < 64; o <<= 1) mx = fmaxf(mx, __shfl_xor(mx, o));
    float l = 0.f;
#pragma unroll
    for (int i = 0; i < 4; ++i) { sc[i] = expf(sc[i] - mx); l += sc[i]; }
    l = wave_sum(l);
#pragma unroll
    for (int i = 0; i < 4; ++i) scr[128 + lane + 64 * i] = sc[i] / l;
    LDS_WAIT();
    for (int dd = 0; dd < 2; ++dd) { const int d = lane + 64 * dd; float o = 0.f; for (int j = 0; j < 256; ++j) o += scr[128 + j] * bf2f(vp[(size_t)j * 2048 + d]);
        chk(flag, stage, bf2f(got[d]), o, 0.05f); }
    LDS_WAIT();
}
__device__ __forceinline__ float naive_diff(const bf16* big, int row, int qcol, int kcol, int vcol, LAS float* scr, int lane) {
    const int b = row >> 11, t = row & 2047; const bf16* q = big + (size_t)row * BIGP + qcol;
    float mx = -1e30f;
    for (int j = lane; j <= t; j += 64) { const bf16* k = big + (size_t)(b * 2048 + j) * BIGP + kcol; float s = 0.f; for (int d = 0; d < 64; ++d) s += bf2f(q[d]) * bf2f(k[d]); scr[j] = s; mx = fmaxf(mx, s); }
    for (int o = 1; o < 64; o <<= 1) mx = fmaxf(mx, __shfl_xor(mx, o));
    float l = 0.f; for (int j = lane; j <= t; j += 64) { const float p = exp2f(scr[j] - mx); scr[j] = p; l += p; } l = wave_sum(l);
    LDS_WAIT();
    float o = 0.f; for (int j = 0; j <= t; ++j) o += scr[j] * bf2f(big[(size_t)(b * 2048 + j) * BIGP + vcol + lane]);
    LDS_WAIT();
    return o / l;
}
#endif
constexpr int DA_KP = 144, DA_VP = 144;
constexpr int DA_K_BYTES = 64 * DA_KP, DA_V_BYTES = 128 * DA_VP, DA_BUF = DA_K_BYTES + DA_V_BYTES;
__device__ __forceinline__ void diffattn_core(const bf16* qp, const bf16* kp, const bf16* vp, int qb, LAS unsigned char* lds, int wid, int lane, f32x16 (&o)[4], float& rl) {
    const int tid = wid * 64 + lane, r32 = lane & 31, hh = lane >> 5;
    const int q0 = qb * 256 + wid * 32;
    const int NT = 4 * (qb + 1);
    const bf16* kg = kp + (size_t)(tid >> 3) * BIGP + 8 * (tid & 7);
    const bf16* vg = vp + (size_t)lane * BIGP + 16 * wid;
    v4u kr = *(const v4u*)kg, vr0 = *(const v4u*)vg, vr1 = *(const v4u*)(vg + 8);
    bf16x8 qr[4];
    { const bf16* qrow = qp + (size_t)(q0 + r32) * BIGP;
#pragma unroll
      for (int d0 = 0; d0 < 4; ++d0) qr[d0] = *(const bf16x8*)(qrow + 16 * d0 + 8 * hh); }
    o[0] = f32x16{}; o[1] = f32x16{}; o[2] = f32x16{}; o[3] = f32x16{};
    float lsum = 0.f;
    __syncthreads();
#define DA_WRITE(buf) do { LAS unsigned char* kb_ = lds + (buf) * DA_BUF; \
        *(LAS v4u*)(kb_ + (tid >> 3) * DA_KP + 16 * (tid & 7)) = kr; \
        LAS unsigned short* d_ = (LAS unsigned short*)(kb_ + DA_K_BYTES + (16 * wid) * DA_VP + 2 * lane); \
        d_[0 * (DA_VP / 2)] = (unsigned short)(vr0.x & 0xffffu); d_[1 * (DA_VP / 2)] = (unsigned short)(vr0.x >> 16); d_[2 * (DA_VP / 2)] = (unsigned short)(vr0.y & 0xffffu); d_[3 * (DA_VP / 2)] = (unsigned short)(vr0.y >> 16); \
        d_[4 * (DA_VP / 2)] = (unsigned short)(vr0.z & 0xffffu); d_[5 * (DA_VP / 2)] = (unsigned short)(vr0.z >> 16); d_[6 * (DA_VP / 2)] = (unsigned short)(vr0.w & 0xffffu); d_[7 * (DA_VP / 2)] = (unsigned short)(vr0.w >> 16); \
        d_[8 * (DA_VP / 2)] = (unsigned short)(vr1.x & 0xffffu); d_[9 * (DA_VP / 2)] = (unsigned short)(vr1.x >> 16); d_[10 * (DA_VP / 2)] = (unsigned short)(vr1.y & 0xffffu); d_[11 * (DA_VP / 2)] = (unsigned short)(vr1.y >> 16); \
        d_[12 * (DA_VP / 2)] = (unsigned short)(vr1.z & 0xffffu); d_[13 * (DA_VP / 2)] = (unsigned short)(vr1.z >> 16); d_[14 * (DA_VP / 2)] = (unsigned short)(vr1.w & 0xffffu); d_[15 * (DA_VP / 2)] = (unsigned short)(vr1.w >> 16); } while (0)
    DA_WRITE(0);
    __builtin_amdgcn_s_waitcnt(0x0F70);
    __syncthreads();
#pragma unroll 1
    for (int t = 0; t < NT; ++t) {
        if (t + 1 < NT) { kr = *(const v4u*)(kg + (size_t)(t + 1) * 64 * BIGP); vr0 = *(const v4u*)(vg + (size_t)(t + 1) * 64 * BIGP); vr1 = *(const v4u*)(vg + (size_t)(t + 1) * 64 * BIGP + 8); }
        const LAS unsigned char* kbase = lds + (t & 1) * DA_BUF + r32 * DA_KP + 16 * hh;
        const LAS unsigned char* vbase = lds + (t & 1) * DA_BUF + DA_K_BYTES + r32 * DA_VP + 8 * hh;
        if (t * 64 + 63 <= q0) {
            bf16x8 kf[8];
#pragma unroll
            for (int i = 0; i < 8; ++i) kf[i] = *(const LAS bf16x8*)(kbase + (i >> 2) * 32 * DA_KP + 32 * (i & 3));
            f32x16 x0 = f32x16{}, x1 = f32x16{};
#pragma unroll
            for (int d0 = 0; d0 < 4; ++d0) { x0 = __builtin_amdgcn_mfma_f32_32x32x16_bf16(kf[d0], qr[d0], x0, 0, 0, 0); x1 = __builtin_amdgcn_mfma_f32_32x32x16_bf16(kf[4 + d0], qr[d0], x1, 0, 0, 0); }
            float sacc = 0.f;
#pragma unroll
            for (int r = 0; r < 16; ++r) { x0[r] = __builtin_amdgcn_exp2f(x0[r]); sacc += x0[r]; }
            v4u pa, pb;
            pa.x = pg8::cvt_pk_bf16(x0[0], x0[1]); pa.y = pg8::cvt_pk_bf16(x0[2], x0[3]); pa.z = pg8::cvt_pk_bf16(x0[4], x0[5]); pa.w = pg8::cvt_pk_bf16(x0[6], x0[7]);
            pb.x = pg8::cvt_pk_bf16(x0[8], x0[9]); pb.y = pg8::cvt_pk_bf16(x0[10], x0[11]); pb.z = pg8::cvt_pk_bf16(x0[12], x0[13]); pb.w = pg8::cvt_pk_bf16(x0[14], x0[15]);
#define DA_VF(dst0, dst1, db_, blk_) do { const LAS unsigned char* vb_ = vbase + (db_) * 32 * DA_VP + (blk_) * 64; \
                const v2u a0_ = *(const LAS v2u*)(vb_), a1_ = *(const LAS v2u*)(vb_ + 16), b0_ = *(const LAS v2u*)(vb_ + 32), b1_ = *(const LAS v2u*)(vb_ + 48); \
                dst0.x = a0_.x; dst0.y = a0_.y; dst0.z = a1_.x; dst0.w = a1_.y; dst1.x = b0_.x; dst1.y = b0_.y; dst1.z = b1_.x; dst1.w = b1_.y; } while (0)
            v4u c0, c1, n0, n1;
            DA_VF(c0, c1, 0, 0);
#pragma unroll
            for (int db = 0; db < 4; ++db) {
                if (db < 3) DA_VF(n0, n1, db + 1, 0); else DA_VF(n0, n1, 0, 1);
                __builtin_amdgcn_sched_barrier(0);
                o[db] = __builtin_amdgcn_mfma_f32_32x32x16_bf16(__builtin_bit_cast(bf16x8, c0), __builtin_bit_cast(bf16x8, pa), o[db], 0, 0, 0);
                o[db] = __builtin_amdgcn_mfma_f32_32x32x16_bf16(__builtin_bit_cast(bf16x8, c1), __builtin_bit_cast(bf16x8, pb), o[db], 0, 0, 0);
#pragma unroll
                for (int r = 4 * db; r < 4 * db + 4; ++r) { x1[r] = __builtin_amdgcn_exp2f(x1[r]); sacc += x1[r]; }
                __builtin_amdgcn_sched_barrier(0);
                c0 = n0; c1 = n1;
            }
            lsum += sacc;
            pa.x = pg8::cvt_pk_bf16(x1[0], x1[1]); pa.y = pg8::cvt_pk_bf16(x1[2], x1[3]); pa.z = pg8::cvt_pk_bf16(x1[4], x1[5]); pa.w = pg8::cvt_pk_bf16(x1[6], x1[7]);
            pb.x = pg8::cvt_pk_bf16(x1[8], x1[9]); pb.y = pg8::cvt_pk_bf16(x1[10], x1[11]); pb.z = pg8::cvt_pk_bf16(x1[12], x1[13]); pb.w = pg8::cvt_pk_bf16(x1[14], x1[15]);
#pragma unroll
            for (int db = 0; db < 4; ++db) {
                if (db < 3) DA_VF(n0, n1, db + 1, 1);
                __builtin_amdgcn_sched_barrier(0);
                o[db] = __builtin_amdgcn_mfma_f32_32x32x16_bf16(__builtin_bit_cast(bf16x8, c0), __builtin_bit_cast(bf16x8, pa), o[db], 0, 0, 0);
                o[db] = __builtin_amdgcn_mfma_f32_32x32x16_bf16(__builtin_bit_cast(bf16x8, c1), __builtin_bit_cast(bf16x8, pb), o[db], 0, 0, 0);
                __builtin_amdgcn_sched_barrier(0);
                c0 = n0; c1 = n1;
            }
#undef DA_VF
        } else
#pragma unroll
        for (int kb = 0; kb < 2; ++kb) {
            const int k0 = t * 64 + kb * 32;
            if (k0 <= q0 + 31) {
                f32x16 x = f32x16{};
#pragma unroll
                for (int d0 = 0; d0 < 4; ++d0) { const bf16x8 kf = *(const LAS bf16x8*)(kbase + kb * 32 * DA_KP + 32 * d0);
                    x = __builtin_amdgcn_mfma_f32_32x32x16_bf16(kf, qr[d0], x, 0, 0, 0); }
#pragma unroll
                for (int r = 0; r < 16; ++r) x[r] = __builtin_amdgcn_exp2f(x[r]);
                if (k0 + 31 > q0) {
                    asm volatile("" ::: "memory");
#pragma unroll
                    for (int r = 0; r < 16; ++r) { const int kv = k0 + (r & 3) + 8 * (r >> 2) + 4 * hh; x[r] = (kv > q0 + r32) ? 0.f : x[r]; }
                    asm volatile("" ::: "memory");
                }
                float sacc = 0.f;
#pragma unroll
                for (int r = 0; r < 16; ++r) sacc += x[r];
                lsum += sacc;
                v4u pw0, pw1;
                pw0.x = pg8::cvt_pk_bf16(x[0], x[1]); pw0.y = pg8::cvt_pk_bf16(x[2], x[3]); pw0.z = pg8::cvt_pk_bf16(x[4], x[5]); pw0.w = pg8::cvt_pk_bf16(x[6], x[7]);
                pw1.x = pg8::cvt_pk_bf16(x[8], x[9]); pw1.y = pg8::cvt_pk_bf16(x[10], x[11]); pw1.z = pg8::cvt_pk_bf16(x[12], x[13]); pw1.w = pg8::cvt_pk_bf16(x[14], x[15]);
                const bf16x8 p0 = __builtin_bit_cast(bf16x8, pw0), p1 = __builtin_bit_cast(bf16x8, pw1);
#define DA_VF2(dst0, dst1, db_) do { const LAS unsigned char* vb_ = vbase + (db_) * 32 * DA_VP + kb * 64; \
                    const v2u a0_ = *(const LAS v2u*)(vb_), a1_ = *(const LAS v2u*)(vb_ + 16), b0_ = *(const LAS v2u*)(vb_ + 32), b1_ = *(const LAS v2u*)(vb_ + 48); \
                    dst0.x = a0_.x; dst0.y = a0_.y; dst0.z = a1_.x; dst0.w = a1_.y; dst1.x = b0_.x; dst1.y = b0_.y; dst1.z = b1_.x; dst1.w = b1_.y; } while (0)
                v4u c0, c1, n0, n1;
                DA_VF2(c0, c1, 0);
#pragma unroll
                for (int db = 0; db < 4; ++db) {
                    if (db < 3) DA_VF2(n0, n1, db + 1);
                    __builtin_amdgcn_sched_barrier(0);
                    o[db] = __builtin_amdgcn_mfma_f32_32x32x16_bf16(__builtin_bit_cast(bf16x8, c0), p0, o[db], 0, 0, 0);
                    o[db] = __builtin_amdgcn_mfma_f32_32x32x16_bf16(__builtin_bit_cast(bf16x8, c1), p1, o[db], 0, 0, 0);
                    __builtin_amdgcn_sched_barrier(0);
                    c0 = n0; c1 = n1;
                }
#undef DA_VF2
            }
        }
        if (t + 1 < NT) DA_WRITE((t + 1) & 1);
        __syncthreads();
    }
#undef DA_WRITE
    lsum += __shfl_xor(lsum, 32);
    rl = 1.0f / lsum;
}
constexpr int DA_PARK = 57344;
__device__ __forceinline__ void diffattn_pair(bf16* rb, int h, int qb, float lam, const float* subln, LAS unsigned char* lds, int wid, int lane) {
    f32x16 o[4]; float rl;
    diffattn_core(rb + 3072 + h * 64, rb + h * 64, rb + 1536 + h * 128, qb, lds, wid, lane, o, rl);
    LAS unsigned* park = (LAS unsigned*)(lds + DA_PARK) + (wid * 64 + lane);
#pragma unroll
    for (int db = 0; db < 4; ++db)
#pragma unroll
        for (int rp = 0; rp < 8; ++rp) park[(db * 8 + rp) * 512] = pk2(o[db][2 * rp] * rl, o[db][2 * rp + 1] * rl);
    diffattn_core(rb + 3840 + h * 64, rb + 768 + h * 64, rb + 1536 + h * 128, qb, lds, wid, lane, o, rl);
    const float lr = lam * rl; float ss = 0.f;
#pragma unroll
    for (int db = 0; db < 4; ++db)
#pragma unroll
        for (int rp = 0; rp < 8; ++rp) { const unsigned w = park[(db * 8 + rp) * 512];
            const float a0 = bflo(w) - lr * o[db][2 * rp], a1 = bfhi(w) - lr * o[db][2 * rp + 1];
            o[db][2 * rp] = a0; o[db][2 * rp + 1] = a1; ss += a0 * a0 + a1 * a1; }
    ss += __shfl_xor(ss, 32);
    const float rs = rsqrtf(ss * (1.0f / 128.0f) + RMS_EPS) * (1.0f - 0.35550906759096934f);
    int tl_ = threadIdx.x; asm volatile("" : "+v"(tl_));
    const int r32e = tl_ & 31, hhe = (tl_ >> 5) & 1;
    bf16* orow = rb + (size_t)(qb * 256 + wid * 32 + r32e) * BIGP + 5120 + h * 128;
#pragma unroll
    for (int db = 0; db < 4; ++db)
#pragma unroll
        for (int g = 0; g < 4; ++g) { const f32x4 gg = *(const f32x4*)(subln + 32 * db + 8 * g + 4 * hhe);
            v2u w; w.x = pk2(o[db][4 * g] * rs * gg.x, o[db][4 * g + 1] * rs * gg.y); w.y = pk2(o[db][4 * g + 2] * rs * gg.z, o[db][4 * g + 3] * rs * gg.w);
            *(v2u*)(orow + 32 * db + 8 * g + 4 * hhe) = w; }
}
__device__ __forceinline__ int da_tab(int role, int k) {
    const unsigned long long c = (k == 0) ? 0xa16ce35de7ull : (k == 1) ? 0x9d56c68864ull : 0x9455042420ull;
    return (int)((c >> (5 * role)) & 31ull);
}
struct DiffUnit { int row, qb; };
__device__ __forceinline__ bool diff_next(int vcu, int G, int i, DiffUnit& u) {
    const int rep = i / 12, k = i - rep * 12; const int p = (vcu >> 1) + rep * (G >> 1); if (p >= 128) return false;
    const int role = vcu & 1;
    if (k < 8) { u.row = 3 * p + role; u.qb = 7 - k; }
    else { const int jx = k - 8; u.row = 3 * p + 2; u.qb = role == 0 ? ((jx & 1) ? (jx >> 1) : 7 - (jx >> 1)) : ((jx & 1) ? 2 + (jx >> 1) : 5 - (jx >> 1)); }
    return true;
}

struct Args { const float* in[20]; float* out; unsigned char* ws; int ph_lo, ph_hi; };

__global__ void __launch_bounds__(NTHREADS, 2) mega_fwd(Args args) {
    extern __shared__ __attribute__((aligned(16))) unsigned char lds_raw[];
    LAS unsigned char* lds = (LAS unsigned char*)lds_raw;
    cg::grid_group grid = cg::this_grid();
#ifdef TPHASE
    unsigned long long tst0 = 0, tst1 = 0;
#define TSTART(k) do { if ((k) == TPHASE) tst0 = __builtin_amdgcn_s_memrealtime(); } while (0)
#define TEND(k) do { if ((k) == TPHASE) tst1 = __builtin_amdgcn_s_memrealtime(); } while (0)
#else
#define TSTART(k) do {} while (0)
#define TEND(k) do {} while (0)
#endif
    { volatile LAS unsigned* st_ = (volatile LAS unsigned*)(lds + LDS_BYTES - 64); if (threadIdx.x < 2) st_[threadIdx.x] = 0u; __syncthreads();
      (void)xcd_barrier_post((unsigned*)(args.ws + WS_BAR), st_); }
    grid.sync();
#define TIDS() int tid_ = threadIdx.x; asm volatile("" : "+v"(tid_)); const int tid = tid_, lane = tid & 63, wid = __builtin_amdgcn_readfirstlane(tid >> 6); \
    int bx_ = blockIdx.x; asm volatile("" : "+s"(bx_)); const int bx = bx_, G = gridDim.x, vcu = (G % 8 == 0) ? (bx % 8) * (G / 8) + bx / 8 : bx, gw = vcu * NWAVES + wid, NGW = G * NWAVES; \
    LAS float* scr = (LAS float*)(lds + wid * 16384); (void)tid; (void)lane; (void)gw; (void)NGW; (void)scr; (void)vcu
    typedef const __attribute__((address_space(4))) Args* kargp_t;
#define KARG() kargp_t ap = (kargp_t)__builtin_amdgcn_kernarg_segment_ptr(); asm volatile("" : "+s"(ap)); unsigned char* ws = ap->ws; (void)ws
#define INP(k) (ap->in[k])
#define WSP(T, off) ((T*)(ws + (off)))
#define lamp WSP(float, WS_SMALL)
#define rss0 WSP(float, WS_SMALL + 65536)
#define rss1 ((float*)((char*)(ap->out) + 64 * MiB))
#define rss2 ((float*)((char*)(ap->out) + 66 * MiB))
#define rss3 ((float*)((char*)(ap->out) + 68 * MiB))
#define rope WSP(float, WS_SMALL + 524288)
#define W1 WSP(bf16, WS_W1)
#define WPOOL WSP(bf16, WS_POOL)
#define WO0 WSP(bf16, WS_WO0)
#define WO1 WSP(bf16, WS_WO1)
#define W6 WSP(bf16, WS_W6)
#define WF1 WSP(bf16, WS_WF1)
#define WF2 WSP(bf16, WS_WF2)
#define WF2B WSP(bf16, WS_WF2B)
#define MKV WSP(bf16, WS_MKV)
#define XB WSP(bf16, WS_XB)
#define BIG WSP(bf16, WS_BIG)
#define DFLAG WSP(unsigned, WS_SMALL + 1024)
#define x_in INP(0)
#define mem_in INP(1)
#define mix_norm INP(2)
#define w_in INP(3)
#define w_out INP(4)
#define mem_norm INP(5)
#define w_mem_kv INP(6)
#define mem_q_norm INP(7)
#define mem_k_norm INP(8)
#define ffn_norm INP(9)
#define w_ff1 INP(10)
#define w_ff2 INP(11)
#define pool_w INP(12)
#define pool_scale INP(13)
#define kv_norm INP(14)
#define w_kv INP(15)
#define k_norm INP(16)
#define q_norm INP(17)
#define diff_lambda INP(18)
#define subln_norm INP(19)
#define out_p (ap->out)
#define IN(k) true
#define CGSYNC() do { asm volatile("s_waitcnt vmcnt(0) lgkmcnt(0)" ::: "memory"); grid.sync(); asm volatile("buffer_inv sc1\n\ts_waitcnt vmcnt(0)" ::: "memory"); } while (0)
#define GSYNC() do { kargp_t ap_ = (kargp_t)__builtin_amdgcn_kernarg_segment_ptr(); asm volatile("" : "+s"(ap_)); XcdBarrier b_; b_.bar = (unsigned*)(ap_->ws + WS_BAR); b_.x = xb_xcc_id(); \
    b_.st = (volatile LAS unsigned*)(lds + LDS_BYTES - 64); xcd_barrier(b_); } while (0)
#define SEAM(k) do { if (IN(k) && IN((k) + 1)) GSYNC(); } while (0)

    TSTART(0); if (IN(0)) {
        KARG(); TIDS();
        int cursor = 0;
        { TJob j{w_in, 2048, 2048, W1, 0, mix_norm, nullptr, 0, 0, 0}; run_tjob(j, scr, gw, NGW, lane, cursor); }
        { TJob j{w_mem_kv, 2048, 1024, W1, 2048, mem_norm, nullptr, 0, 0, 0}; run_tjob(j, scr, gw, NGW, lane, cursor); }
        { TJob j{w_mem_kv + (size_t)2048 * 1024, 2048, 1024, W1, 3072, mem_norm + 2048, nullptr, 0, 0, 0}; run_tjob(j, scr, gw, NGW, lane, cursor); }
#pragma unroll 1
        for (int g = 0; g < 4; ++g) { TJob j{pool_w + (size_t)g * 384 * 384, 384, 384, WPOOL, g * 512, nullptr, pool_scale + g * 384, 0, 0, 0}; run_tjob(j, scr, gw, NGW, lane, cursor); }
        { TJob j{w_out, 2048, 2048, WO0, 0, nullptr, nullptr, 1, 0, 0}; run_tjob(j, scr, gw, NGW, lane, cursor); }
        { TJob j{w_out + (size_t)2048 * 2048, 2048, 2048, WO1, 0, nullptr, nullptr, 1, 0, 0}; run_tjob(j, scr, gw, NGW, lane, cursor); }
        { TJob j{w_kv, 2048, 3072, W6, 0, kv_norm, nullptr, 0, 1, 0}; run_tjob(j, scr, gw, NGW, lane, cursor); }
        { TJob j{w_in + (size_t)2048 * 2048, 2048, 2048, W6, 3072, mix_norm + 2048, nullptr, 0, 1, 0}; run_tjob(j, scr, gw, NGW, lane, cursor); }
        { TJob j{w_ff1, 2048, 8192, WF1, 0, ffn_norm, nullptr, 0, 0, 0}; run_tjob(j, scr, gw, NGW, lane, cursor); }
        { TJob j{w_ff2, 8192, 2048, WF2, 0, nullptr, nullptr, 0, 0, WF2P}; run_tjob(j, scr, gw, NGW, lane, cursor); }
        for (int i = gw * 64 + lane; i < 4 * 128 * 384 / 8; i += NGW * 64) { const int g = i / (128 * 48), r = i % (128 * 48); *(v4u*)(WPOOL + (size_t)(g * 512 + 384) * 384 + (size_t)r * 8) = (v4u){0u, 0u, 0u, 0u}; }
        for (int m = gw; m < M + MEMROWS; m += NGW) row_to_bf16(m < M ? x_in + (size_t)m * DM : mem_in + (size_t)(m - M) * DM, XB + (size_t)m * DM, rss0 + m, lane);
        for (int i = gw * 64 + lane; i < 2048 * 8; i += NGW * 64) { const int pos = i >> 3, fi = i & 7;
            const double invf = fi == 0 ? 1.0 : fi == 1 ? 0.19392274474868576 : fi == 2 ? 0.03760603093086393 : fi == 3 ? 0.007292664737217109 : fi == 4 ? 0.001414213562373095 : fi == 5 ? 0.0002742481756762073 : fi == 6 ? 5.318295896944988e-05 : 1.031338537721246e-05;
            double rev = (double)pos * invf * 0.15915494309189535; rev -= __builtin_rint(rev);
            rope[pos * 16 + fi] = __builtin_amdgcn_cosf((float)rev); rope[pos * 16 + 8 + fi] = __builtin_amdgcn_sinf((float)rev); }
#ifdef DBGCHK
        if (gw == 0 && lane == 0) DFLAG[0] = 0xffffffffu;
#endif
        if (gw == 0) { float a = diff_lambda[lane] * diff_lambda[64 + lane], b = diff_lambda[128 + lane] * diff_lambda[192 + lane]; a = wave_sum(a); b = wave_sum(b);
            if (lane == 0) lamp[0] = expf(a) - expf(b) + 0.35550906759096934f; }
    }
    GSYNC(); TEND(0);
    TSTART(1); if (IN(1)) {
        KARG(); TIDS();
        pg8::GemmX g{XB, W1, M, 2048, 2048, 2048, 2048}; pg8::SchedStd S; S.init(M, 2048, G, bx, 4);
        pg8::EpiP1 E{BIG, MKV, rss0};
        pg8::gemm_phase<pg8::EpiP1, pg8::SchedStd, true, true>(lds, g, S, E);
    }
    SEAM(1); TEND(1);
#ifdef DBGCHK
    { KARG(); TIDS(); if (gw < 64) { const int s_ = gw; (void)s_;
        { const int row = hsh(s_, 1) % 16384, col = hsh(s_, 2) % 2048; const float* xr = x_in + (size_t)row * 2048;
          const float want = row_dot(xr, mix_norm, w_in, 2048, col, lane) * row_rstd(xr, lane);
          chk(DFLAG, 1, bf2f(BIG[(size_t)row * BIGP + (col < 1536 ? col : 3072 + col - 1536)]), want, 0.03f); }
        { const int mrow = hsh(s_, 3) % 2048, mcol = hsh(s_, 4) % 2048, layer = mcol >> 10; const float* xr = mem_in + (size_t)mrow * 2048;
          const float want = row_dot(xr, mem_norm + layer * 2048, w_mem_kv + (size_t)layer * 2048 * 1024, 1024, mcol & 1023, lane) * row_rstd(xr, lane);
          chk(DFLAG, 2, bf2f(MKV[(size_t)mrow * 2048 + mcol]), want, 0.03f); }
    } GSYNC(); }
#endif

    TSTART(2); if (IN(2)) {
        KARG(); TIDS();
        if (bx < 64 && G > 64) {
            pg8::GemmX g{XB, W1, M + MEMROWS, 4096, 2048, 2048, 2048}; pg8::SchedMem S; S.init(bx);
            pg8::EpiP1 E{BIG, MKV, rss0};
            pg8::gemm_phase<pg8::EpiP1, pg8::SchedMem, true, true>(lds, g, S, E);
        } else {
        for (int it = (bx - 64) * NWAVES + wid; it < 3072; it += (G - 64) * NWAVES) {
            const int span = it % 3, rb = it / 3, m0 = rb * 16, t0 = m0 & 2047;
            const int col = span * 512 + lane * 8; const int w = 2 << (col / 384);
            const bf16* src = BIG + (size_t)m0 * BIGP + col; bf16* dst = BIG + (size_t)m0 * BIGP + 1536 + col;
            v4u R[32];
#pragma unroll
            for (int i = 0; i < 16; ++i) R[i] = (t0 > 0) ? *(const v4u*)(src - (size_t)(16 - i) * BIGP) : (v4u){0u, 0u, 0u, 0u};
#pragma unroll
            for (int i = 0; i < 16; ++i) R[16 + i] = *(const v4u*)(src + (size_t)i * BIGP);
            float s[8];
#pragma unroll
            for (int e = 0; e < 8; ++e) s[e] = 0.f;
#pragma unroll
            for (int i = 0; i < 16; ++i) { const bool in = (16 - i) <= w;
                s[0] += in ? bflo(R[i].x) : 0.f; s[1] += in ? bfhi(R[i].x) : 0.f; s[2] += in ? bflo(R[i].y) : 0.f; s[3] += in ? bfhi(R[i].y) : 0.f;
                s[4] += in ? bflo(R[i].z) : 0.f; s[5] += in ? bfhi(R[i].z) : 0.f; s[6] += in ? bflo(R[i].w) : 0.f; s[7] += in ? bfhi(R[i].w) : 0.f; }
#pragma unroll
            for (int r = 0; r < 16; ++r) { const int t = t0 + r; const v4u q = R[16 + r];
                const v4u p = (w == 2) ? R[14 + r] : (w == 4) ? R[12 + r] : (w == 8) ? R[8 + r] : R[r];
                float c[8]; c[0] = bflo(q.x); c[1] = bfhi(q.x); c[2] = bflo(q.y); c[3] = bfhi(q.y); c[4] = bflo(q.z); c[5] = bfhi(q.z); c[6] = bflo(q.w); c[7] = bfhi(q.w);
                s[0] += c[0] - bflo(p.x); s[1] += c[1] - bfhi(p.x); s[2] += c[2] - bflo(p.y); s[3] += c[3] - bfhi(p.y); s[4] += c[4] - bflo(p.z); s[5] += c[5] - bfhi(p.z); s[6] += c[6] - bflo(p.w); s[7] += c[7] - bfhi(p.w);
                const float ic = 1.0f / (float)((t + 1) < w ? (t + 1) : w);
                v4u o; o.x = pk2(s[0] * ic - c[0], s[1] * ic - c[1]); o.y = pk2(s[2] * ic - c[2], s[3] * ic - c[3]); o.z = pk2(s[4] * ic - c[4], s[5] * ic - c[5]); o.w = pk2(s[6] * ic - c[6], s[7] * ic - c[7]);
                *(v4u*)(dst + (size_t)r * BIGP) = o; }
        }
        }
        { unsigned* qhead = (unsigned*)(ws + WS_BAR) + 3840;
          TJob j1{w_ff1 + (size_t)2048 * 8192, 2048, 8192, (bf16*)out_p, 0, ffn_norm + 2048, nullptr, 0, 0, 0};
          TJob j2{w_ff2 + (size_t)8192 * 2048, 8192, 2048, WF2B, 0, nullptr, nullptr, 0, 0, WF2P};
          for (;;) { unsigned base = 0u; if (lane == 0) base = __hip_atomic_fetch_add(qhead, 8u, __ATOMIC_RELAXED, __HIP_MEMORY_SCOPE_AGENT);
              base = (unsigned)__builtin_amdgcn_readfirstlane((int)base); if (base >= 16384u) break;
#pragma unroll 1
              for (int k = 0; k < 8; ++k) { const int it = (int)base + k; if (it < 8192) transpose_item(j1, scr, it, lane); else transpose_item(j2, scr, it - 8192, lane); } } }
    }
    SEAM(2); TEND(2);
#ifdef DBGCHK
    { KARG(); TIDS(); if (gw < 64) { const int s_ = gw; (void)s_;
        { const int row = hsh(s_, 5) % 16384, col = hsh(s_, 6) % 1536, w = 2 << (col / 384), t = row & 2047; float sum = 0.f; const int n = (t + 1) < w ? (t + 1) : w;
          for (int j = 0; j < n; ++j) sum += bf2f(BIG[(size_t)(row - j) * BIGP + col]);
          const float want = sum / (float)n - bf2f(BIG[(size_t)row * BIGP + col]);
          chk(DFLAG, 3, bf2f(BIG[(size_t)row * BIGP + 1536 + col]), want, 0.03f); }
        if (s_ < 16) { const int row = hsh(s_, 7) % 16384, h = s_ & 3, b = row >> 11;
          chk_memattn(DFLAG, 4, x_in + (size_t)row * 2048, mix_norm, w_in, 2048, 1536 + 128 * h, MKV + (size_t)(b * 256) * 2048 + 128 * h, MKV + (size_t)(b * 256) * 2048 + 512 + 128 * h,
                      mem_q_norm, mem_k_norm, BIG + (size_t)row * BIGP + 3072 + 128 * h, scr, lane); }
    } GSYNC(); }
#endif

    TSTART(3); if (IN(3)) {
        KARG(); TIDS();
        pg8::GemmX g{BIG + 1536, WPOOL, M, 2048, 384, BIGP, 384}; pg8::SchedPool S; S.init(G, bx);
        pg8::EpiPool E{BIG};
        pg8::gemm_phase<pg8::EpiPool, pg8::SchedPool, true, true>(lds, g, S, E);
        for (int u = vcu; u < 256; u += G) { const int b = u >> 5, h = (u >> 3) & 3, qb = u & 7;
            memattn_unit(BIG + (size_t)(b * SEQ + qb * 256) * BIGP + 3072 + 128 * h, MKV + (size_t)(b * 256) * 2048 + 128 * h, MKV + (size_t)(b * 256) * 2048 + 512 + 128 * h, mem_q_norm, mem_k_norm, lds, wid, lane); }
        __syncthreads();
    }
    SEAM(3); TEND(3);
#ifdef DBGCHK
    { KARG(); TIDS(); if (gw < 64) { const int s_ = gw; (void)s_;
        { const int row = hsh(s_, 8) % 16384, col = hsh(s_, 9) % 1536, g = col / 384, d = col % 384; float sum = 0.f;
          for (int c = lane; c < 384; c += 64) sum += bf2f(BIG[(size_t)row * BIGP + 1536 + 384 * g + c]) * pool_w[((size_t)g * 384 + c) * 384 + d];
          const float want = wave_sum(sum) * pool_scale[col];
          chk(DFLAG, 5, bf2f(BIG[(size_t)row * BIGP + 3584 + col]), want, 0.03f); }
    } GSYNC(); }
#endif

#pragma unroll 1
    for (int layer = 0; layer < 2; ++layer) {
        const int pb = 4 + layer * 10;
        if (layer == 1) {
            TSTART(11); if (IN(11)) {
                KARG(); TIDS();
                pg8::GemmX g{XB, W6, M, 5120, 2048, 2048, 2048}; pg8::SchedStd S; S.init(M, 5120, G, bx);
                int pm0_ = -1; { pg8::Unit u0_; if (S.next(0, u0_)) { if (tid < 256) { float sacc = 0.f;
#pragma unroll 8
                    for (int k = 0; k < 32; ++k) sacc += rss2[(size_t)k * 16384 + u0_.pm * 256 + tid];
                    ((LAS float*)(lds + 131072))[tid] = rsqrtf(sacc * (1.0f / 2048.0f) + RMS_EPS); } pm0_ = u0_.pm; } }
                __syncthreads();
                pg8::EpiP6 E{BIG, pg8::RowScale{(LAS const float*)(lds + 131072), pm0_, rss2}, k_norm, q_norm, rope};
                pg8::gemm_phase<pg8::EpiP6, pg8::SchedStd, true, true>(lds, g, S, E);
            }
            SEAM(11); TEND(11);
#ifdef DBGCHK
            { KARG(); TIDS(); if (gw < 64) { const int s_ = gw;
              const int row = hsh(s_, 14) % 16384, hh = hsh(s_, 15) % 12, kind = s_ & 3; const float* xr = out_p + (size_t)row * 2048; const float rs = row_rstd(xr, lane);
              const float* Wp = kind == 2 ? w_in + (size_t)2048 * 2048 : w_kv; const float* gp = kind == 2 ? mix_norm + 2048 : kv_norm; const int ldw = kind == 2 ? 2048 : 3072;
              const int wcol = (kind == 0 ? 0 : kind == 1 ? 768 : kind == 2 ? 768 : 1536) + hh * 64; const int bcol = (kind == 0 ? 0 : kind == 1 ? 768 : kind == 2 ? 3840 : 1536) + hh * 64;
              for (int d = 0; d < 64; ++d) { const float v = row_dot(xr, gp, Wp, ldw, wcol + d, lane) * rs; if (lane == 0) scr[d] = v; }
              LDS_WAIT();
              float y = scr[lane];
              if (kind != 3) { float ss = 0.f; for (int d = 0; d < 64; ++d) ss += scr[d] * scr[d]; const float r = rsqrtf(ss * (1.0f / 64.0f) + RMS_EPS);
                y = y * r * (kind == 2 ? q_norm[lane] * (0.125f * 1.4426950408889634f) : k_norm[lane]); scr[64 + lane] = y; LDS_WAIT();
                if (lane < 16) { const int i = lane & 7; const float c = rope[(size_t)(row & 2047) * 16 + i], sn = rope[(size_t)(row & 2047) * 16 + 8 + i];
                  y = lane < 8 ? scr[64 + lane] * c - scr[64 + lane + 8] * sn : scr[64 + lane - 8] * sn + scr[64 + lane] * c; } }
              chk(DFLAG, 9, bf2f(BIG[(size_t)row * BIGP + bcol + lane]), y, 0.03f);
              LDS_WAIT();
            } GSYNC(); }
#endif

            TSTART(12); if (IN(12)) {
                KARG(); TIDS();
                { const float lam = lamp[0];
                for (int grp = vcu >> 3; grp < 32; grp += (G >> 3)) { const int role = vcu & 7;
#pragma unroll 1
                    for (int k = 0; k < 3; ++k) { const int code = da_tab(role, k), row = 3 * grp + (code >> 3), qb = code & 7, b = row / 12, h = row - b * 12;
                        diffattn_pair(BIG + (size_t)(b * SEQ) * BIGP, h, qb, lam, subln_norm, lds, wid, lane); } } }
                for (int u = vcu; u < 256; u += G) { const int b = u >> 5, h = (u >> 3) & 3, qb = u & 7;
                    memattn_unit(BIG + (size_t)(b * SEQ + qb * 256) * BIGP + 4608 + 128 * h, MKV + (size_t)(b * 256) * 2048 + 1024 + 128 * h, MKV + (size_t)(b * 256) * 2048 + 1536 + 128 * h,
                                 mem_q_norm + 128, mem_k_norm + 128, lds, wid, lane); }
                __syncthreads();
            }
            SEAM(12); TEND(12);
#ifdef DBGCHK
            { KARG(); TIDS(); if (gw < 64) { const int s_ = gw;
              { const int row = hsh(s_, 16) % 16384, hh = hsh(s_, 17) % 12, map = s_ & 1, half = (s_ >> 1) & 1;
                const float o = naive_diff(BIG, row, 3072 + map * 768 + hh * 64, map * 768 + hh * 64, 1536 + hh * 128 + half * 64, scr, lane);
                chk(DFLAG, 10, bf2f(BIG[(size_t)row * BIGP + 5120 + map * 1536 + hh * 128 + half * 64 + lane]), o, 0.03f); }
              if (s_ < 16) { const int row = hsh(s_, 18) % 16384, h = s_ & 3, b = row >> 11;
                chk_memattn(DFLAG, 11, out_p + (size_t)row * 2048, mix_norm + 2048, w_in + (size_t)2048 * 2048, 2048, 1536 + 128 * h, MKV + (size_t)(b * 256) * 2048 + 1024 + 128 * h, MKV + (size_t)(b * 256) * 2048 + 1536 + 128 * h,
                            mem_q_norm + 128, mem_k_norm + 128, BIG + (size_t)row * BIGP + 4608 + 128 * h, scr, lane); }
            } GSYNC(); }
#endif

        }
        TSTART(pb); if (IN(pb)) {
            KARG(); TIDS();
            pg8::GemmX g{BIG + (layer == 0 ? 3072 : 4608), layer == 0 ? WO0 : WO1, M, 2048, 2048, BIGP, 2048}; pg8::SchedStd S; S.init(M, 2048, G, bx, 4);
            pg8::EpiResid E{layer == 0 ? x_in : nullptr, nullptr, XB, layer == 0 ? rss1 : rss3};
            pg8::gemm_phase<pg8::EpiResid, pg8::SchedStd, true, true>(lds, g, S, E);
        }
        SEAM(pb); TEND(pb);
#ifdef DBGCHK
        if (layer == 0) { KARG(); TIDS(); if (gw < 64) { const int s_ = gw;
          const int row = hsh(s_, 10) % 16384, col = hsh(s_, 11) % 2048; float sum = 0.f;
          for (int k = lane; k < 2048; k += 64) sum += bf2f(BIG[(size_t)row * BIGP + (k < 1536 ? 3584 + k : 3072 + k - 1536)]) * w_out[(size_t)k * 2048 + col];
          const float want = x_in[(size_t)row * 2048 + col] + wave_sum(sum);
          chk(DFLAG, 6, out_p[(size_t)row * 2048 + col], want, 0.01f);
          chk(DFLAG, 7, bf2f(XB[(size_t)row * 2048 + col]), out_p[(size_t)row * 2048 + col], 0.01f);
          const float r1 = row_rstd(out_p + (size_t)row * 2048, lane); chk(DFLAG, 7, pg8::rstd2048(rss1, row), r1, 0.001f);
        } GSYNC(); }
#endif

        TSTART(pb + 1); if (IN(pb + 1)) {
            KARG(); TIDS();
            pg8::GemmX g{XB, layer == 0 ? WF1 : (bf16*)out_p, M, 8192, 2048, 2048, 2048}; pg8::SchedStd S; S.init(M, 8192, G, bx);
            const float* rssx_ = layer == 0 ? rss1 : rss3; int pm0_ = -1; { pg8::Unit u0_; if (S.next(0, u0_)) { if (tid < 256) { float sacc = 0.f;
#pragma unroll 8
                    for (int k = 0; k < 32; ++k) sacc += rssx_[(size_t)k * 16384 + u0_.pm * 256 + tid];
                    ((LAS float*)(lds + 131072))[tid] = rsqrtf(sacc * (1.0f / 2048.0f) + RMS_EPS); } pm0_ = u0_.pm; } }
                __syncthreads();
            pg8::EpiRelu2 E{BIG, pg8::RowScale{(LAS const float*)(lds + 131072), pm0_, rssx_}};
            pg8::gemm_phase<pg8::EpiRelu2, pg8::SchedStd, true, true>(lds, g, S, E);
        }
        SEAM(pb + 1); TEND(pb + 1);
#ifdef DBGCHK
        { KARG(); TIDS(); if (gw < 64) { const int s_ = gw;
          const int row = hsh(s_, 12) % 16384, col = hsh(s_, 13) % 8192; const float* xr = out_p + (size_t)row * 2048;
          float v = row_dot(xr, ffn_norm + layer * 2048, w_ff1 + (size_t)layer * 2048 * 8192, 8192, col, lane) * row_rstd(xr, lane); v = fmaxf(v, 0.f); v *= v;
          chk(DFLAG, layer == 0 ? 8 : 15, bf2f(BIG[(size_t)row * BIGP + col]), v, 0.03f);
        } GSYNC(); }
#endif

        TSTART(pb + 2); if (IN(pb + 2)) {
            KARG(); TIDS();
            pg8::GemmX g{BIG, layer == 0 ? WF2 : WF2B, M, 2048, 8192, BIGP, WF2P}; pg8::SchedStd S; S.init(M, 2048, G, bx, 4);
            pg8::EpiResid E{nullptr, layer == 0 ? nullptr : out_p, XB, layer == 0 ? rss2 : nullptr};
            pg8::gemm_phase<pg8::EpiResid, pg8::SchedStd, true, true>(lds, g, S, E);
        }
        if (layer == 0) { if (IN(6) && IN(11)) GSYNC(); TEND(6); }
    }
#ifdef TPHASE
    { GSYNC(); if (TPHASE == 16) tst1 = __builtin_amdgcn_s_memrealtime(); KARG(); if (blockIdx.x == 0 && threadIdx.x == 0) out_p[0] = (float)((((tst1 - tst0) / 100ull + 10ull) / 20ull) * 20ull); }
#endif
#ifdef DBGCHK
    { GSYNC(); KARG(); if (blockIdx.x == 0 && threadIdx.x == 0) { const unsigned f = DFLAG[0]; if (f != 0xffffffffu) out_p[0] = 100.0f * (float)f; } }
#endif
#undef IN
#undef SEAM
#undef rope
#undef lamp
}

extern "C" void kernel_launch(void* const* d_in, const int* in_sizes, int n_in, void* d_out, int out_size, void* d_ws, size_t ws_size, hipStream_t stream) {
    static int grid = 0;
    if (grid == 0) {
        if (n_in != 20 || out_size != M * DM || ws_size < WS_END) { fprintf(stderr, "kernel_launch: unexpected shapes (n_in %d out %d ws %zu)\n", n_in, out_size, ws_size); grid = -1; return; }
        int dev = 0, cus = 0, per_cu = 0;
        (void)hipGetDevice(&dev); (void)hipDeviceGetAttribute(&cus, hipDeviceAttributeMultiprocessorCount, dev);
        if (hipFuncSetAttribute((const void*)mega_fwd, hipFuncAttributeMaxDynamicSharedMemorySize, LDS_BYTES) != hipSuccess) { fprintf(stderr, "kernel_launch: hipFuncSetAttribute failed\n"); grid = -1; return; }
        (void)hipOccupancyMaxActiveBlocksPerMultiprocessor(&per_cu, (const void*)mega_fwd, NTHREADS, LDS_BYTES);
        (void)hipGetLastError();
        if (per_cu < 1) { fprintf(stderr, "kernel_launch: occupancy query says %d blocks per CU\n", per_cu); per_cu = 1; }
        grid = cus * 1;
        fprintf(stderr, "kernel_launch: grid %d (cus %d, per_cu %d), ws %zu\n", grid, cus, per_cu, ws_size);
    }
    if (grid < 0) return;
    if (hipMemsetAsync((char*)d_ws + WS_BAR, 0, 16384, stream) != hipSuccess) { fprintf(stderr, "kernel_launch: memset failed\n"); return; }
    Args a{};
    for (int i = 0; i < 20; ++i) a.in[i] = (const float*)d_in[i];
    a.out = (float*)d_out; a.ws = (unsigned char*)d_ws; a.ph_lo = 0; a.ph_hi = 100;
    void* kargs[] = {&a};
    hipError_t e = hipLaunchCooperativeKernel((const void*)mega_fwd, dim3(grid), dim3(NTHREADS), kargs, LDS_BYTES, stream);
    if (e != hipSuccess) fprintf(stderr, "kernel_launch: cooperative launch failed: %s (grid %d)\n", hipGetErrorString(e), grid);
}
```

```cpp
#include <hip/hip_runtime.h>
#include <hip/hip_cooperative_groups.h>
#include <cstdio>
#include <cstdint>
namespace cg = cooperative_groups;
namespace pg8 {
#define PG8_LAS __attribute__((address_space(3)))
typedef unsigned short bf16_t;
typedef short bf16x8 __attribute__((ext_vector_type(8)));
typedef float f32x4 __attribute__((ext_vector_type(4)));
typedef unsigned u32x4 __attribute__((ext_vector_type(4)));
constexpr int BM = 256, BK = 64, HALF = 128, HTB = HALF * BK * 2  , STAGE_BYTES = 8 * HTB, NXCD = 8, WGM = 8;

__host__ __device__ __forceinline__ int lds_byte(int r, int c) { const int st = (r >> 4) * 2 + (c >> 5), rr = r & 15, cc = c & 31, ob = rr * 64 + cc * 2; return st * 1024 + (ob ^ (((ob >> 9) & 1) << 5)); }
__host__ __device__ __forceinline__ void stage_rc(int b, int& R, int& C) { const int st = b / 1024, sb = b % 1024, swz = sb ^ (((sb >> 9) & 1) << 5); R = (st >> 1) * 16 + swz / 64; C = (st & 1) * 32 + (swz % 64) / 2; }
__host__ __device__ __forceinline__ int perm32(int rho) { const int n = rho >> 4, i = rho & 15; return 8 * (i >> 2) + 4 * n + (i & 3); }

struct Unit { int pm, pn; };
struct Gemm { const bf16_t* A; const bf16_t* Bt; int M, N, K; };

struct StaticOrder {
    int nM, nN, nwg, G, c, wgm;
    __host__ __device__ void init(int M, int N, int G_, int c_, int wgm_ = WGM) { nM = M / BM; nN = N / BM; nwg = nM * nN; G = G_; c = c_; wgm = wgm_; }
    __host__ __device__ bool next(int i, Unit& u) const {
        const long L = (long)i * G + c; if (L >= nwg) return false;
        int wgid = (int)L; { const int q = nwg / NXCD, r = nwg % NXCD, xcd = wgid % NXCD, off = wgid / NXCD; wgid = (xcd < r ? xcd * (q + 1) : r * (q + 1) + (xcd - r) * q) + off; }
        const int nig = wgm * nN, gid = wgid / nig, fm = gid * wgm, gsz = (nM - fm) < wgm ? (nM - fm) : wgm;
        u.pm = fm + ((wgid % nig) % gsz); u.pn = (wgid % nig) / gsz; return true;
    }
    __device__ __forceinline__ void a_ready(const Unit&) const {}
    __device__ __forceinline__ void done(const Unit&) const {}
};

__device__ __forceinline__ unsigned cvt_pk_bf16(float lo, float hi) { unsigned r; asm volatile("v_cvt_pk_bf16_f32 %0, %1, %2" : "=v"(r) : "v"(lo), "v"(hi)); return r; }
typedef float f32x2 __attribute__((ext_vector_type(2)));
struct GemmX { const bf16_t* A; const bf16_t* Bt; int M, N, K, lda, ldb; };
struct SchedStd : StaticOrder {
    __device__ __forceinline__ const char* a_ptr(const GemmX& g, const Unit& u) const { return (const char*)g.A + (size_t)u.pm * BM * g.lda * 2; }
    __device__ __forceinline__ const char* b_ptr(const GemmX& g, const Unit& u) const { return (const char*)g.Bt + (size_t)u.pn * BM * g.ldb * 2; }
};
struct SchedMem {
    int c;
    __device__ void init(int c_) { c = c_; }
    __device__ bool next(int i, Unit& u) const { if (i > 0 || c >= 64) return false; u.pm = 64 + (c >> 3); u.pn = 8 + (c & 7); return true; }
    __device__ __forceinline__ void a_ready(const Unit&) const {}
    __device__ __forceinline__ void done(const Unit&) const {}
    __device__ __forceinline__ const char* a_ptr(const GemmX& g, const Unit& u) const { return (const char*)g.A + (size_t)u.pm * BM * g.lda * 2; }
    __device__ __forceinline__ const char* b_ptr(const GemmX& g, const Unit& u) const { return (const char*)g.Bt + (size_t)u.pn * BM * g.ldb * 2; }
};
struct SchedPool {
    int G, c;
    __device__ void init(int G_, int c_) { G = G_; c = c_; }
    __device__ bool next(int i, Unit& u) const {
        const int L = i * G + c; if (L >= 512) return false;
        u.pm = (L >> 1) & 63; u.pn = ((L >> 7) << 1) | (L & 1); return true;
    }
    __device__ __forceinline__ void a_ready(const Unit&) const {}
    __device__ __forceinline__ void done(const Unit&) const {}
    __device__ __forceinline__ const char* a_ptr(const GemmX& g, const Unit& u) const { return (const char*)g.A + ((size_t)u.pm * BM * g.lda + (size_t)(u.pn >> 1) * 384) * 2; }
    __device__ __forceinline__ const char* b_ptr(const GemmX& g, const Unit& u) const { return (const char*)g.Bt + (size_t)u.pn * BM * g.ldb * 2; }
};

typedef unsigned u32x2 __attribute__((ext_vector_type(2)));
constexpr float RMS_EPS = 1e-6f;
constexpr int BIGP_ = 8256;
__device__ __forceinline__ float rstd2048(const float* rss, int row) { return rsqrtf(rss[row] * (1.0f / 2048.0f) + RMS_EPS); }
struct RowScale {
    PG8_LAS const float* tab; int pm0; const float* part;
    __device__ __forceinline__ float get(int pm, int rloc) const { return tab[rloc]; }
};

struct EpiP1 {
    static constexpr bool PERM = true, AFTER_DRAIN = false;
    bf16_t* big; bf16_t* mkv; const float* rss;
    __device__ __forceinline__ void operator()(const f32x4 (&acc)[2][2][4][2], const Unit& u, int wr, int wc, int fr, int fq) const {
        const int row0 = u.pm * BM + wr * 64 + fr;
        bf16_t* base; size_t ld;
        if (u.pm < 64) { ld = BIGP_; base = big + (u.pn < 6 ? u.pn * 256 : 3072 + (u.pn - 6) * 256); }
        else { ld = 2048; base = mkv - (size_t)16384 * 2048 + (u.pn - 8) * 256; }
        base += wc * 32 + 8 * fq;
#pragma unroll
        for (int ai = 0; ai < 2; ++ai)
#pragma unroll
            for (int m = 0; m < 4; ++m) { const int row = row0 + ai * HALF + m * 16; const float sc = rstd2048(rss, row); bf16_t* rowp = base + (size_t)row * ld;
#pragma unroll
                for (int bj = 0; bj < 2; ++bj) { const f32x4 v0 = acc[ai][bj][m][0] * sc, v1 = acc[ai][bj][m][1] * sc;
                    u32x4 w; w.x = cvt_pk_bf16(v0[0], v0[1]); w.y = cvt_pk_bf16(v0[2], v0[3]); w.z = cvt_pk_bf16(v1[0], v1[1]); w.w = cvt_pk_bf16(v1[2], v1[3]);
                    *(u32x4*)(rowp + bj * HALF) = w; } }
    }
};
struct EpiPool {
    static constexpr bool PERM = true, AFTER_DRAIN = false;
    bf16_t* big;
    __device__ __forceinline__ void operator()(const f32x4 (&acc)[2][2][4][2], const Unit& u, int wr, int wc, int fr, int fq) const {
        const int row0 = u.pm * BM + wr * 64 + fr; const int g = u.pn >> 1, half = u.pn & 1;
        bf16_t* base = big + 3584 + g * 384 + half * 256 + wc * 32 + 8 * fq;
#pragma unroll
        for (int ai = 0; ai < 2; ++ai)
#pragma unroll
            for (int m = 0; m < 4; ++m) { bf16_t* rowp = base + (size_t)(row0 + ai * HALF + m * 16) * BIGP_;
#pragma unroll
                for (int bj = 0; bj < 2; ++bj) { if (bj == 1 && half == 1) continue;
                    const f32x4 v0 = acc[ai][bj][m][0], v1 = acc[ai][bj][m][1];
                    u32x4 w; w.x = cvt_pk_bf16(v0[0], v0[1]); w.y = cvt_pk_bf16(v0[2], v0[3]); w.z = cvt_pk_bf16(v1[0], v1[1]); w.w = cvt_pk_bf16(v1[2], v1[3]);
                    *(u32x4*)(rowp + bj * HALF) = w; } }
    }
};
struct EpiRelu2 {
    static constexpr bool PERM = true, AFTER_DRAIN = false;
    bf16_t* big; RowScale rs;
    __device__ __forceinline__ void operator()(const f32x4 (&acc)[2][2][4][2], const Unit& u, int wr, int wc, int fr, int fq) const {
        const int row0 = u.pm * BM + wr * 64 + fr;
        bf16_t* base = big + u.pn * BM + wc * 32 + 8 * fq;
#pragma unroll
        for (int ai = 0; ai < 2; ++ai)
#pragma unroll
            for (int m = 0; m < 4; ++m) { const int row = row0 + ai * HALF + m * 16; const float sc = rs.get(u.pm, wr * 64 + fr + ai * HALF + m * 16); bf16_t* rowp = base + (size_t)row * BIGP_;
#pragma unroll
                for (int bj = 0; bj < 2; ++bj) { f32x4 v0 = acc[ai][bj][m][0] * sc, v1 = acc[ai][bj][m][1] * sc;
#pragma unroll
                    for (int e = 0; e < 4; ++e) { v0[e] = fmaxf(v0[e], 0.f); v0[e] *= v0[e]; v1[e] = fmaxf(v1[e], 0.f); v1[e] *= v1[e]; }
                    u32x4 w; w.x = cvt_pk_bf16(v0[0], v0[1]); w.y = cvt_pk_bf16(v0[2], v0[3]); w.z = cvt_pk_bf16(v1[0], v1[1]); w.w = cvt_pk_bf16(v1[2], v1[3]);
                    *(u32x4*)(rowp + bj * HALF) = w; } }
    }
};
struct EpiResid {
    static constexpr bool PERM = true, AFTER_DRAIN = false;
    const float* base_f32; float* out_f32; bf16_t* xb; float* rss_out;
    __device__ __forceinline__ void finish(const f32x4& o0, const f32x4& o1, size_t off, float& ss) const {
        if (out_f32) { *(f32x4*)(out_f32 + off) = o0; *(f32x4*)(out_f32 + off + 4) = o1; }
        else { u32x4 w; w.x = cvt_pk_bf16(o0[0], o0[1]); w.y = cvt_pk_bf16(o0[2], o0[3]); w.z = cvt_pk_bf16(o1[0], o1[1]); w.w = cvt_pk_bf16(o1[2], o1[3]); *(u32x4*)(xb + off) = w; }
        ss += ((o0[0] * o0[0] + o0[1] * o0[1]) + (o0[2] * o0[2] + o0[3] * o0[3])) + ((o1[0] * o1[0] + o1[1] * o1[1]) + (o1[2] * o1[2] + o1[3] * o1[3]));
    }
    __device__ __forceinline__ void operator()(const f32x4 (&acc)[2][2][4][2], const Unit& u, int wr, int wc, int fr, int fq) const {
        const int row0 = u.pm * BM + wr * 64 + fr; const int col0 = u.pn * BM + wc * 32 + 8 * fq;
        if (base_f32) {
#pragma unroll
            for (int ai = 0; ai < 2; ++ai) {
                f32x4 bs[4][2][2];
#pragma unroll
                for (int m = 0; m < 4; ++m)
#pragma unroll
                    for (int bj = 0; bj < 2; ++bj)
#pragma unroll
                        for (int n = 0; n < 2; ++n) bs[m][bj][n] = *(const f32x4*)(base_f32 + (size_t)(row0 + ai * HALF + m * 16) * 2048 + col0 + bj * HALF + n * 4);
#pragma unroll
                for (int m = 0; m < 4; ++m) { const int row = row0 + ai * HALF + m * 16; const size_t off = (size_t)row * 2048 + col0; float ss = 0.f;
#pragma unroll
                    for (int bj = 0; bj < 2; ++bj) finish(bs[m][bj][0] + acc[ai][bj][m][0], bs[m][bj][1] + acc[ai][bj][m][1], off + bj * HALF, ss);
                    if (rss_out) { ss += __shfl_xor(ss, 16); ss += __shfl_xor(ss, 32); if (fq == 0) rss_out[(size_t)(u.pn * 4 + wc) * 16384 + row] = ss; } }
                asm volatile("" ::: "memory");
            }
        } else {
            u32x4 bs[2][4][2];
#pragma unroll
            for (int ai = 0; ai < 2; ++ai)
#pragma unroll
                for (int m = 0; m < 4; ++m)
#pragma unroll
                    for (int bj = 0; bj < 2; ++bj) bs[ai][m][bj] = *(const u32x4*)(xb + (size_t)(row0 + ai * HALF + m * 16) * 2048 + col0 + bj * HALF);
#pragma unroll
            for (int ai = 0; ai < 2; ++ai)
#pragma unroll
                for (int m = 0; m < 4; ++m) { const int row = row0 + ai * HALF + m * 16; const size_t off = (size_t)row * 2048 + col0; float ss = 0.f;
#pragma unroll
                    for (int bj = 0; bj < 2; ++bj) { const u32x4 b = bs[ai][m][bj]; f32x4 o0, o1;
                        o0[0] = __builtin_bit_cast(float, b.x << 16) + acc[ai][bj][m][0][0]; o0[1] = __builtin_bit_cast(float, b.x & 0xffff0000u) + acc[ai][bj][m][0][1];
                        o0[2] = __builtin_bit_cast(float, b.y << 16) + acc[ai][bj][m][0][2]; o0[3] = __builtin_bit_cast(float, b.y & 0xffff0000u) + acc[ai][bj][m][0][3];
                        o1[0] = __builtin_bit_cast(float, b.z << 16) + acc[ai][bj][m][1][0]; o1[1] = __builtin_bit_cast(float, b.z & 0xffff0000u) + acc[ai][bj][m][1][1];
                        o1[2] = __builtin_bit_cast(float, b.w << 16) + acc[ai][bj][m][1][2]; o1[3] = __builtin_bit_cast(float, b.w & 0xffff0000u) + acc[ai][bj][m][1][3];
                        finish(o0, o1, off + bj * HALF, ss); }
                    if (rss_out) { ss += __shfl_xor(ss, 16); ss += __shfl_xor(ss, 32); if (fq == 0) rss_out[(size_t)(u.pn * 4 + wc) * 16384 + row] = ss; } }
        }
    }
};
struct EpiP6 {
    static constexpr bool PERM = true, AFTER_DRAIN = false;
    bf16_t* big; RowScale rs; const float* kgain; const float* qgain; const float* rope;
    __device__ __forceinline__ void operator()(const f32x4 (&acc)[2][2][4][2], const Unit& u, int wr, int wc, int fr, int fq) const {
        const int row0 = u.pm * BM + wr * 64 + fr; const int pn = u.pn;
        const int kind = (pn < 6) ? 1 : (pn >= 12 && pn < 18) ? 2 : 0;
        bf16_t* basep = big + pn * BM + wc * 64 + 8 * fq;
        if (kind == 0) {
#pragma unroll
            for (int ai = 0; ai < 2; ++ai)
#pragma unroll
                for (int m = 0; m < 4; ++m) { const int row = row0 + ai * HALF + m * 16; const float sc = rs.get(u.pm, wr * 64 + fr + ai * HALF + m * 16); bf16_t* rowp = basep + (size_t)row * BIGP_;
#pragma unroll
                    for (int bj = 0; bj < 2; ++bj) { const f32x4 v0 = acc[ai][bj][m][0] * sc, v1 = acc[ai][bj][m][1] * sc;
                        u32x4 w; w.x = cvt_pk_bf16(v0[0], v0[1]); w.y = cvt_pk_bf16(v0[2], v0[3]); w.z = cvt_pk_bf16(v1[0], v1[1]); w.w = cvt_pk_bf16(v1[2], v1[3]); *(u32x4*)(rowp + bj * 32) = w; } }
        } else {
            const float* gp = (kind == 1 ? kgain : qgain) + 8 * fq; const float osc = (kind == 2) ? (0.125f * 1.4426950408889634f) : 1.0f;
            f32x4 gv[2][2];
#pragma unroll
            for (int bj = 0; bj < 2; ++bj)
#pragma unroll
                for (int n = 0; n < 2; ++n) gv[bj][n] = *(const f32x4*)(gp + bj * 32 + n * 4) * osc;
            const float sg = (fq == 0) ? -1.0f : 1.0f;
#pragma unroll
            for (int ai = 0; ai < 2; ++ai)
#pragma unroll
                for (int m = 0; m < 4; ++m) { const int row = row0 + ai * HALF + m * 16; const float sc = rs.get(u.pm, wr * 64 + fr + ai * HALF + m * 16); bf16_t* rowp = basep + (size_t)row * BIGP_;
                    f32x4 v[2][2]; float ss = 0.f;
#pragma unroll
                    for (int bj = 0; bj < 2; ++bj)
#pragma unroll
                        for (int n = 0; n < 2; ++n) { v[bj][n] = acc[ai][bj][m][n] * sc; const f32x4 x = v[bj][n]; ss += (x[0] * x[0] + x[1] * x[1]) + (x[2] * x[2] + x[3] * x[3]); }
                    ss += __shfl_xor(ss, 16); ss += __shfl_xor(ss, 32);
                    const float r = rsqrtf(ss * (1.0f / 64.0f) + RMS_EPS);
#pragma unroll
                    for (int bj = 0; bj < 2; ++bj)
#pragma unroll
                        for (int n = 0; n < 2; ++n) v[bj][n] = v[bj][n] * r * gv[bj][n];
                    {
                        const float* rp = rope + (size_t)(row & 2047) * 16;
#pragma unroll
                        for (int n = 0; n < 2; ++n) { const f32x4 cs = *(const f32x4*)(rp + 4 * n), sn = *(const f32x4*)(rp + 8 + 4 * n);
                            const f32x4 y = v[0][n]; f32x4 oth;
#pragma unroll
                            for (int e = 0; e < 4; ++e) oth[e] = __shfl_xor(y[e], 16);
                            const f32x4 res = y * cs + oth * (sn * sg);
                            if (fq < 2) v[0][n] = res; }
                    }
#pragma unroll
                    for (int bj = 0; bj < 2; ++bj) { const f32x4 v0 = v[bj][0], v1 = v[bj][1];
                        u32x4 w; w.x = cvt_pk_bf16(v0[0], v0[1]); w.y = cvt_pk_bf16(v0[2], v0[3]); w.z = cvt_pk_bf16(v1[0], v1[1]); w.w = cvt_pk_bf16(v1[2], v1[3]); *(u32x4*)(rowp + bj * 32) = w; } }
        }
    }
};
template <class Epi, class Sched, bool ALIGN_EPI = false, bool SP2 = false>
__device__ __forceinline__ void gemm_phase(PG8_LAS unsigned char* lds, const GemmX g, const Sched& S, const Epi& E) {
    int tid_ = threadIdx.x; asm volatile("" : "+v"(tid_));
    const int tid = tid_, wid = __builtin_amdgcn_readfirstlane(tid >> 6), lane = tid & 63, wr = wid >> 2, wc = wid & 3, fr = lane & 15, fq = lane >> 4;
    const int K = g.K, nt = K / BK;
    unsigned voffA[2], voffB[2];
#pragma unroll
    for (int i = 0; i < 2; ++i) { int R, C; stage_rc(tid * 16 + i * 8192, R, C); const int Rb = Epi::PERM ? ((R & ~31) + perm32(R & 31)) : R;
        voffA[i] = (unsigned)(R * g.lda + C) * 2u; voffB[i] = (unsigned)(Rb * g.ldb + C) * 2u; }
    const size_t kstep = (size_t)(BK * 2);
    const size_t hsA = (size_t)HALF * g.lda * 2, hsB = (size_t)HALF * g.ldb * 2;
    const unsigned ldsw = (unsigned)wid * 1024u;
    const int aoff = lds_byte(wr * 64 + fr, fq * 8), boff = lds_byte(wc * 32 + fr, fq * 8);
#define PG8_SA(b, h) (((b) * 2 + (h)) * HTB)
#define PG8_SB(b, h) ((4 + (b) * 2 + (h)) * HTB)
#define PG8_STAGE(bufoff, gbase, voff) do { _Pragma("unroll") for (int _i = 0; _i < 2; ++_i) \
        __builtin_amdgcn_global_load_lds((const unsigned*)((const char*)(gbase) + (voff)[_i]), (PG8_LAS unsigned*)(lds + (bufoff) + ldsw + _i * 8192), 16, 0, 0); } while (0)
#define PG8_LDA(dst, b, h) do { _Pragma("unroll") for (int m = 0; m < 4; ++m) _Pragma("unroll") for (int k = 0; k < 2; ++k) dst[m][k] = *(const PG8_LAS bf16x8*)(lds + PG8_SA(b, h) + aoff + m * 2048 + k * 1024); } while (0)
#define PG8_LDB(dst, b, h) do { _Pragma("unroll") for (int n = 0; n < 2; ++n) _Pragma("unroll") for (int k = 0; k < 2; ++k) dst[n][k] = *(const PG8_LAS bf16x8*)(lds + PG8_SB(b, h) + boff + n * 2048 + k * 1024); } while (0)
#define PG8_MMA(ai, bj, At, Bt) do { __builtin_amdgcn_s_setprio(1); _Pragma("unroll") for (int m = 0; m < 4; ++m) _Pragma("unroll") for (int n = 0; n < 2; ++n) _Pragma("unroll") for (int k = 0; k < 2; ++k) \
        acc[ai][bj][m][n] = __builtin_amdgcn_mfma_f32_16x16x32_bf16(Bt[n][k], At[m][k], acc[ai][bj][m][n], 0, 0, 0); __builtin_amdgcn_s_setprio(0); } while (0)
#define PG8_WAIT_V(n) asm volatile("s_waitcnt vmcnt(" #n ")" ::: "memory")
#define PG8_WAIT_L(n) asm volatile("s_waitcnt lgkmcnt(" #n ")" ::: "memory")
#define PG8_BAR __builtin_amdgcn_s_barrier()
#define PG8_SCHED __builtin_amdgcn_sched_barrier(0)
    Unit cur, nxt; int ui = 0;
    if (!S.next(0, cur)) return;
    f32x4 acc[2][2][4][2];
#pragma unroll
    for (int a = 0; a < 2; ++a)
#pragma unroll
        for (int b = 0; b < 2; ++b)
#pragma unroll
            for (int m = 0; m < 4; ++m)
#pragma unroll
                for (int n = 0; n < 2; ++n) acc[a][b][m][n] = (f32x4){0.f, 0.f, 0.f, 0.f};
    bf16x8 At[4][2], B0[2][2], B1[2][2];
    const char* cA = S.a_ptr(g, cur); const char* cB = S.b_ptr(g, cur);
    S.a_ready(cur);
    if constexpr (SP2) {
        PG8_STAGE(PG8_SB(0, 0), cB, voffB); PG8_STAGE(PG8_SB(0, 1), cB + hsB, voffB); PG8_STAGE(PG8_SA(0, 0), cA, voffA); PG8_STAGE(PG8_SA(0, 1), cA + hsA, voffA);
        if (wr == 1) PG8_BAR;
        PG8_WAIT_V(2); PG8_BAR;
        PG8_STAGE(PG8_SB(1, 0), cB + kstep, voffB); PG8_STAGE(PG8_SA(1, 0), cA + kstep, voffA); PG8_STAGE(PG8_SB(1, 1), cB + hsB + kstep, voffB);
        PG8_WAIT_V(6); PG8_BAR;
    } else {
        PG8_STAGE(PG8_SB(0, 0), cB, voffB); PG8_STAGE(PG8_SA(0, 0), cA, voffA); PG8_STAGE(PG8_SB(0, 1), cB + hsB, voffB); PG8_STAGE(PG8_SA(0, 1), cA + hsA, voffA);
        if (wr == 1) PG8_BAR;
        PG8_WAIT_V(4); PG8_BAR;
        PG8_STAGE(PG8_SB(1, 0), cB + kstep, voffB); PG8_STAGE(PG8_SA(1, 0), cA + kstep, voffA); PG8_STAGE(PG8_SB(1, 1), cB + hsB + kstep, voffB);
        PG8_WAIT_V(6); PG8_BAR;
    }
    for (;;) {
        const bool has_next = S.next(ui + 1, nxt);
        const char* nA = has_next ? S.a_ptr(g, nxt) : cA; const char* nB = has_next ? S.b_ptr(g, nxt) : cB;
        for (int t = 0; t < nt; t += 2) {
            const bool last = (t == nt - 2);
            const char* a1 = cA + (size_t)(t + 1) * kstep;
            const char* a2 = last ? nA : cA + (size_t)(t + 2) * kstep; const char* b2 = last ? nB : cB + (size_t)(t + 2) * kstep;
            const char* a3 = a2 + kstep; const char* b3 = b2 + kstep;
            if (last && has_next) S.a_ready(nxt);
            if constexpr (SP2) {
            PG8_LDB(B0, 0, 0); PG8_LDB(B1, 0, 1); PG8_SCHED; PG8_LDA(At, 0, 0); PG8_STAGE(PG8_SA(1, 1), a1 + hsA, voffA);
            PG8_WAIT_V(8); PG8_WAIT_L(0); PG8_BAR; PG8_MMA(0, 0, At, B0); PG8_MMA(0, 1, At, B1); PG8_BAR; PG8_SCHED;
            PG8_LDA(At, 0, 1); PG8_STAGE(PG8_SB(0, 0), b2, voffB); PG8_STAGE(PG8_SB(0, 1), b2 + hsB, voffB); PG8_STAGE(PG8_SA(0, 0), a2, voffA);
            PG8_WAIT_V(8); PG8_WAIT_L(0); PG8_BAR; PG8_MMA(1, 0, At, B0); PG8_MMA(1, 1, At, B1); PG8_BAR; PG8_SCHED;
            PG8_LDB(B0, 1, 0); PG8_LDB(B1, 1, 1); PG8_SCHED; PG8_LDA(At, 1, 0); PG8_STAGE(PG8_SA(0, 1), a2 + hsA, voffA);
            PG8_WAIT_V(8); PG8_WAIT_L(0); PG8_BAR; PG8_MMA(0, 0, At, B0); PG8_MMA(0, 1, At, B1); PG8_BAR; PG8_SCHED;
            PG8_LDA(At, 1, 1); PG8_STAGE(PG8_SB(1, 0), b3, voffB); PG8_STAGE(PG8_SB(1, 1), b3 + hsB, voffB); PG8_STAGE(PG8_SA(1, 0), a3, voffA);
            PG8_WAIT_V(8); PG8_WAIT_L(0); PG8_BAR; PG8_MMA(1, 0, At, B0); PG8_MMA(1, 1, At, B1); PG8_BAR; PG8_SCHED;
            } else {
            PG8_LDB(B0, 0, 0); PG8_SCHED; PG8_LDA(At, 0, 0); PG8_STAGE(PG8_SA(1, 1), a1 + hsA, voffA);
            PG8_WAIT_L(8); PG8_BAR; PG8_WAIT_L(0); PG8_MMA(0, 0, At, B0); PG8_BAR; PG8_SCHED;
            PG8_LDB(B1, 0, 1); PG8_STAGE(PG8_SB(0, 0), b2, voffB);
            PG8_BAR; PG8_WAIT_L(0); PG8_MMA(0, 1, At, B1); PG8_BAR;
            PG8_LDA(At, 0, 1); PG8_STAGE(PG8_SA(0, 0), a2, voffA);
            PG8_BAR; PG8_WAIT_L(0); PG8_MMA(1, 0, At, B0); PG8_BAR; PG8_SCHED;
            PG8_STAGE(PG8_SB(0, 1), b2 + hsB, voffB);
            PG8_WAIT_V(6); PG8_BAR; PG8_MMA(1, 1, At, B1); PG8_BAR;
            PG8_LDB(B0, 1, 0); PG8_SCHED; PG8_LDA(At, 1, 0); PG8_STAGE(PG8_SA(0, 1), a2 + hsA, voffA);
            PG8_WAIT_L(8); PG8_BAR; PG8_WAIT_L(0); PG8_MMA(0, 0, At, B0); PG8_BAR; PG8_SCHED;
            PG8_LDB(B1, 1, 1); PG8_STAGE(PG8_SB(1, 0), b3, voffB);
            PG8_BAR; PG8_WAIT_L(0); PG8_MMA(0, 1, At, B1); PG8_BAR;
            PG8_LDA(At, 1, 1); PG8_STAGE(PG8_SA(1, 0), a3, voffA);
            PG8_BAR; PG8_WAIT_L(0); PG8_MMA(1, 0, At, B0); PG8_BAR; PG8_SCHED;
            PG8_STAGE(PG8_SB(1, 1), b3 + hsB, voffB);
            PG8_WAIT_V(6); PG8_BAR; PG8_MMA(1, 1, At, B1); PG8_BAR;
            }
        }
        if constexpr (ALIGN_EPI) { if (wr == 0) PG8_BAR; }
        if constexpr (!Epi::AFTER_DRAIN) { E(acc, cur, wr, wc, fr, fq); S.done(cur); }
        if (!has_next) break;
#pragma unroll
        for (int a = 0; a < 2; ++a)
#pragma unroll
            for (int b = 0; b < 2; ++b)
#pragma unroll
                for (int m = 0; m < 4; ++m)
#pragma unroll
                    for (int n = 0; n < 2; ++n) acc[a][b][m][n] = (f32x4){0.f, 0.f, 0.f, 0.f};
        cur = nxt; cA = nA; cB = nB; ++ui;
        if constexpr (ALIGN_EPI) { if (wr == 1) PG8_BAR; }
    }
    PG8_WAIT_V(0);
    if constexpr (!ALIGN_EPI) { if (wr == 0) PG8_BAR; }
    PG8_BAR;
    if constexpr (Epi::AFTER_DRAIN) { E.fused(acc, cur, wr, wc, fr, fq, lds, wid, lane); S.done(cur); }
#undef PG8_SA
#undef PG8_SB
#undef PG8_STAGE
#undef PG8_LDA
#undef PG8_LDB
#undef PG8_MMA
#undef PG8_WAIT_V
#undef PG8_WAIT_L
#undef PG8_BAR
#undef PG8_SCHED
}
}

#include <hip/hip_bf16.h>
#include <cmath>
namespace attn_body {
using bf16=__hip_bfloat16;
using bf16x8=__attribute__((ext_vector_type(8)))short;
using s16x4=__attribute__((ext_vector_type(4)))short;
using f32x16=__attribute__((ext_vector_type(16)))float;
using u32x4=__attribute__((ext_vector_type(4)))unsigned;
constexpr int BATCH=8,SEQ=2048,D=64,DM=8256;
constexpr int NW=8,QBLK=32,QB=QBLK*NW,KVBLK=64,NQB=SEQ/QB;
constexpr int ATTN_PITCH=DM, ATTN_UNIT_ROWS=QB;
__device__ __forceinline__ int crow(int r,int hi){return (r&3)+8*(r>>2)+4*hi;}
#define SBAR() __builtin_amdgcn_sched_barrier(0)
__device__ __forceinline__ void cmask(f32x16&p0,f32x16&p1,int jb,int qrel,int hi){
  const float NEG=-INFINITY; int kb=64*jb+4*hi;
  #pragma unroll
  for(int r=0;r<16;++r){int kv=kb+(r&3)+8*(r>>2); if(kv>qrel)p0[r]=NEG; if(kv+32>qrel)p1[r]=NEG;}
}

constexpr int NSLOT=3, SLOTB=8192;
constexpr int LDS_K=0, LDS_V=NSLOT*SLOTB, LDS_WS=2*NSLOT*SLOTB, LDS_OST=LDS_WS+NW*64*4, LDS_BYTES=LDS_OST+NW*4096;
constexpr float C2=0.125f*1.4426950408889634f;
__device__ __forceinline__ void glds16(const void*gsrc,unsigned lds_dst){unsigned keep;
  asm volatile("s_mov_b32 %0, m0\n\ts_mov_b32 m0, %2\n\ts_nop 0\n\tglobal_load_lds_dwordx4 %1, off\n\ts_mov_b32 m0, %0":"=&s"(keep):"v"(gsrc),"s"(lds_dst):"memory");}
__device__ __forceinline__ float max3f(float a,float b,float c){float r;asm("v_max3_f32 %0, %1, %2, %3":"=v"(r):"v"(a),"v"(b),"v"(c));return r;}
__device__ __forceinline__ float max2f(float a,float b){float r;asm("v_max_f32_e32 %0, %1, %2":"=v"(r):"v"(a),"v"(b));return r;}
__device__ __forceinline__ float fadd_s(float a,float b){float r;asm("v_add_f32_e32 %0, %1, %2":"=v"(r):"v"(a),"v"(b));return r;}
__device__ __forceinline__ float fsub_s(float a,float b){float r;asm("v_sub_f32_e32 %0, %1, %2":"=v"(r):"v"(a),"v"(b));return r;}
typedef float f32x2_t __attribute__((ext_vector_type(2))); typedef __bf16 bf16x2_t __attribute__((ext_vector_type(2)));
__device__ __forceinline__ unsigned cvtpk_s(float lo,float hi){f32x2_t v={lo,hi};bf16x2_t b=__builtin_convertvector(v,bf16x2_t);return __builtin_bit_cast(unsigned,b);}
#define WAIT_BAR(N) asm volatile("s_waitcnt vmcnt(" #N ") lgkmcnt(0)\n\ts_barrier":::"memory")

__device__ __forceinline__ void qkt(f32x16&p0,f32x16&p1,const char*Kslot,const bf16x8*qr,const f32x16&negm,int r32,int hi){
  const char*kb=Kslot+hi*1024+r32*16;
  #pragma unroll
  for(int d0=0;d0<4;++d0){
    const bf16x8 b0=*reinterpret_cast<const bf16x8*>(kb+d0*2048);
    const bf16x8 b1=*reinterpret_cast<const bf16x8*>(kb+d0*2048+512);
    if(d0==0){p0=__builtin_amdgcn_mfma_f32_32x32x16_bf16(b0,qr[0],negm,0,0,0);p1=__builtin_amdgcn_mfma_f32_32x32x16_bf16(b1,qr[0],negm,0,0,0);}
    else{p0=__builtin_amdgcn_mfma_f32_32x32x16_bf16(b0,qr[d0],p0,0,0,0);p1=__builtin_amdgcn_mfma_f32_32x32x16_bf16(b1,qr[d0],p1,0,0,0);}}
}
typedef __attribute__((address_space(3))) const char* lds_cptr;
typedef short v4i16_t __attribute__((ext_vector_type(4)));
__device__ __forceinline__ void kload8(bf16x8*kf,lds_cptr kp){
  kf[0]=*(const __attribute__((address_space(3))) bf16x8*)(kp);      kf[1]=*(const __attribute__((address_space(3))) bf16x8*)(kp+512);
  kf[2]=*(const __attribute__((address_space(3))) bf16x8*)(kp+2048); kf[3]=*(const __attribute__((address_space(3))) bf16x8*)(kp+2560);
  kf[4]=*(const __attribute__((address_space(3))) bf16x8*)(kp+4096); kf[5]=*(const __attribute__((address_space(3))) bf16x8*)(kp+4608);
  kf[6]=*(const __attribute__((address_space(3))) bf16x8*)(kp+6144); kf[7]=*(const __attribute__((address_space(3))) bf16x8*)(kp+6656);
}
__device__ __forceinline__ void kload2(bf16x8*kf,lds_cptr kp,int j){ kf[2*j]=*(const __attribute__((address_space(3))) bf16x8*)(kp+j*2048); kf[2*j+1]=*(const __attribute__((address_space(3))) bf16x8*)(kp+j*2048+512); }
__device__ __forceinline__ s16x4 vtr(lds_cptr p){ return __builtin_bit_cast(s16x4,__builtin_amdgcn_ds_read_tr16_b64_v4i16((__attribute__((address_space(3))) v4i16_t*)p)); }
__device__ __forceinline__ float rowmax(const f32x16&p0,const f32x16&p1){
  float a=max3f(p0[0],p0[1],p1[0]),b=max3f(p0[2],p0[3],p1[1]);a=max3f(a,p1[2],p1[3]);
  #pragma unroll
  for(int r=4;r<16;r+=4){a=max3f(a,p0[r],p0[r+1]);b=max3f(b,p0[r+2],p0[r+3]);a=max3f(a,p1[r],p1[r+1]);b=max3f(b,p1[r+2],p1[r+3]);}
  const float m=max2f(a,b);
  auto rr=__builtin_amdgcn_permlane32_swap(__float_as_uint(m),__float_as_uint(m),false,false);
  return max2f(__uint_as_float(rr[0]),__uint_as_float(rr[1]));
}
__device__ __forceinline__ void pv(f32x16*o,int vb,bf16x8 pa0,bf16x8 pa1,bf16x8 pa2,bf16x8 pa3){
  #pragma unroll
  for(int d0=0;d0<2;++d0){s16x4 lo[4],hi[4];
    #pragma unroll
    for(int ks=0;ks<4;++ks){
      asm volatile("ds_read_b64_tr_b16 %0,%1 offset:%c2":"=&v"(lo[ks]):"v"(vb),"i"(d0*4096+ks*1024):"memory");
      asm volatile("ds_read_b64_tr_b16 %0,%1 offset:%c2":"=&v"(hi[ks]):"v"(vb),"i"(d0*4096+ks*1024+512):"memory");}
    asm volatile("s_waitcnt lgkmcnt(0)":::"memory");SBAR();
    #define PK(k) (bf16x8){lo[k][0],lo[k][1],lo[k][2],lo[k][3],hi[k][0],hi[k][1],hi[k][2],hi[k][3]}
    o[d0]=__builtin_amdgcn_mfma_f32_32x32x16_bf16(pa0,PK(0),o[d0],0,0,0);
    o[d0]=__builtin_amdgcn_mfma_f32_32x32x16_bf16(pa1,PK(1),o[d0],0,0,0);
    o[d0]=__builtin_amdgcn_mfma_f32_32x32x16_bf16(pa2,PK(2),o[d0],0,0,0);
    o[d0]=__builtin_amdgcn_mfma_f32_32x32x16_bf16(pa3,PK(3),o[d0],0,0,0);
    #undef PK
  }
}

#ifndef ATTN_STORE16
#define ATTN_STORE16(p,v) (*(u32x4*)(p)=(v))
#endif
template<int THRL> __device__ __forceinline__ void attn_unit(int b,int h,int qb,const bf16*Q,const bf16*__restrict__ K,const bf16*__restrict__ V,bf16*O,char*shm){
  int tid_=threadIdx.x; asm volatile("":"+v"(tid_)); const int tid=tid_,lane=tid&63,r32=lane&31,hi=lane>>5; const int wid=__builtin_amdgcn_readfirstlane(tid>>6);
  const long rowbase=(long)b*SEQ; const int q0=qb*QB;
  const bf16*Qw=Q+(rowbase+q0+wid*QBLK)*DM+h*D;
  const bf16*Kh=K+rowbase*DM+h*D,*Vh=V+rowbase*DM+h*D;
  const unsigned lds0=(unsigned)(uintptr_t)shm;
  float*wsf=(float*)(shm+LDS_WS)+wid*64;
  const bf16*ksrc=Kh+(long)lane*DM+wid*8;
  const bf16*vsrc=Vh+(long)(16*(wid&3)+(lane>>2))*DM+(wid>>2)*32+(lane&3)*8;
  const unsigned kdst=lds0+LDS_K+wid*1024, vdst=lds0+LDS_V+wid*1024;
  #define DMA_K(t,slot) glds16(ksrc+(long)(t)*KVBLK*DM,(unsigned)__builtin_amdgcn_readfirstlane(kdst+(slot)))
  #define DMA_V(t,slot) glds16(vsrc+(long)(t)*KVBLK*DM,(unsigned)__builtin_amdgcn_readfirstlane(vdst+(slot)))
  const int vb0=(int)(lds0+LDS_V)+((lane>>4)&1)*32+(lane&3)*8+(4*hi+((lane&15)>>2))*64;
  const char*Kbase=shm+LDS_K; bf16x8 kf[8];
  const lds_cptr shm3=(lds_cptr)shm; const lds_cptr kp0=shm3+LDS_K+hi*1024+r32*16; const lds_cptr vp0=shm3+LDS_V+((lane>>4)&1)*32+(lane&3)*8+(4*hi+((lane&15)>>2))*64;
  const int NT=(q0+QB)/KVBLK;
  DMA_K(0,0);DMA_V(0,0);DMA_K(1,SLOTB);
  bf16x8 qr[4];
  #pragma unroll
  for(int d0=0;d0<4;++d0)qr[d0]=*reinterpret_cast<const bf16x8*>(&Qw[(long)r32*DM+d0*16+hi*8]);
  float mhat=0.f,l_reg=0.f;f32x16 o[2];o[0]=f32x16{};o[1]=f32x16{};f32x16 negm=f32x16{};asm volatile("":"+v"(negm));
  const int qrel=wid*QBLK+r32;
  #define CMASK(P0,P1,t) do{int jb_=(t)-(NT-4); if(jb_>=0)cmask(P0,P1,jb_,qrel,hi);}while(0)
  bool resc=false;
  #define START(P0,P1) do{ const float rm=rowmax(P0,P1); resc=false; \
    { const float dl=rm; mhat=fadd_s(mhat,dl); \
      _Pragma("unroll") for(int r=0;r<16;++r){P0[r]=fsub_s(P0[r],dl);P1[r]=fsub_s(P1[r],dl);} \
      _Pragma("unroll") for(int r=0;r<16;++r)negm[r]=-mhat; asm volatile("":"+v"(negm)); } \
    _Pragma("unroll") for(int r=0;r<16;++r)P0[r]=__builtin_amdgcn_exp2f(P0[r]); }while(0)
  #define RESC() do{ if(resc){ asm volatile("s_waitcnt lgkmcnt(0)":::"memory"); \
      _Pragma("unroll") for(int d_=0;d_<2;++d_) _Pragma("unroll") for(int r=0;r<16;++r)o[d_][r]*=wsf[crow(r,hi)]; } }while(0)
  f32x16 pA0,pA1,pB0,pB1;
  int sl_prev=0,sl_cur=0,sl_next=SLOTB;
  #define ROT() do{sl_prev=sl_cur;sl_cur=sl_next;sl_next=(sl_next==(NSLOT-1)*SLOTB)?0:sl_next+SLOTB;}while(0)
  DMA_K(2,2*SLOTB);
  WAIT_BAR(3);
  qkt(pA0,pA1,Kbase,qr,negm,r32,hi);asm volatile("s_nop 15\n\ts_nop 7":"+v"(pA0),"+v"(pA1));CMASK(pA0,pA1,0);
  START(pA0,pA1);
  _Pragma("unroll") for(int r=0;r<16;++r)pA1[r]=__builtin_amdgcn_exp2f(pA1[r]);
  WAIT_BAR(0);
  DMA_K(3,0);DMA_V(1,SLOTB);
  ROT();
  kload8(kf,kp0+sl_cur);
  WAIT_BAR(2);
  s16x4 vlo[8],vhi[8]; u32x4 pw0,pw1,pw2,pw3;
  #define PKW(P,B) cvtpk_s(P[B],P[B+1])
  #define PAF(k) __builtin_bit_cast(bf16x8,pw##k)
  #define VFR(i) (bf16x8){vlo[i][0],vlo[i][1],vlo[i][2],vlo[i][3],vhi[i][0],vhi[i][1],vhi[i][2],vhi[i][3]}
  #define PIN(x) asm volatile("":"+v"(x))
  #define MX3(a,b,c) __builtin_fmaxf(__builtin_fmaxf((a),(b)),(c))
  #define GAPA(MF,A0,A1,A2,A3,W0,W1,PW) do{ MF; sacc+=A0; sacc+=A1; sacc+=A2; sacc+=A3; PIN(sacc); W0; W1; PIN(PW); SBAR(); }while(0)
  #define EX(v) __builtin_amdgcn_exp2f(v)
  #define GAPB(MF,X,B) do{ MF; X[B]=EX(X[B]); X[B+1]=EX(X[B+1]); X[B+2]=EX(X[B+2]); X[B+3]=EX(X[B+3]); PIN(X); SBAR(); }while(0)
  #define VRD(i) do{ vlo[i]=vtr(vp_+(((i)>>2)*4096+((i)&3)*1024)); vhi[i]=vtr(vp_+(((i)>>2)*4096+((i)&3)*1024+512)); }while(0)
  #define KRD(G,j) do{ if(G){ kload2(kf,kp0+sl_next,j); SBAR(); } }while(0)
  #define STEP(C0,C1,P0,P1,t,GK,GV,GL) do{ SBAR(); \
    const lds_cptr vp_=vp0+sl_prev; \
    VRD(0); SBAR(); float sacc=(P0[0]+P0[1]); \
    GAPA(C0=__builtin_amdgcn_mfma_f32_32x32x16_bf16(kf[0],qr[0],negm,0,0,0), P0[2],P0[3],P0[4],P0[5],     pw0[0]=PKW(P0,0), pw0[1]=PKW(P0,2), pw0); \
    VRD(4); SBAR(); GAPA(C1=__builtin_amdgcn_mfma_f32_32x32x16_bf16(kf[1],qr[0],negm,0,0,0), P0[6],P0[7],P0[8],P0[9],     pw0[2]=PKW(P0,4), pw0[3]=PKW(P0,6), pw0); \
    VRD(1); SBAR(); GAPA(C0=__builtin_amdgcn_mfma_f32_32x32x16_bf16(kf[2],qr[1],C0,0,0,0),   P0[10],P0[11],P0[12],P0[13], pw1[0]=PKW(P0,8), pw1[1]=PKW(P0,10), pw1); \
    VRD(5); SBAR(); GAPA(C1=__builtin_amdgcn_mfma_f32_32x32x16_bf16(kf[3],qr[1],C1,0,0,0),   P0[14],P0[15],P1[0],P1[1],   pw1[2]=PKW(P0,12),pw1[3]=PKW(P0,14), pw1); \
    VRD(2); SBAR(); GAPA(C0=__builtin_amdgcn_mfma_f32_32x32x16_bf16(kf[4],qr[2],C0,0,0,0),   P1[2],P1[3],P1[4],P1[5],     pw2[0]=PKW(P1,0), pw2[1]=PKW(P1,2), pw2); \
    VRD(6); SBAR(); GAPA(C1=__builtin_amdgcn_mfma_f32_32x32x16_bf16(kf[5],qr[2],C1,0,0,0),   P1[6],P1[7],P1[8],P1[9],     pw2[2]=PKW(P1,4), pw2[3]=PKW(P1,6), pw2); \
    VRD(3); SBAR(); GAPA(C0=__builtin_amdgcn_mfma_f32_32x32x16_bf16(kf[6],qr[3],C0,0,0,0),   P1[10],P1[11],P1[12],P1[13], pw3[0]=PKW(P1,8), pw3[1]=PKW(P1,10), pw3); \
    VRD(7); SBAR(); GAPA(C1=__builtin_amdgcn_mfma_f32_32x32x16_bf16(kf[7],qr[3],C1,0,0,0),   P1[14],P1[15],0.f,0.f,       pw3[2]=PKW(P1,12),pw3[3]=PKW(P1,14), pw3); \
    l_reg+=sacc; \
    if(GK){DMA_K((t)+3,sl_cur);} if(GV){DMA_V((t)+1,sl_next);} \
    CMASK(C0,C1,t); \
    { float a=MX3(C0[0],C0[1],C1[0]),b=MX3(C0[2],C0[3],C1[1]); a=MX3(a,C1[2],C1[3]); \
      _Pragma("unroll") for(int r=4;r<16;r+=4){a=MX3(a,C0[r],C0[r+1]);b=MX3(b,C0[r+2],C0[r+3]);a=MX3(a,C1[r],C1[r+1]);b=MX3(b,C1[r+2],C1[r+3]);} \
      float rm=__builtin_fmaxf(a,b); { auto rr=__builtin_amdgcn_permlane32_swap(__float_as_uint(rm),__float_as_uint(rm),false,false); rm=__builtin_fmaxf(__uint_as_float(rr[0]),__uint_as_float(rr[1])); } \
      resc=false; \
      if(__builtin_expect(__any(rm>(float)THRL),0)){ const float dl=__builtin_fmaxf(rm,0.f); mhat+=dl; \
        _Pragma("unroll") for(int r=0;r<16;++r){C0[r]-=dl;C1[r]-=dl;} \
        _Pragma("unroll") for(int r=0;r<16;++r)negm[r]=-mhat; asm volatile("":"+v"(negm)); \
        const float f=__builtin_amdgcn_exp2f(-dl); l_reg*=f; if(hi==0)wsf[r32]=f; resc=true; } } \
    SBAR(); \
    GAPB(o[0]=__builtin_amdgcn_mfma_f32_32x32x16_bf16(PAF(0),VFR(0),o[0],0,0,0), C0,0); \
    GAPB(o[1]=__builtin_amdgcn_mfma_f32_32x32x16_bf16(PAF(0),VFR(4),o[1],0,0,0), C0,4); \
    KRD(GL,0); GAPB(o[0]=__builtin_amdgcn_mfma_f32_32x32x16_bf16(PAF(1),VFR(1),o[0],0,0,0), C0,8); \
    KRD(GL,1); GAPB(o[1]=__builtin_amdgcn_mfma_f32_32x32x16_bf16(PAF(1),VFR(5),o[1],0,0,0), C0,12); \
    KRD(GL,2); GAPB(o[0]=__builtin_amdgcn_mfma_f32_32x32x16_bf16(PAF(2),VFR(2),o[0],0,0,0), C1,0); \
    KRD(GL,3); GAPB(o[1]=__builtin_amdgcn_mfma_f32_32x32x16_bf16(PAF(2),VFR(6),o[1],0,0,0), C1,4); \
    GAPB(o[0]=__builtin_amdgcn_mfma_f32_32x32x16_bf16(PAF(3),VFR(3),o[0],0,0,0), C1,8); \
    GAPB(o[1]=__builtin_amdgcn_mfma_f32_32x32x16_bf16(PAF(3),VFR(7),o[1],0,0,0), C1,12); \
    }while(0)
  int t=1;
  #undef CMASK
  #define CMASK(P0,P1,t) do{}while(0)
  for(;t+5<NT;t+=2){
    STEP(pB0,pB1,pA0,pA1,t,true,true,true);     WAIT_BAR(2); RESC(); ROT();
    STEP(pA0,pA1,pB0,pB1,t+1,true,true,true);   WAIT_BAR(2); RESC(); ROT();
  }
  #undef CMASK
  #define CMASK(P0,P1,t) do{int jb_=(t)-(NT-4); if(jb_>=0)cmask(P0,P1,jb_,qrel,hi);}while(0)
  #define ENDW(tt) do{ if((tt)+3<NT){WAIT_BAR(2);} else if((tt)+2<NT){WAIT_BAR(1);} else {WAIT_BAR(0);} }while(0)
  for(;t+1<NT;t+=2){
    STEP(pB0,pB1,pA0,pA1,t,(t+3<NT),(t+1<NT),(t+1<NT));       ENDW(t);   RESC(); ROT();
    STEP(pA0,pA1,pB0,pB1,t+1,(t+4<NT),(t+2<NT),(t+2<NT));     ENDW(t+1); RESC(); ROT();
  }
  STEP(pB0,pB1,pA0,pA1,NT-1,false,false,false); RESC();
  { float sacc=pB0[0]+pB0[1]; _Pragma("unroll") for(int r=2;r<16;++r)sacc+=pB0[r]; _Pragma("unroll") for(int r=0;r<16;++r)sacc+=pB1[r]; l_reg+=sacc;
    pw0=(u32x4){PKW(pB0,0),PKW(pB0,2),PKW(pB0,4),PKW(pB0,6)};pw1=(u32x4){PKW(pB0,8),PKW(pB0,10),PKW(pB0,12),PKW(pB0,14)};pw2=(u32x4){PKW(pB1,0),PKW(pB1,2),PKW(pB1,4),PKW(pB1,6)};pw3=(u32x4){PKW(pB1,8),PKW(pB1,10),PKW(pB1,12),PKW(pB1,14)};
    SBAR(); pv(o,vb0+sl_cur,PAF(0),PAF(1),PAF(2),PAF(3)); }
  #undef PKW
  #undef PAF
  #undef VFR
  #undef PIN
  #undef MX3
  #undef GAPA
  #undef GAPB
  #undef EX
  #undef VRD
  #undef KRD
  #undef STEP
  #undef ENDW
  {auto rr=__builtin_amdgcn_permlane32_swap(__float_as_uint(l_reg),__float_as_uint(l_reg),false,false);l_reg=__uint_as_float(rr[0])+__uint_as_float(rr[1]);}
  if(hi==0)wsf[32+r32]=l_reg;asm volatile("s_waitcnt lgkmcnt(0)":::"memory");
  float rli[16];
  #pragma unroll
  for(int r=0;r<16;++r)rli[r]=__builtin_amdgcn_rcpf(wsf[32+crow(r,hi)]);
  bf16*Ow=O+(rowbase+q0+wid*QBLK)*DM+h*D;
  { bf16*stg=(bf16*)(shm+LDS_OST)+wid*2048;
    #pragma unroll
    for(int r=0;r<16;++r){const int orow=crow(r,hi);
      #pragma unroll
      for(int d0=0;d0<2;++d0)stg[orow*64+d0*32+r32]=__float2bfloat16(o[d0][r]*rli[r]);}
    asm volatile("s_waitcnt lgkmcnt(0)":::"memory");
    #pragma unroll
    for(int i=0;i<4;++i){const int row=i*8+(lane>>3),ch=lane&7; const u32x4 v=*(const u32x4*)(stg+row*64+ch*8); ATTN_STORE16(Ow+(long)row*DM+ch*8,v);} }
  asm volatile("s_waitcnt lgkmcnt(0)\n\ts_barrier":::"memory");
  #undef DMA_K
  #undef DMA_V
  #undef CMASK
  #undef START
  #undef RESC
  #undef ROT
}
constexpr int ATTN_LDS_BYTES=LDS_BYTES;
#undef SBAR
#undef WAIT_BAR
}

#define LAS __attribute__((address_space(3)))
typedef unsigned short bf16;
typedef unsigned v4u __attribute__((ext_vector_type(4)));
typedef unsigned v2u __attribute__((ext_vector_type(2)));
typedef float f32x4 __attribute__((ext_vector_type(4)));
typedef float f32x16 __attribute__((ext_vector_type(16)));
typedef short bf16x8 __attribute__((ext_vector_type(8)));
typedef short s16x4 __attribute__((ext_vector_type(4)));
constexpr float RMS_EPS = 1e-6f;
constexpr int NWAVES = 8, NTHREADS = 512;
constexpr int M = 16384, DM = 2048, SEQ = 2048, MEMROWS = 2048, BIGP = 8256, WF2P = 8256;
constexpr size_t MiB = 1u << 20;
constexpr size_t WS_SMALL = 0;
constexpr size_t WS_BAR = 1 * MiB;
constexpr size_t WS_W1 = 2 * MiB;
constexpr size_t WS_POOL = 18 * MiB;
constexpr size_t WS_WO0 = 20 * MiB, WS_WO1 = 28 * MiB;
constexpr size_t WS_W6 = 36 * MiB;
constexpr size_t WS_WF1 = 56 * MiB;
constexpr size_t WS_WF2 = 88 * MiB;
constexpr size_t WS_MKV = 122 * MiB;
constexpr size_t WS_XB = 130 * MiB;
constexpr size_t WS_BIG = 202 * MiB;
constexpr size_t WS_WF2B = 460 * MiB;
constexpr size_t WS_END = 493 * MiB;
constexpr int LDS_BYTES = 147456;

__device__ __forceinline__ unsigned f2bf(float f) { unsigned u = __builtin_bit_cast(unsigned, f); return (u + 0x7fffu + ((u >> 16) & 1u)) >> 16; }
__device__ __forceinline__ unsigned pk2(float lo, float hi) { return f2bf(lo) | (f2bf(hi) << 16); }
__device__ __forceinline__ float bflo(unsigned w) { return __builtin_bit_cast(float, w << 16); }
__device__ __forceinline__ float bfhi(unsigned w) { return __builtin_bit_cast(float, w & 0xffff0000u); }
#define LDS_WAIT() asm volatile("s_waitcnt lgkmcnt(0)" ::: "memory")
__device__ __forceinline__ float wave_sum(float v) {
#pragma unroll
    for (int o = 1; o < 64; o <<= 1) v += __shfl_xor(v, o);
    return v;
}

typedef unsigned gu32_unused_t;
#define RLX_AGENT __ATOMIC_RELAXED, __HIP_MEMORY_SCOPE_AGENT
#define XB_TMO      128
#define XB_XCNT(j)  (256  + 64 * (j))
#define XB_XSUB(j)  (1280 + 64 * (j))
#define XB_XGEN(j)  (2304 + 64 * (j))
#define XB_TOP      3328
#define XB_TOPGEN   3392
#define XCD_BAR_WORDS 3456
#define XB_SPIN_CAP (1u << 18)

__device__ __forceinline__ unsigned xb_ld(unsigned* p)              { return __hip_atomic_load(p, __ATOMIC_RELAXED, __HIP_MEMORY_SCOPE_AGENT); }
__device__ __forceinline__ unsigned xb_add(unsigned* p, unsigned v) { return __hip_atomic_fetch_add(p, v, __ATOMIC_RELAXED, __HIP_MEMORY_SCOPE_AGENT); }
__device__ __forceinline__ unsigned xb_xcc_id() { return (unsigned)__builtin_amdgcn_s_getreg((3 << 11) | 20) & 0xFu; }
#define XB_SPIN(cond, bar) do { unsigned _sp = 0; while (cond) { __builtin_amdgcn_s_sleep(1); \
    if ((++_sp & 255u) == 0u) { if (xb_ld(&(bar)[XB_TMO])) break; if (_sp > XB_SPIN_CAP) { atomicAdd(&(bar)[XB_TMO], 1u); break; } } } } while (0)

struct XcdBarrier {
    unsigned* bar; unsigned x;
    volatile LAS unsigned* st;
};

__device__ __forceinline__ XcdBarrier xcd_barrier_post(unsigned* bar, volatile LAS unsigned* st) {
    XcdBarrier b; b.bar = bar; b.x = xb_xcc_id(); b.st = st;
    if (threadIdx.x == 0) (void)xb_add(&bar[XB_XCNT(b.x)], 1u);
    return b;
}
__device__ __forceinline__ void xcd_barrier_complete(unsigned* bar, unsigned x, unsigned& nloc, unsigned& nx) {
    const unsigned G = gridDim.x * gridDim.y * gridDim.z;
    unsigned sum, cnt, mine, sp = 0u;
    for (;;) {
        sum = 0u; cnt = 0u; mine = 0u;
#pragma unroll
        for (unsigned j = 0; j < 16; ++j) { const unsigned c = xb_ld(&bar[XB_XCNT(j)]); sum += c; cnt += (c > 0u) ? 1u : 0u; mine = (j == x) ? c : mine; }
        if (sum == G) break;
        __builtin_amdgcn_s_sleep(1);
        if ((++sp & 255u) == 0u) { if (xb_ld(&bar[XB_TMO])) break; if (sp > XB_SPIN_CAP) { atomicAdd(&bar[XB_TMO], 1u); break; } }
    }
    nloc = mine > 0u ? mine : 1u; nx = cnt > 0u ? cnt : 1u;
}

__device__ __forceinline__ void xcd_barrier(const XcdBarrier& b) {
    asm volatile("s_waitcnt vmcnt(0)" ::: "memory");
    __syncthreads();
    if (threadIdx.x == 0) {
        unsigned* bar = b.bar;
        __builtin_amdgcn_s_waitcnt(0);
        unsigned nloc = b.st[0], nx = b.st[1];
        if (nloc == 0u) { xcd_barrier_complete(bar, b.x, nloc, nx); b.st[0] = nloc; b.st[1] = nx; }
        const unsigned old = xb_add(&bar[XB_XSUB(b.x)], 1u);
        const unsigned gen = old / nloc;
        if (old + 1u == (gen + 1u) * nloc) {
            __builtin_amdgcn_fence(__ATOMIC_RELEASE, "agent");
            asm volatile("s_waitcnt vmcnt(0)" ::: "memory");
            const unsigned og = xb_add(&bar[XB_TOP], 1u);
            const unsigned tg = og / nx;
            if (og + 1u == (tg + 1u) * nx) xb_add(&bar[XB_TOPGEN], 1u);
            else XB_SPIN(xb_ld(&bar[XB_TOPGEN]) == tg, bar);
            __builtin_amdgcn_fence(__ATOMIC_ACQUIRE, "agent");
            xb_add(&bar[XB_XGEN(b.x)], 1u);
            asm volatile("s_waitcnt vmcnt(0)" ::: "memory");
        } else {
            XB_SPIN(xb_ld(&bar[XB_XGEN(b.x)]) == gen, bar);
            __builtin_amdgcn_fence(__ATOMIC_ACQUIRE, "agent");
            asm volatile("s_waitcnt vmcnt(0)" ::: "memory");
        }
    }
    __syncthreads();
}


struct TJob { const float* W; int K, N; bf16* WT; int row_off; const float* kgain; const float* nscale; int kperm, sigma, ldw; };
__device__ __forceinline__ void transpose_item(const TJob& j, LAS float* scr, int item, int lane) {
    const int nblk = j.N / 32, kb = item / nblk, nb = item % nblk, k0 = 64 * kb, n0 = 32 * nb;
    const float ns = j.nscale ? j.nscale[n0 + (lane & 31)] : 1.0f;
    const float* wp = j.W + (size_t)(k0 + (lane >> 5)) * j.N + n0 + (lane & 31);
    float v[32];
#pragma unroll
    for (int i = 0; i < 32; ++i) v[i] = wp[(size_t)(2 * i) * j.N];
    const int c = lane & 7;
    f32x4 g0 = (f32x4){1.f, 1.f, 1.f, 1.f}, g1 = g0;
    if (j.kgain) { g0 = *(const f32x4*)(j.kgain + k0 + 8 * c); g1 = *(const f32x4*)(j.kgain + k0 + 8 * c + 4); }
#pragma unroll
    for (int i = 0; i < 32; ++i) scr[(2 * i + (lane >> 5)) * 33 + (lane & 31)] = v[i] * ns;
    LDS_WAIT(); asm volatile("" ::: "memory");
    const int kd = j.kperm ? ((k0 + 512) & 2047) : k0;
    int nd0 = n0;
    if (j.sigma) { const int tile = n0 >> 8, grp = (n0 & 255) >> 5; nd0 = tile * 256 + (4 * (grp & 1) + (grp >> 1)) * 32; }
#pragma unroll
    for (int jj = 0; jj < 4; ++jj) { const int n = (lane >> 3) + 8 * jj; const LAS float* s = scr + (8 * c) * 33 + n;
        v4u o; o.x = pk2(s[0 * 33] * g0.x, s[1 * 33] * g0.y); o.y = pk2(s[2 * 33] * g0.z, s[3 * 33] * g0.w); o.z = pk2(s[4 * 33] * g1.x, s[5 * 33] * g1.y); o.w = pk2(s[6 * 33] * g1.z, s[7 * 33] * g1.w);
        *(v4u*)(j.WT + (size_t)(j.row_off + nd0 + n) * (j.ldw ? j.ldw : j.K) + kd + 8 * c) = o; }
    LDS_WAIT(); asm volatile("" ::: "memory");
}
__device__ __forceinline__ void run_tjob(const TJob& j, LAS float* scr, int gw, int NGW, int lane, int& cursor) {
    const int nitems = (j.K / 64) * (j.N / 32);
    int first = (gw - cursor % NGW + NGW) % NGW;
    for (int it = first; it < nitems; it += NGW) transpose_item(j, scr, it, lane);
    cursor += nitems;
}
__device__ __forceinline__ void row_to_bf16(const float* xrow, bf16* orow, float* rss, int lane) {
    const f32x4* xr = (const f32x4*)xrow + lane;
    f32x4 v[8]; float s = 0.f;
#pragma unroll
    for (int jx = 0; jx < 8; ++jx) { v[jx] = xr[64 * jx]; s += (v[jx].x * v[jx].x + v[jx].y * v[jx].y) + (v[jx].z * v[jx].z + v[jx].w * v[jx].w); }
    s = wave_sum(s);
    unsigned long long* o8 = (unsigned long long*)orow + lane;
#pragma unroll
    for (int jx = 0; jx < 8; ++jx) o8[64 * jx] = (unsigned long long)pk2(v[jx].x, v[jx].y) | ((unsigned long long)pk2(v[jx].z, v[jx].w) << 32);
    if (lane == 0) *rss = s;
}

constexpr int MA_KP = 272, MA_VP = 528;
constexpr int MA_K_OFF = 0, MA_V_OFF = 256 * MA_KP;
static_assert(MA_V_OFF + 128 * MA_VP <= 139264, "mem-attn LDS");
__device__ __forceinline__ void memattn_unit(bf16* qp, const bf16* kp, const bf16* vp, const float* qg, const float* kg, LAS unsigned char* lds, int wid, int lane) {
    __syncthreads();
    {
        const int c = lane & 15; const f32x4 g0 = *(const f32x4*)(kg + 8 * c), g1 = *(const f32x4*)(kg + 8 * c + 4);
        const int kv = 64 * (wid & 3) + lane;
        v4u kw[8], vw[8];
#pragma unroll
        for (int it = 0; it < 8; ++it) kw[it] = *(const v4u*)(kp + (size_t)(it * 32 + wid * 4 + (lane >> 4)) * 2048 + 8 * c);
#pragma unroll
        for (int it = 0; it < 8; ++it) vw[it] = *(const v4u*)(vp + (size_t)kv * 2048 + 8 * (8 * (wid >> 2) + it));
#pragma unroll
        for (int it = 0; it < 8; ++it) { const int r = it * 32 + wid * 4 + (lane >> 4); const v4u w = kw[it];
            float f[8]; f[0] = bflo(w.x); f[1] = bfhi(w.x); f[2] = bflo(w.y); f[3] = bfhi(w.y); f[4] = bflo(w.z); f[5] = bfhi(w.z); f[6] = bflo(w.w); f[7] = bfhi(w.w);
            float ss = 0.f;
#pragma unroll
            for (int e = 0; e < 8; ++e) ss += f[e] * f[e];
            ss += __shfl_xor(ss, 1); ss += __shfl_xor(ss, 2); ss += __shfl_xor(ss, 4); ss += __shfl_xor(ss, 8);
            const float rs = rsqrtf(ss * (1.0f / 128.0f) + RMS_EPS);
            v4u o; o.x = pk2(f[0] * rs * g0.x, f[1] * rs * g0.y); o.y = pk2(f[2] * rs * g0.z, f[3] * rs * g0.w); o.z = pk2(f[4] * rs * g1.x, f[5] * rs * g1.y); o.w = pk2(f[6] * rs * g1.z, f[7] * rs * g1.w);
            *(LAS v4u*)(lds + MA_K_OFF + r * MA_KP + 16 * c) = o; }
#pragma unroll
        for (int it = 0; it < 8; ++it) { const int cc = 8 * (wid >> 2) + it; const v4u w = vw[it];
            LAS unsigned short* d = (LAS unsigned short*)(lds + MA_V_OFF + (8 * cc) * MA_VP + 2 * kv);
            d[0 * (MA_VP / 2)] = (unsigned short)(w.x & 0xffffu); d[1 * (MA_VP / 2)] = (unsigned short)(w.x >> 16);
            d[2 * (MA_VP / 2)] = (unsigned short)(w.y & 0xffffu); d[3 * (MA_VP / 2)] = (unsigned short)(w.y >> 16);
            d[4 * (MA_VP / 2)] = (unsigned short)(w.z & 0xffffu); d[5 * (MA_VP / 2)] = (unsigned short)(w.z >> 16);
            d[6 * (MA_VP / 2)] = (unsigned short)(w.w & 0xffffu); d[7 * (MA_VP / 2)] = (unsigned short)(w.w >> 16); }
    }
    const int r32 = lane & 31, hh = lane >> 5;
    bf16* qrow = qp + (size_t)(wid * 32 + r32) * BIGP;
    bf16x8 qr[8];
    {
        v4u qw[8]; float ss = 0.f;
#pragma unroll
        for (int d0 = 0; d0 < 8; ++d0) { qw[d0] = *(const v4u*)(qrow + 16 * d0 + 8 * hh);
            const float a0 = bflo(qw[d0].x), a1 = bfhi(qw[d0].x), a2 = bflo(qw[d0].y), a3 = bfhi(qw[d0].y), a4 = bflo(qw[d0].z), a5 = bfhi(qw[d0].z), a6 = bflo(qw[d0].w), a7 = bfhi(qw[d0].w);
            ss += (a0 * a0 + a1 * a1) + (a2 * a2 + a3 * a3) + (a4 * a4 + a5 * a5) + (a6 * a6 + a7 * a7); }
        ss += __shfl_xor(ss, 32);
        const float rs = rsqrtf(ss * (1.0f / 128.0f) + RMS_EPS) * (0.08838834764831845f * 1.4426950408889634f);
#pragma unroll
        for (int d0 = 0; d0 < 8; ++d0) { const f32x4 g0 = *(const f32x4*)(qg + 16 * d0 + 8 * hh), g1 = *(const f32x4*)(qg + 16 * d0 + 8 * hh + 4);
            v4u o; o.x = pk2(bflo(qw[d0].x) * rs * g0.x, bfhi(qw[d0].x) * rs * g0.y); o.y = pk2(bflo(qw[d0].y) * rs * g0.z, bfhi(qw[d0].y) * rs * g0.w);
            o.z = pk2(bflo(qw[d0].z) * rs * g1.x, bfhi(qw[d0].z) * rs * g1.y); o.w = pk2(bflo(qw[d0].w) * rs * g1.z, bfhi(qw[d0].w) * rs * g1.w);
            qr[d0] = __builtin_bit_cast(bf16x8, o); }
    }
    __syncthreads();
    f32x16 o[4]; o[0] = f32x16{}; o[1] = f32x16{}; o[2] = f32x16{}; o[3] = f32x16{};
    float lsum = 0.f;
    const LAS unsigned char* kbase = lds + MA_K_OFF + r32 * MA_KP + 16 * hh;
    const LAS unsigned char* vbase = lds + MA_V_OFF + r32 * MA_VP + 8 * hh;
#pragma unroll 1
    for (int kb = 0; kb < 8; kb += 2) {
        f32x16 x0 = f32x16{}, x1 = f32x16{};
#pragma unroll
        for (int d0 = 0; d0 < 8; ++d0) { const bf16x8 k0 = *(const LAS bf16x8*)(kbase + kb * 32 * MA_KP + 32 * d0), k1 = *(const LAS bf16x8*)(kbase + (kb + 1) * 32 * MA_KP + 32 * d0);
            x0 = __builtin_amdgcn_mfma_f32_32x32x16_bf16(k0, qr[d0], x0, 0, 0, 0); x1 = __builtin_amdgcn_mfma_f32_32x32x16_bf16(k1, qr[d0], x1, 0, 0, 0); }
        float sacc = 0.f;
#pragma unroll
        for (int r = 0; r < 16; ++r) { x0[r] = __builtin_amdgcn_exp2f(x0[r]); x1[r] = __builtin_amdgcn_exp2f(x1[r]); sacc += x0[r] + x1[r]; }
        lsum += sacc;
        v4u pw[4];
        pw[0].x = pk2(x0[0], x0[1]); pw[0].y = pk2(x0[2], x0[3]); pw[0].z = pk2(x0[4], x0[5]); pw[0].w = pk2(x0[6], x0[7]);
        pw[1].x = pk2(x0[8], x0[9]); pw[1].y = pk2(x0[10], x0[11]); pw[1].z = pk2(x0[12], x0[13]); pw[1].w = pk2(x0[14], x0[15]);
        pw[2].x = pk2(x1[0], x1[1]); pw[2].y = pk2(x1[2], x1[3]); pw[2].z = pk2(x1[4], x1[5]); pw[2].w = pk2(x1[6], x1[7]);
        pw[3].x = pk2(x1[8], x1[9]); pw[3].y = pk2(x1[10], x1[11]); pw[3].z = pk2(x1[12], x1[13]); pw[3].w = pk2(x1[14], x1[15]);
#define MA_VF(dst, db_, s_) do { const LAS unsigned char* vb_ = vbase + (db_) * 32 * MA_VP + kb * 64 + (s_) * 32; const v2u a_ = *(const LAS v2u*)(vb_), b_ = *(const LAS v2u*)(vb_ + 16); \
            dst.x = a_.x; dst.y = a_.y; dst.z = b_.x; dst.w = b_.y; } while (0)
        v4u c[4], n[4];
#pragma unroll
        for (int s_ = 0; s_ < 4; ++s_) MA_VF(c[s_], 0, s_);
#pragma unroll
        for (int db = 0; db < 4; ++db) {
            if (db < 3) {
#pragma unroll
                for (int s_ = 0; s_ < 4; ++s_) MA_VF(n[s_], db + 1, s_); }
            __builtin_amdgcn_sched_barrier(0);
#pragma unroll
            for (int s_ = 0; s_ < 4; ++s_) o[db] = __builtin_amdgcn_mfma_f32_32x32x16_bf16(__builtin_bit_cast(bf16x8, c[s_]), __builtin_bit_cast(bf16x8, pw[s_]), o[db], 0, 0, 0);
            __builtin_amdgcn_sched_barrier(0);
#pragma unroll
            for (int s_ = 0; s_ < 4; ++s_) c[s_] = n[s_];
        }
#undef MA_VF
    }
    lsum += __shfl_xor(lsum, 32);
    const float rl = 1.0f / lsum;
#pragma unroll
    for (int db = 0; db < 4; ++db)
#pragma unroll
        for (int g = 0; g < 4; ++g) { v2u w; w.x = pk2(o[db][4 * g] * rl, o[db][4 * g + 1] * rl); w.y = pk2(o[db][4 * g + 2] * rl, o[db][4 * g + 3] * rl);
            *(v2u*)(qrow + 32 * db + 8 * g + 4 * hh) = w; }
}
#ifdef DBGCHK
__device__ __forceinline__ float bf2f(bf16 v) { return __builtin_bit_cast(float, (unsigned)v << 16); }
__device__ __forceinline__ unsigned hsh(unsigned s, unsigned k) { unsigned h = s * 2654435761u + k * 40503u + 12345u; h ^= h >> 13; h *= 2246822519u; h ^= h >> 16; return h; }
__device__ __forceinline__ void chk(unsigned* flag, int stage, float got, float want, float tol) { if (!(fabsf(got - want) <= tol * (fabsf(want) + 1.0f))) atomicMin(flag, (unsigned)stage); }
__device__ __forceinline__ float row_rstd(const float* xr, int lane) { float s = 0.f; for (int k = lane; k < 2048; k += 64) s += xr[k] * xr[k]; s = wave_sum(s); return rsqrtf(s * (1.0f / 2048.0f) + RMS_EPS); }
__device__ __forceinline__ float row_dot(const float* xr, const float* g, const float* W, int ldw, int col, int lane) { float s = 0.f; for (int k = lane; k < 2048; k += 64) s += xr[k] * (g ? g[k] : 1.0f) * W[(size_t)k * ldw + col]; return wave_sum(s); }
__device__ __forceinline__ void chk_memattn(unsigned* flag, int stage, const float* xr, const float* g, const float* W, int ldw, int wcol, const bf16* kp, const bf16* vp, const float* qg, const float* kg, const bf16* got, LAS float* scr, int lane) {
    const float rs = row_rstd(xr, lane);
    for (int d = 0; d < 128; ++d) { const float v = row_dot(xr, g, W, ldw, wcol + d, lane) * rs; if (lane == 0) scr[d] = v; }
    LDS_WAIT();
    float ss = 0.f; for (int d = 0; d < 128; ++d) ss += scr[d] * scr[d];
    const float qr = rsqrtf(ss * (1.0f / 128.0f) + RMS_EPS);
    float sc[4], mx = -1e30f;
#pragma unroll
    for (int i = 0; i < 4; ++i) { const int j = lane + 64 * i; float ks = 0.f; for (int d = 0; d < 128; ++d) { const float kv = bf2f(kp[(size_t)j * 2048 + d]); ks += kv * kv; }
        const float kr = rsqrtf(ks * (1.0f / 128.0f) + RMS_EPS); float s = 0.f;
        for (int d = 0; d < 128; ++d) s += scr[d] * qr * qg[d] * bf2f(kp[(size_t)j * 2048 + d]) * kr * kg[d];
        sc[i] = s * 0.08838834764831845f; mx = fmaxf(mx, sc[i]); }
    for (int o = 1; o < 64; o <<= 1) mx = fmaxf(mx, __shfl_xor(mx, o));
    float l = 0.f;
#pragma unroll
    for (int i = 0; i < 4; ++i) { sc[i] = expf(sc[i] - mx); l += sc[i]; }
    l = wave_sum(l);
#pragma unroll
    for (int i = 0; i < 4; ++i) scr[128 + lane + 64 * i] = sc[i] / l;
    LDS_WAIT();
    for (int dd = 0; dd < 2; ++dd) { const int d = lane + 64 * dd; float o = 0.f; for (int j = 0; j < 256; ++j) o += scr[128 + j] * bf2f(vp[(size_t)j * 2048 + d]);
        chk(flag, stage, bf2f(got[d]), o, 0.05f); }
    LDS_WAIT();
}
__device__ __forceinline__ float naive_diff(const bf16* big, int row, int qcol, int kcol, int vcol, LAS float* scr, int lane) {
    const int b = row >> 11, t = row & 2047; const bf16* q = big + (size_t)row * BIGP + qcol;
    float mx = -1e30f;
    for (int j = lane; j <= t; j += 64) { const bf16* k = big + (size_t)(b * 2048 + j) * BIGP + kcol; float s = 0.f; for (int d = 0; d < 64; ++d) s += bf2f(q[d]) * bf2f(k[d]); scr[j] = s; mx = fmaxf(mx, s); }
    for (int o = 1; o < 64; o <<= 1) mx = fmaxf(mx, __shfl_xor(mx, o));
    float l = 0.f; for (int j = lane; j <= t; j += 64) { const float p = exp2f(scr[j] - mx); scr[j] = p; l += p; } l = wave_sum(l);
    LDS_WAIT();
    float o = 0.f; for (int j = 0; j <= t; ++j) o += scr[j] * bf2f(big[(size_t)(b * 2048 + j) * BIGP + vcol + lane]);
    LDS_WAIT();
    return o / l;
}
#endif
constexpr int DA_KP = 144, DA_VP = 144;
constexpr int DA_K_BYTES = 64 * DA_KP, DA_V_BYTES = 128 * DA_VP, DA_BUF = DA_K_BYTES + DA_V_BYTES;
__device__ __forceinline__ void diffattn_core(const bf16* qp, const bf16* kp, const bf16* vp, int qb, LAS unsigned char* lds, int wid, int lane, f32x16 (&o)[4], float& rl, bool have, const bf16* nk, const bf16* nv) {
    const int tid = wid * 64 + lane, r32 = lane & 31, hh = lane >> 5;
    const int q0 = qb * 256 + wid * 32;
    const int NT = 4 * (qb + 1);
    const bf16* kg = kp + (size_t)(tid >> 3) * BIGP + 8 * (tid & 7);
    const bf16* vg = vp + (size_t)lane * BIGP + 16 * wid;
    v4u kr = (v4u){0u, 0u, 0u, 0u}, vr0 = kr, vr1 = kr;
    if (!have) { kr = *(const v4u*)kg; vr0 = *(const v4u*)vg; vr1 = *(const v4u*)(vg + 8); }
    bf16x8 qr[4];
    { const bf16* qrow = qp + (size_t)(q0 + r32) * BIGP;
#pragma unroll
      for (int d0 = 0; d0 < 4; ++d0) qr[d0] = *(const bf16x8*)(qrow + 16 * d0 + 8 * hh); }
    o[0] = f32x16{}; o[1] = f32x16{}; o[2] = f32x16{}; o[3] = f32x16{};
    float lsum = 0.f;
    if (!have) __syncthreads();
#define DA_WRITE(buf) do { LAS unsigned char* kb_ = lds + (buf) * DA_BUF; \
        *(LAS v4u*)(kb_ + (tid >> 3) * DA_KP + 16 * (tid & 7)) = kr; \
        LAS unsigned short* d_ = (LAS unsigned short*)(kb_ + DA_K_BYTES + (16 * wid) * DA_VP + 2 * lane); \
        d_[0 * (DA_VP / 2)] = (unsigned short)(vr0.x & 0xffffu); d_[1 * (DA_VP / 2)] = (unsigned short)(vr0.x >> 16); d_[2 * (DA_VP / 2)] = (unsigned short)(vr0.y & 0xffffu); d_[3 * (DA_VP / 2)] = (unsigned short)(vr0.y >> 16); \
        d_[4 * (DA_VP / 2)] = (unsigned short)(vr0.z & 0xffffu); d_[5 * (DA_VP / 2)] = (unsigned short)(vr0.z >> 16); d_[6 * (DA_VP / 2)] = (unsigned short)(vr0.w & 0xffffu); d_[7 * (DA_VP / 2)] = (unsigned short)(vr0.w >> 16); \
        d_[8 * (DA_VP / 2)] = (unsigned short)(vr1.x & 0xffffu); d_[9 * (DA_VP / 2)] = (unsigned short)(vr1.x >> 16); d_[10 * (DA_VP / 2)] = (unsigned short)(vr1.y & 0xffffu); d_[11 * (DA_VP / 2)] = (unsigned short)(vr1.y >> 16); \
        d_[12 * (DA_VP / 2)] = (unsigned short)(vr1.z & 0xffffu); d_[13 * (DA_VP / 2)] = (unsigned short)(vr1.z >> 16); d_[14 * (DA_VP / 2)] = (unsigned short)(vr1.w & 0xffffu); d_[15 * (DA_VP / 2)] = (unsigned short)(vr1.w >> 16); } while (0)
    if (!have) DA_WRITE(0);
    __builtin_amdgcn_s_waitcnt(0x0F70);
    if (!have) __syncthreads();
#pragma unroll 1
    for (int t = 0; t < NT; ++t) {
        if (t + 1 < NT) { kr = *(const v4u*)(kg + (size_t)(t + 1) * 64 * BIGP); vr0 = *(const v4u*)(vg + (size_t)(t + 1) * 64 * BIGP); vr1 = *(const v4u*)(vg + (size_t)(t + 1) * 64 * BIGP + 8); }
        else if (nk) { kr = *(const v4u*)(nk + (size_t)(tid >> 3) * BIGP + 8 * (tid & 7)); vr0 = *(const v4u*)(nv + (size_t)lane * BIGP + 16 * wid); vr1 = *(const v4u*)(nv + (size_t)lane * BIGP + 16 * wid + 8); }
        const LAS unsigned char* kbase = lds + (t & 1) * DA_BUF + r32 * DA_KP + 16 * hh;
        const LAS unsigned char* vbase = lds + (t & 1) * DA_BUF + DA_K_BYTES + r32 * DA_VP + 8 * hh;
        if (t * 64 + 63 <= q0) {
            bf16x8 kf[8];
#pragma unroll
            for (int i = 0; i < 8; ++i) kf[i] = *(const LAS bf16x8*)(kbase + (i >> 2) * 32 * DA_KP + 32 * (i & 3));
            f32x16 x0 = f32x16{}, x1 = f32x16{};
#pragma unroll
            for (int d0 = 0; d0 < 4; ++d0) { x0 = __builtin_amdgcn_mfma_f32_32x32x16_bf16(kf[d0], qr[d0], x0, 0, 0, 0); x1 = __builtin_amdgcn_mfma_f32_32x32x16_bf16(kf[4 + d0], qr[d0], x1, 0, 0, 0); }
            float sacc = 0.f;
#pragma unroll
            for (int r = 0; r < 16; ++r) { x0[r] = __builtin_amdgcn_exp2f(x0[r]); sacc += x0[r]; }
            v4u pa, pb;
            pa.x = pg8::cvt_pk_bf16(x0[0], x0[1]); pa.y = pg8::cvt_pk_bf16(x0[2], x0[3]); pa.z = pg8::cvt_pk_bf16(x0[4], x0[5]); pa.w = pg8::cvt_pk_bf16(x0[6], x0[7]);
            pb.x = pg8::cvt_pk_bf16(x0[8], x0[9]); pb.y = pg8::cvt_pk_bf16(x0[10], x0[11]); pb.z = pg8::cvt_pk_bf16(x0[12], x0[13]); pb.w = pg8::cvt_pk_bf16(x0[14], x0[15]);
#define DA_VF(dst0, dst1, db_, blk_) do { const LAS unsigned char* vb_ = vbase + (db_) * 32 * DA_VP + (blk_) * 64; \
                const v2u a0_ = *(const LAS v2u*)(vb_), a1_ = *(const LAS v2u*)(vb_ + 16), b0_ = *(const LAS v2u*)(vb_ + 32), b1_ = *(const LAS v2u*)(vb_ + 48); \
                dst0.x = a0_.x; dst0.y = a0_.y; dst0.z = a1_.x; dst0.w = a1_.y; dst1.x = b0_.x; dst1.y = b0_.y; dst1.z = b1_.x; dst1.w = b1_.y; } while (0)
            v4u c0, c1, n0, n1;
            DA_VF(c0, c1, 0, 0);
#pragma unroll
            for (int db = 0; db < 4; ++db) {
                if (db < 3) DA_VF(n0, n1, db + 1, 0); else DA_VF(n0, n1, 0, 1);
                __builtin_amdgcn_sched_barrier(0);
                o[db] = __builtin_amdgcn_mfma_f32_32x32x16_bf16(__builtin_bit_cast(bf16x8, c0), __builtin_bit_cast(bf16x8, pa), o[db], 0, 0, 0);
                o[db] = __builtin_amdgcn_mfma_f32_32x32x16_bf16(__builtin_bit_cast(bf16x8, c1), __builtin_bit_cast(bf16x8, pb), o[db], 0, 0, 0);
#pragma unroll
                for (int r = 4 * db; r < 4 * db + 4; ++r) { x1[r] = __builtin_amdgcn_exp2f(x1[r]); sacc += x1[r]; }
                __builtin_amdgcn_sched_barrier(0);
                c0 = n0; c1 = n1;
            }
            lsum += sacc;
            pa.x = pg8::cvt_pk_bf16(x1[0], x1[1]); pa.y = pg8::cvt_pk_bf16(x1[2], x1[3]); pa.z = pg8::cvt_pk_bf16(x1[4], x1[5]); pa.w = pg8::cvt_pk_bf16(x1[6], x1[7]);
            pb.x = pg8::cvt_pk_bf16(x1[8], x1[9]); pb.y = pg8::cvt_pk_bf16(x1[10], x1[11]); pb.z = pg8::cvt_pk_bf16(x1[12], x1[13]); pb.w = pg8::cvt_pk_bf16(x1[14], x1[15]);
#pragma unroll
            for (int db = 0; db < 4; ++db) {
                if (db < 3) DA_VF(n0, n1, db + 1, 1);
                __builtin_amdgcn_sched_barrier(0);
                o[db] = __builtin_amdgcn_mfma_f32_32x32x16_bf16(__builtin_bit_cast(bf16x8, c0), __builtin_bit_cast(bf16x8, pa), o[db], 0, 0, 0);
                o[db] = __builtin_amdgcn_mfma_f32_32x32x16_bf16(__builtin_bit_cast(bf16x8, c1), __builtin_bit_cast(bf16x8, pb), o[db], 0, 0, 0);
                __builtin_amdgcn_sched_barrier(0);
                c0 = n0; c1 = n1;
            }
#undef DA_VF
        } else
#pragma unroll
        for (int kb = 0; kb < 2; ++kb) {
            const int k0 = t * 64 + kb * 32;
            if (k0 <= q0 + 31) {
                f32x16 x = f32x16{};
#pragma unroll
                for (int d0 = 0; d0 < 4; ++d0) { const bf16x8 kf = *(const LAS bf16x8*)(kbase + kb * 32 * DA_KP + 32 * d0);
                    x = __builtin_amdgcn_mfma_f32_32x32x16_bf16(kf, qr[d0], x, 0, 0, 0); }
#pragma unroll
                for (int r = 0; r < 16; ++r) x[r] = __builtin_amdgcn_exp2f(x[r]);
                if (k0 + 31 > q0) {
                    asm volatile("" ::: "memory");
#pragma unroll
                    for (int r = 0; r < 16; ++r) { const int kv = k0 + (r & 3) + 8 * (r >> 2) + 4 * hh; x[r] = (kv > q0 + r32) ? 0.f : x[r]; }
                    asm volatile("" ::: "memory");
                }
                float sacc = 0.f;
#pragma unroll
                for (int r = 0; r < 16; ++r) sacc += x[r];
                lsum += sacc;
                v4u pw0, pw1;
                pw0.x = pg8::cvt_pk_bf16(x[0], x[1]); pw0.y = pg8::cvt_pk_bf16(x[2], x[3]); pw0.z = pg8::cvt_pk_bf16(x[4], x[5]); pw0.w = pg8::cvt_pk_bf16(x[6], x[7]);
                pw1.x = pg8::cvt_pk_bf16(x[8], x[9]); pw1.y = pg8::cvt_pk_bf16(x[10], x[11]); pw1.z = pg8::cvt_pk_bf16(x[12], x[13]); pw1.w = pg8::cvt_pk_bf16(x[14], x[15]);
                const bf16x8 p0 = __builtin_bit_cast(bf16x8, pw0), p1 = __builtin_bit_cast(bf16x8, pw1);
#define DA_VF2(dst0, dst1, db_) do { const LAS unsigned char* vb_ = vbase + (db_) * 32 * DA_VP + kb * 64; \
                    const v2u a0_ = *(const LAS v2u*)(vb_), a1_ = *(const LAS v2u*)(vb_ + 16), b0_ = *(const LAS v2u*)(vb_ + 32), b1_ = *(const LAS v2u*)(vb_ + 48); \
                    dst0.x = a0_.x; dst0.y = a0_.y; dst0.z = a1_.x; dst0.w = a1_.y; dst1.x = b0_.x; dst1.y = b0_.y; dst1.z = b1_.x; dst1.w = b1_.y; } while (0)
                v4u c0, c1, n0, n1;
                DA_VF2(c0, c1, 0);
#pragma unroll
                for (int db = 0; db < 4; ++db) {
                    if (db < 3) DA_VF2(n0, n1, db + 1);
                    __builtin_amdgcn_sched_barrier(0);
                    o[db] = __builtin_amdgcn_mfma_f32_32x32x16_bf16(__builtin_bit_cast(bf16x8, c0), p0, o[db], 0, 0, 0);
                    o[db] = __builtin_amdgcn_mfma_f32_32x32x16_bf16(__builtin_bit_cast(bf16x8, c1), p1, o[db], 0, 0, 0);
                    __builtin_amdgcn_sched_barrier(0);
                    c0 = n0; c1 = n1;
                }
#undef DA_VF2
            }
        }
        if (t + 1 < NT || nk) DA_WRITE((t + 1) & 1);
        __syncthreads();
    }
#undef DA_WRITE
    lsum += __shfl_xor(lsum, 32);
    rl = 1.0f / lsum;
}
constexpr int DA_PARK = 57344;
__device__ __forceinline__ void diffattn_pair(bf16* rb, int h, int qb, float lam, const float* subln, LAS unsigned char* lds, int wid, int lane, bool have, const bf16* nkv  , int nh) {
    f32x16 o[4]; float rl;
    diffattn_core(rb + 3072 + h * 64, rb + h * 64, rb + 1536 + h * 128, qb, lds, wid, lane, o, rl, have, rb + 768 + h * 64, rb + 1536 + h * 128);
    LAS unsigned* park = (LAS unsigned*)(lds + DA_PARK) + (wid * 64 + lane);
#pragma unroll
    for (int db = 0; db < 4; ++db)
#pragma unroll
        for (int rp = 0; rp < 8; ++rp) park[(db * 8 + rp) * 512] = pk2(o[db][2 * rp] * rl, o[db][2 * rp + 1] * rl);
    diffattn_core(rb + 3840 + h * 64, rb + 768 + h * 64, rb + 1536 + h * 128, qb, lds, wid, lane, o, rl, true, nkv, nkv ? nkv + 1536 + nh * 64 : nullptr);
    const float lr = lam * rl; float ss = 0.f;
#pragma unroll
    for (int db = 0; db < 4; ++db)
#pragma unroll
        for (int rp = 0; rp < 8; ++rp) { const unsigned w = park[(db * 8 + rp) * 512];
            const float a0 = bflo(w) - lr * o[db][2 * rp], a1 = bfhi(w) - lr * o[db][2 * rp + 1];
            o[db][2 * rp] = a0; o[db][2 * rp + 1] = a1; ss += a0 * a0 + a1 * a1; }
    ss += __shfl_xor(ss, 32);
    const float rs = rsqrtf(ss * (1.0f / 128.0f) + RMS_EPS) * (1.0f - 0.35550906759096934f);
    int tl_ = threadIdx.x; asm volatile("" : "+v"(tl_));
    const int r32e = tl_ & 31, hhe = (tl_ >> 5) & 1;
    bf16* orow = rb + (size_t)(qb * 256 + wid * 32 + r32e) * BIGP + 5120 + h * 128;
#pragma unroll
    for (int db = 0; db < 4; ++db)
#pragma unroll
        for (int g = 0; g < 4; ++g) { const f32x4 gg = *(const f32x4*)(subln + 32 * db + 8 * g + 4 * hhe);
            v2u w; w.x = pk2(o[db][4 * g] * rs * gg.x, o[db][4 * g + 1] * rs * gg.y); w.y = pk2(o[db][4 * g + 2] * rs * gg.z, o[db][4 * g + 3] * rs * gg.w);
            *(v2u*)(orow + 32 * db + 8 * g + 4 * hhe) = w; }
}
__device__ __forceinline__ int da_tab(int role, int k) {
    const unsigned long long c = (k == 0) ? 0xa16ce35de7ull : (k == 1) ? 0x9d56c68864ull : 0x9455042420ull;
    return (int)((c >> (5 * role)) & 31ull);
}
struct DiffUnit { int row, qb; };
__device__ __forceinline__ bool diff_next(int vcu, int G, int i, DiffUnit& u) {
    const int rep = i / 12, k = i - rep * 12; const int p = (vcu >> 1) + rep * (G >> 1); if (p >= 128) return false;
    const int role = vcu & 1;
    if (k < 8) { u.row = 3 * p + role; u.qb = 7 - k; }
    else { const int jx = k - 8; u.row = 3 * p + 2; u.qb = role == 0 ? ((jx & 1) ? (jx >> 1) : 7 - (jx >> 1)) : ((jx & 1) ? 2 + (jx >> 1) : 5 - (jx >> 1)); }
    return true;
}

struct Args { const float* in[20]; float* out; unsigned char* ws; int ph_lo, ph_hi; };

__global__ void __launch_bounds__(NTHREADS, 2) mega_fwd(Args args) {
    extern __shared__ __attribute__((aligned(16))) unsigned char lds_raw[];
    LAS unsigned char* lds = (LAS unsigned char*)lds_raw;
    cg::grid_group grid = cg::this_grid();
#ifdef TPHASE
    unsigned long long tst0 = 0, tst1 = 0;
#define TSTART(k) do { if ((k) == TPHASE) tst0 = __builtin_amdgcn_s_memrealtime(); } while (0)
#define TEND(k) do { if ((k) == TPHASE) tst1 = __builtin_amdgcn_s_memrealtime(); } while (0)
#else
#define TSTART(k) do {} while (0)
#define TEND(k) do {} while (0)
#endif
    { volatile LAS unsigned* st_ = (volatile LAS unsigned*)(lds + LDS_BYTES - 64); if (threadIdx.x < 2) st_[threadIdx.x] = 0u; __syncthreads();
      (void)xcd_barrier_post((unsigned*)(args.ws + WS_BAR), st_); }
    grid.sync();
#define TIDS() int tid_ = threadIdx.x; asm volatile("" : "+v"(tid_)); const int tid = tid_, lane = tid & 63, wid = __builtin_amdgcn_readfirstlane(tid >> 6); \
    int bx_ = blockIdx.x; asm volatile("" : "+s"(bx_)); const int bx = bx_, G = gridDim.x, vcu = (G % 8 == 0) ? (bx % 8) * (G / 8) + bx / 8 : bx, gw = vcu * NWAVES + wid, NGW = G * NWAVES; \
    LAS float* scr = (LAS float*)(lds + wid * 16384); (void)tid; (void)lane; (void)gw; (void)NGW; (void)scr; (void)vcu
    typedef const __attribute__((address_space(4))) Args* kargp_t;
#define KARG() kargp_t ap = (kargp_t)__builtin_amdgcn_kernarg_segment_ptr(); asm volatile("" : "+s"(ap)); unsigned char* ws = ap->ws; (void)ws
#define INP(k) (ap->in[k])
#define WSP(T, off) ((T*)(ws + (off)))
#define lamp WSP(float, WS_SMALL)
#define rss0 WSP(float, WS_SMALL + 65536)
#define rss1 ((float*)((char*)(ap->out) + 64 * MiB))
#define rss2 ((float*)((char*)(ap->out) + 66 * MiB))
#define rss3 ((float*)((char*)(ap->out) + 68 * MiB))
#define rope WSP(float, WS_SMALL + 524288)
#define W1 WSP(bf16, WS_W1)
#define WPOOL WSP(bf16, WS_POOL)
#define WO0 WSP(bf16, WS_WO0)
#define WO1 WSP(bf16, WS_WO1)
#define W6 WSP(bf16, WS_W6)
#define WF1 WSP(bf16, WS_WF1)
#define WF2 WSP(bf16, WS_WF2)
#define WF2B WSP(bf16, WS_WF2B)
#define MKV WSP(bf16, WS_MKV)
#define XB WSP(bf16, WS_XB)
#define BIG WSP(bf16, WS_BIG)
#define DFLAG WSP(unsigned, WS_SMALL + 1024)
#define x_in INP(0)
#define mem_in INP(1)
#define mix_norm INP(2)
#define w_in INP(3)
#define w_out INP(4)
#define mem_norm INP(5)
#define w_mem_kv INP(6)
#define mem_q_norm INP(7)
#define mem_k_norm INP(8)
#define ffn_norm INP(9)
#define w_ff1 INP(10)
#define w_ff2 INP(11)
#define pool_w INP(12)
#define pool_scale INP(13)
#define kv_norm INP(14)
#define w_kv INP(15)
#define k_norm INP(16)
#define q_norm INP(17)
#define diff_lambda INP(18)
#define subln_norm INP(19)
#define out_p (ap->out)
#define IN(k) true
#define CGSYNC() do { asm volatile("s_waitcnt vmcnt(0) lgkmcnt(0)" ::: "memory"); grid.sync(); asm volatile("buffer_inv sc1\n\ts_waitcnt vmcnt(0)" ::: "memory"); } while (0)
#define GSYNC() do { kargp_t ap_ = (kargp_t)__builtin_amdgcn_kernarg_segment_ptr(); asm volatile("" : "+s"(ap_)); XcdBarrier b_; b_.bar = (unsigned*)(ap_->ws + WS_BAR); b_.x = xb_xcc_id(); \
    b_.st = (volatile LAS unsigned*)(lds + LDS_BYTES - 64); xcd_barrier(b_); } while (0)
#define SEAM(k) do { if (IN(k) && IN((k) + 1)) GSYNC(); } while (0)

    TSTART(0); if (IN(0)) {
        KARG(); TIDS();
        int cursor = 0;
        { TJob j{w_in, 2048, 2048, W1, 0, mix_norm, nullptr, 0, 0, 0}; run_tjob(j, scr, gw, NGW, lane, cursor); }
        { TJob j{w_mem_kv, 2048, 1024, W1, 2048, mem_norm, nullptr, 0, 0, 0}; run_tjob(j, scr, gw, NGW, lane, cursor); }
        { TJob j{w_mem_kv + (size_t)2048 * 1024, 2048, 1024, W1, 3072, mem_norm + 2048, nullptr, 0, 0, 0}; run_tjob(j, scr, gw, NGW, lane, cursor); }
#pragma unroll 1
        for (int g = 0; g < 4; ++g) { TJob j{pool_w + (size_t)g * 384 * 384, 384, 384, WPOOL, g * 512, nullptr, pool_scale + g * 384, 0, 0, 0}; run_tjob(j, scr, gw, NGW, lane, cursor); }
        { TJob j{w_out, 2048, 2048, WO0, 0, nullptr, nullptr, 1, 0, 0}; run_tjob(j, scr, gw, NGW, lane, cursor); }
        { TJob j{w_out + (size_t)2048 * 2048, 2048, 2048, WO1, 0, nullptr, nullptr, 1, 0, 0}; run_tjob(j, scr, gw, NGW, lane, cursor); }
        { TJob j{w_kv, 2048, 3072, W6, 0, kv_norm, nullptr, 0, 1, 0}; run_tjob(j, scr, gw, NGW, lane, cursor); }
        { TJob j{w_in + (size_t)2048 * 2048, 2048, 2048, W6, 3072, mix_norm + 2048, nullptr, 0, 1, 0}; run_tjob(j, scr, gw, NGW, lane, cursor); }
        { TJob j{w_ff1, 2048, 8192, WF1, 0, ffn_norm, nullptr, 0, 0, 0}; run_tjob(j, scr, gw, NGW, lane, cursor); }
        { TJob j{w_ff2, 8192, 2048, WF2, 0, nullptr, nullptr, 0, 0, WF2P}; run_tjob(j, scr, gw, NGW, lane, cursor); }
        for (int i = gw * 64 + lane; i < 4 * 128 * 384 / 8; i += NGW * 64) { const int g = i / (128 * 48), r = i % (128 * 48); *(v4u*)(WPOOL + (size_t)(g * 512 + 384) * 384 + (size_t)r * 8) = (v4u){0u, 0u, 0u, 0u}; }
        for (int m = gw; m < M + MEMROWS; m += NGW) row_to_bf16(m < M ? x_in + (size_t)m * DM : mem_in + (size_t)(m - M) * DM, XB + (size_t)m * DM, rss0 + m, lane);
        for (int i = gw * 64 + lane; i < 2048 * 8; i += NGW * 64) { const int pos = i >> 3, fi = i & 7;
            const double invf = fi == 0 ? 1.0 : fi == 1 ? 0.19392274474868576 : fi == 2 ? 0.03760603093086393 : fi == 3 ? 0.007292664737217109 : fi == 4 ? 0.001414213562373095 : fi == 5 ? 0.0002742481756762073 : fi == 6 ? 5.318295896944988e-05 : 1.031338537721246e-05;
            double rev = (double)pos * invf * 0.15915494309189535; rev -= __builtin_rint(rev);
            rope[pos * 16 + fi] = __builtin_amdgcn_cosf((float)rev); rope[pos * 16 + 8 + fi] = __builtin_amdgcn_sinf((float)rev); }
#ifdef DBGCHK
        if (gw == 0 && lane == 0) DFLAG[0] = 0xffffffffu;
#endif
        if (gw == 0) { float a = diff_lambda[lane] * diff_lambda[64 + lane], b = diff_lambda[128 + lane] * diff_lambda[192 + lane]; a = wave_sum(a); b = wave_sum(b);
            if (lane == 0) lamp[0] = expf(a) - expf(b) + 0.35550906759096934f; }
    }
    GSYNC(); TEND(0);
    TSTART(1); if (IN(1)) {
        KARG(); TIDS();
        pg8::GemmX g{XB, W1, M, 2048, 2048, 2048, 2048}; pg8::SchedStd S; S.init(M, 2048, G, bx, 4);
        pg8::EpiP1 E{BIG, MKV, rss0};
        pg8::gemm_phase<pg8::EpiP1, pg8::SchedStd, true, true>(lds, g, S, E);
    }
    SEAM(1); TEND(1);
#ifdef DBGCHK
    { KARG(); TIDS(); if (gw < 64) { const int s_ = gw; (void)s_;
        { const int row = hsh(s_, 1) % 16384, col = hsh(s_, 2) % 2048; const float* xr = x_in + (size_t)row * 2048;
          const float want = row_dot(xr, mix_norm, w_in, 2048, col, lane) * row_rstd(xr, lane);
          chk(DFLAG, 1, bf2f(BIG[(size_t)row * BIGP + (col < 1536 ? col : 3072 + col - 1536)]), want, 0.03f); }
        { const int mrow = hsh(s_, 3) % 2048, mcol = hsh(s_, 4) % 2048, layer = mcol >> 10; const float* xr = mem_in + (size_t)mrow * 2048;
          const float want = row_dot(xr, mem_norm + layer * 2048, w_mem_kv + (size_t)layer * 2048 * 1024, 1024, mcol & 1023, lane) * row_rstd(xr, lane);
          chk(DFLAG, 2, bf2f(MKV[(size_t)mrow * 2048 + mcol]), want, 0.03f); }
    } GSYNC(); }
#endif

    TSTART(2); if (IN(2)) {
        KARG(); TIDS();
        if (bx < 64 && G > 64) {
            pg8::GemmX g{XB, W1, M + MEMROWS, 4096, 2048, 2048, 2048}; pg8::SchedMem S; S.init(bx);
            pg8::EpiP1 E{BIG, MKV, rss0};
            pg8::gemm_phase<pg8::EpiP1, pg8::SchedMem, true, true>(lds, g, S, E);
        } else {
        for (int it = (bx - 64) * NWAVES + wid; it < 3072; it += (G - 64) * NWAVES) {
            const int span = it % 3, rb = it / 3, m0 = rb * 16, t0 = m0 & 2047;
            const int col = span * 512 + lane * 8; const int w = 2 << (col / 384);
            const bf16* src = BIG + (size_t)m0 * BIGP + col; bf16* dst = BIG + (size_t)m0 * BIGP + 1536 + col;
            v4u R[32];
#pragma unroll
            for (int i = 0; i < 16; ++i) R[i] = (t0 > 0) ? *(const v4u*)(src - (size_t)(16 - i) * BIGP) : (v4u){0u, 0u, 0u, 0u};
#pragma unroll
            for (int i = 0; i < 16; ++i) R[16 + i] = *(const v4u*)(src + (size_t)i * BIGP);
            float s[8];
#pragma unroll
            for (int e = 0; e < 8; ++e) s[e] = 0.f;
#pragma unroll
            for (int i = 0; i < 16; ++i) { const bool in = (16 - i) <= w;
                s[0] += in ? bflo(R[i].x) : 0.f; s[1] += in ? bfhi(R[i].x) : 0.f; s[2] += in ? bflo(R[i].y) : 0.f; s[3] += in ? bfhi(R[i].y) : 0.f;
                s[4] += in ? bflo(R[i].z) : 0.f; s[5] += in ? bfhi(R[i].z) : 0.f; s[6] += in ? bflo(R[i].w) : 0.f; s[7] += in ? bfhi(R[i].w) : 0.f; }
#pragma unroll
            for (int r = 0; r < 16; ++r) { const int t = t0 + r; const v4u q = R[16 + r];
                const v4u p = (w == 2) ? R[14 + r] : (w == 4) ? R[12 + r] : (w == 8) ? R[8 + r] : R[r];
                float c[8]; c[0] = bflo(q.x); c[1] = bfhi(q.x); c[2] = bflo(q.y); c[3] = bfhi(q.y); c[4] = bflo(q.z); c[5] = bfhi(q.z); c[6] = bflo(q.w); c[7] = bfhi(q.w);
                s[0] += c[0] - bflo(p.x); s[1] += c[1] - bfhi(p.x); s[2] += c[2] - bflo(p.y); s[3] += c[3] - bfhi(p.y); s[4] += c[4] - bflo(p.z); s[5] += c[5] - bfhi(p.z); s[6] += c[6] - bflo(p.w); s[7] += c[7] - bfhi(p.w);
                const float ic = 1.0f / (float)((t + 1) < w ? (t + 1) : w);
                v4u o; o.x = pk2(s[0] * ic - c[0], s[1] * ic - c[1]); o.y = pk2(s[2] * ic - c[2], s[3] * ic - c[3]); o.z = pk2(s[4] * ic - c[4], s[5] * ic - c[5]); o.w = pk2(s[6] * ic - c[6], s[7] * ic - c[7]);
                *(v4u*)(dst + (size_t)r * BIGP) = o; }
        }
        }
        { unsigned* qhead = (unsigned*)(ws + WS_BAR) + 3840;
          TJob j1{w_ff1 + (size_t)2048 * 8192, 2048, 8192, (bf16*)out_p, 0, ffn_norm + 2048, nullptr, 0, 0, 0};
          TJob j2{w_ff2 + (size_t)8192 * 2048, 8192, 2048, WF2B, 0, nullptr, nullptr, 0, 0, WF2P};
          for (;;) { unsigned base = 0u; if (lane == 0) base = __hip_atomic_fetch_add(qhead, 8u, __ATOMIC_RELAXED, __HIP_MEMORY_SCOPE_AGENT);
              base = (unsigned)__builtin_amdgcn_readfirstlane((int)base); if (base >= 16384u) break;
#pragma unroll 1
              for (int k = 0; k < 8; ++k) { const int it = (int)base + k; if (it < 8192) transpose_item(j1, scr, it, lane); else transpose_item(j2, scr, it - 8192, lane); } } }
    }
    SEAM(2); TEND(2);
#ifdef DBGCHK
    { KARG(); TIDS(); if (gw < 64) { const int s_ = gw; (void)s_;
        { const int row = hsh(s_, 5) % 16384, col = hsh(s_, 6) % 1536, w = 2 << (col / 384), t = row & 2047; float sum = 0.f; const int n = (t + 1) < w ? (t + 1) : w;
          for (int j = 0; j < n; ++j) sum += bf2f(BIG[(size_t)(row - j) * BIGP + col]);
          const float want = sum / (float)n - bf2f(BIG[(size_t)row * BIGP + col]);
          chk(DFLAG, 3, bf2f(BIG[(size_t)row * BIGP + 1536 + col]), want, 0.03f); }
        if (s_ < 16) { const int row = hsh(s_, 7) % 16384, h = s_ & 3, b = row >> 11;
          chk_memattn(DFLAG, 4, x_in + (size_t)row * 2048, mix_norm, w_in, 2048, 1536 + 128 * h, MKV + (size_t)(b * 256) * 2048 + 128 * h, MKV + (size_t)(b * 256) * 2048 + 512 + 128 * h,
                      mem_q_norm, mem_k_norm, BIG + (size_t)row * BIGP + 3072 + 128 * h, scr, lane); }
    } GSYNC(); }
#endif

    TSTART(3); if (IN(3)) {
        KARG(); TIDS();
        pg8::GemmX g{BIG + 1536, WPOOL, M, 2048, 384, BIGP, 384}; pg8::SchedPool S; S.init(G, bx);
        pg8::EpiPool E{BIG};
        pg8::gemm_phase<pg8::EpiPool, pg8::SchedPool, true, true>(lds, g, S, E);
        for (int u = vcu; u < 256; u += G) { const int b = u >> 5, h = (u >> 3) & 3, qb = u & 7;
            memattn_unit(BIG + (size_t)(b * SEQ + qb * 256) * BIGP + 3072 + 128 * h, MKV + (size_t)(b * 256) * 2048 + 128 * h, MKV + (size_t)(b * 256) * 2048 + 512 + 128 * h, mem_q_norm, mem_k_norm, lds, wid, lane); }
        __syncthreads();
    }
    SEAM(3); TEND(3);
#ifdef DBGCHK
    { KARG(); TIDS(); if (gw < 64) { const int s_ = gw; (void)s_;
        { const int row = hsh(s_, 8) % 16384, col = hsh(s_, 9) % 1536, g = col / 384, d = col % 384; float sum = 0.f;
          for (int c = lane; c < 384; c += 64) sum += bf2f(BIG[(size_t)row * BIGP + 1536 + 384 * g + c]) * pool_w[((size_t)g * 384 + c) * 384 + d];
          const float want = wave_sum(sum) * pool_scale[col];
          chk(DFLAG, 5, bf2f(BIG[(size_t)row * BIGP + 3584 + col]), want, 0.03f); }
    } GSYNC(); }
#endif

#pragma unroll 1
    for (int layer = 0; layer < 2; ++layer) {
        const int pb = 4 + layer * 10;
        if (layer == 1) {
            TSTART(11); if (IN(11)) {
                KARG(); TIDS();
                pg8::GemmX g{XB, W6, M, 5120, 2048, 2048, 2048}; pg8::SchedStd S; S.init(M, 5120, G, bx);
                int pm0_ = -1; { pg8::Unit u0_; if (S.next(0, u0_)) { if (tid < 256) { float sacc = 0.f;
#pragma unroll 8
                    for (int k = 0; k < 32; ++k) sacc += rss2[(size_t)k * 16384 + u0_.pm * 256 + tid];
                    ((LAS float*)(lds + 131072))[tid] = rsqrtf(sacc * (1.0f / 2048.0f) + RMS_EPS); } pm0_ = u0_.pm; } }
                __syncthreads();
                pg8::EpiP6 E{BIG, pg8::RowScale{(LAS const float*)(lds + 131072), pm0_, rss2}, k_norm, q_norm, rope};
                pg8::gemm_phase<pg8::EpiP6, pg8::SchedStd, true, true>(lds, g, S, E);
            }
            SEAM(11); TEND(11);
#ifdef DBGCHK
            { KARG(); TIDS(); if (gw < 64) { const int s_ = gw;
              const int row = hsh(s_, 14) % 16384, hh = hsh(s_, 15) % 12, kind = s_ & 3; const float* xr = out_p + (size_t)row * 2048; const float rs = row_rstd(xr, lane);
              const float* Wp = kind == 2 ? w_in + (size_t)2048 * 2048 : w_kv; const float* gp = kind == 2 ? mix_norm + 2048 : kv_norm; const int ldw = kind == 2 ? 2048 : 3072;
              const int wcol = (kind == 0 ? 0 : kind == 1 ? 768 : kind == 2 ? 768 : 1536) + hh * 64; const int bcol = (kind == 0 ? 0 : kind == 1 ? 768 : kind == 2 ? 3840 : 1536) + hh * 64;
              for (int d = 0; d < 64; ++d) { const float v = row_dot(xr, gp, Wp, ldw, wcol + d, lane) * rs; if (lane == 0) scr[d] = v; }
              LDS_WAIT();
              float y = scr[lane];
              if (kind != 3) { float ss = 0.f; for (int d = 0; d < 64; ++d) ss += scr[d] * scr[d]; const float r = rsqrtf(ss * (1.0f / 64.0f) + RMS_EPS);
                y = y * r * (kind == 2 ? q_norm[lane] * (0.125f * 1.4426950408889634f) : k_norm[lane]); scr[64 + lane] = y; LDS_WAIT();
                if (lane < 16) { const int i = lane & 7; const float c = rope[(size_t)(row & 2047) * 16 + i], sn = rope[(size_t)(row & 2047) * 16 + 8 + i];
                  y = lane < 8 ? scr[64 + lane] * c - scr[64 + lane + 8] * sn : scr[64 + lane - 8] * sn + scr[64 + lane] * c; } }
              chk(DFLAG, 9, bf2f(BIG[(size_t)row * BIGP + bcol + lane]), y, 0.03f);
              LDS_WAIT();
            } GSYNC(); }
#endif

            TSTART(12); if (IN(12)) {
                KARG(); TIDS();
                { const float lam = lamp[0];
                for (int grp = vcu >> 3; grp < 32; grp += (G >> 3)) { const int role = vcu & 7;
#pragma unroll 1
                    for (int k = 0; k < 3; ++k) { const int code = da_tab(role, k), row = 3 * grp + (code >> 3), qb = code & 7, b = row / 12, h = row - b * 12;
                        const int ncode = da_tab(role, k < 2 ? k + 1 : 0), nrow = 3 * grp + (ncode >> 3), nb = nrow / 12, nh = nrow - nb * 12;
                        const bf16* nkv = (k < 2) ? BIG + (size_t)(nb * SEQ) * BIGP + nh * 64 : (const bf16*)nullptr;
                        diffattn_pair(BIG + (size_t)(b * SEQ) * BIGP, h, qb, lam, subln_norm, lds, wid, lane, k > 0, nkv, nh); } } }
                for (int u = vcu; u < 256; u += G) { const int b = u >> 5, h = (u >> 3) & 3, qb = u & 7;
                    memattn_unit(BIG + (size_t)(b * SEQ + qb * 256) * BIGP + 4608 + 128 * h, MKV + (size_t)(b * 256) * 2048 + 1024 + 128 * h, MKV + (size_t)(b * 256) * 2048 + 1536 + 128 * h,
                                 mem_q_norm + 128, mem_k_norm + 128, lds, wid, lane); }
                __syncthreads();
            }
            SEAM(12); TEND(12);
#ifdef DBGCHK
            { KARG(); TIDS(); if (gw < 64) { const int s_ = gw;
              { const int row = hsh(s_, 16) % 16384, hh = hsh(s_, 17) % 12, map = s_ & 1, half = (s_ >> 1) & 1;
                const float o = naive_diff(BIG, row, 3072 + map * 768 + hh * 64, map * 768 + hh * 64, 1536 + hh * 128 + half * 64, scr, lane);
                chk(DFLAG, 10, bf2f(BIG[(size_t)row * BIGP + 5120 + map * 1536 + hh * 128 + half * 64 + lane]), o, 0.03f); }
              if (s_ < 16) { const int row = hsh(s_, 18) % 16384, h = s_ & 3, b = row >> 11;
                chk_memattn(DFLAG, 11, out_p + (size_t)row * 2048, mix_norm + 2048, w_in + (size_t)2048 * 2048, 2048, 1536 + 128 * h, MKV + (size_t)(b * 256) * 2048 + 1024 + 128 * h, MKV + (size_t)(b * 256) * 2048 + 1536 + 128 * h,
                            mem_q_norm + 128, mem_k_norm + 128, BIG + (size_t)row * BIGP + 4608 + 128 * h, scr, lane); }
            } GSYNC(); }
#endif

        }
        TSTART(pb); if (IN(pb)) {
            KARG(); TIDS();
            pg8::GemmX g{BIG + (layer == 0 ? 3072 : 4608), layer == 0 ? WO0 : WO1, M, 2048, 2048, BIGP, 2048}; pg8::SchedStd S; S.init(M, 2048, G, bx, 4);
            pg8::EpiResid E{layer == 0 ? x_in : nullptr, nullptr, XB, layer == 0 ? rss1 : rss3};
            pg8::gemm_phase<pg8::EpiResid, pg8::SchedStd, true, true>(lds, g, S, E);
        }
        SEAM(pb); TEND(pb);
#ifdef DBGCHK
        if (layer == 0) { KARG(); TIDS(); if (gw < 64) { const int s_ = gw;
          const int row = hsh(s_, 10) % 16384, col = hsh(s_, 11) % 2048; float sum = 0.f;
          for (int k = lane; k < 2048; k += 64) sum += bf2f(BIG[(size_t)row * BIGP + (k < 1536 ? 3584 + k : 3072 + k - 1536)]) * w_out[(size_t)k * 2048 + col];
          const float want = x_in[(size_t)row * 2048 + col] + wave_sum(sum);
          chk(DFLAG, 6, out_p[(size_t)row * 2048 + col], want, 0.01f);
          chk(DFLAG, 7, bf2f(XB[(size_t)row * 2048 + col]), out_p[(size_t)row * 2048 + col], 0.01f);
          const float r1 = row_rstd(out_p + (size_t)row * 2048, lane); chk(DFLAG, 7, pg8::rstd2048(rss1, row), r1, 0.001f);
        } GSYNC(); }
#endif

        TSTART(pb + 1); if (IN(pb + 1)) {
            KARG(); TIDS();
            pg8::GemmX g{XB, layer == 0 ? WF1 : (bf16*)out_p, M, 8192, 2048, 2048, 2048}; pg8::SchedStd S; S.init(M, 8192, G, bx);
            const float* rssx_ = layer == 0 ? rss1 : rss3; int pm0_ = -1; { pg8::Unit u0_; if (S.next(0, u0_)) { if (tid < 256) { float sacc = 0.f;
#pragma unroll 8
                    for (int k = 0; k < 32; ++k) sacc += rssx_[(size_t)k * 16384 + u0_.pm * 256 + tid];
                    ((LAS float*)(lds + 131072))[tid] = rsqrtf(sacc * (1.0f / 2048.0f) + RMS_EPS); } pm0_ = u0_.pm; } }
                __syncthreads();
            pg8::EpiRelu2 E{BIG, pg8::RowScale{(LAS const float*)(lds + 131072), pm0_, rssx_}};
            pg8::gemm_phase<pg8::EpiRelu2, pg8::SchedStd, true, true>(lds, g, S, E);
        }
        SEAM(pb + 1); TEND(pb + 1);
#ifdef DBGCHK
        { KARG(); TIDS(); if (gw < 64) { const int s_ = gw;
          const int row = hsh(s_, 12) % 16384, col = hsh(s_, 13) % 8192; const float* xr = out_p + (size_t)row * 2048;
          float v = row_dot(xr, ffn_norm + layer * 2048, w_ff1 + (size_t)layer * 2048 * 8192, 8192, col, lane) * row_rstd(xr, lane); v = fmaxf(v, 0.f); v *= v;
          chk(DFLAG, layer == 0 ? 8 : 15, bf2f(BIG[(size_t)row * BIGP + col]), v, 0.03f);
        } GSYNC(); }
#endif

        TSTART(pb + 2); if (IN(pb + 2)) {
            KARG(); TIDS();
            pg8::GemmX g{BIG, layer == 0 ? WF2 : WF2B, M, 2048, 8192, BIGP, WF2P}; pg8::SchedStd S; S.init(M, 2048, G, bx, 4);
            pg8::EpiResid E{nullptr, layer == 0 ? nullptr : out_p, XB, layer == 0 ? rss2 : nullptr};
            pg8::gemm_phase<pg8::EpiResid, pg8::SchedStd, true, true>(lds, g, S, E);
        }
        if (layer == 0) { if (IN(6) && IN(11)) GSYNC(); TEND(6); }
    }
#ifdef TPHASE
    { GSYNC(); if (TPHASE == 16) tst1 = __builtin_amdgcn_s_memrealtime(); KARG(); if (blockIdx.x == 0 && threadIdx.x == 0) out_p[0] = (float)((((tst1 - tst0) / 100ull + 10ull) / 20ull) * 20ull); }
#endif
#ifdef DBGCHK
    { GSYNC(); KARG(); if (blockIdx.x == 0 && threadIdx.x == 0) { const unsigned f = DFLAG[0]; if (f != 0xffffffffu) out_p[0] = 100.0f * (float)f; } }
#endif
#undef IN
#undef SEAM
#undef rope
#undef lamp
}

extern "C" void kernel_launch(void* const* d_in, const int* in_sizes, int n_in, void* d_out, int out_size, void* d_ws, size_t ws_size, hipStream_t stream) {
    static int grid = 0;
    if (grid == 0) {
        if (n_in != 20 || out_size != M * DM || ws_size < WS_END) { fprintf(stderr, "kernel_launch: unexpected shapes (n_in %d out %d ws %zu)\n", n_in, out_size, ws_size); grid = -1; return; }
        int dev = 0, cus = 0, per_cu = 0;
        (void)hipGetDevice(&dev); (void)hipDeviceGetAttribute(&cus, hipDeviceAttributeMultiprocessorCount, dev);
        if (hipFuncSetAttribute((const void*)mega_fwd, hipFuncAttributeMaxDynamicSharedMemorySize, LDS_BYTES) != hipSuccess) { fprintf(stderr, "kernel_launch: hipFuncSetAttribute failed\n"); grid = -1; return; }
        (void)hipOccupancyMaxActiveBlocksPerMultiprocessor(&per_cu, (const void*)mega_fwd, NTHREADS, LDS_BYTES);
        (void)hipGetLastError();
        if (per_cu < 1) { fprintf(stderr, "kernel_launch: occupancy query says %d blocks per CU\n", per_cu); per_cu = 1; }
        grid = cus * 1;
        fprintf(stderr, "kernel_launch: grid %d (cus %d, per_cu %d), ws %zu\n", grid, cus, per_cu, ws_size);
    }
    if (grid < 0) return;
    if (hipMemsetAsync((char*)d_ws + WS_BAR, 0, 16384, stream) != hipSuccess) { fprintf(stderr, "kernel_launch: memset failed\n"); return; }
    Args a{};
    for (int i = 0; i < 20; ++i) a.in[i] = (const float*)d_in[i];
    a.out = (float*)d_out; a.ws = (unsigned char*)d_ws; a.ph_lo = 0; a.ph_hi = 100;
    void* kargs[] = {&a};
    hipError_t e = hipLaunchCooperativeKernel((const void*)mega_fwd, dim3(grid), dim3(NTHREADS), kargs, LDS_BYTES, stream);
    if (e != hipSuccess) fprintf(stderr, "kernel_launch: cooperative launch failed: %s (grid %d)\n", hipGetErrorString(e), grid);
}
```
